# Optimizing an MI355X kernel written in HIP

```python
import jax
import jax.numpy as jnp
from jax import lax
import numpy as np

D_MODEL = 2048
BATCH = 8
SEQ = 2048
DEPTH = 1

POOL_WINDOWS = (2, 4, 8, 16)
POOL_GROUPS = 4
POOL_GROUP_DIM = D_MODEL // 8
POOL_WIDTH = POOL_GROUPS * POOL_GROUP_DIM
N_HEADS = 16
N_KV_HEADS = 4
HEAD_DIM = 128
ATTN_WIDTH = N_HEADS * HEAD_DIM
KV_WIDTH = N_KV_HEADS * HEAD_DIM
ROT_DIM = HEAD_DIM // 4
IDX_HEADS = 16
IDX_DIM = 64
IDX_ROT_DIM = IDX_DIM // 4
TOPK_MAX = 256
Q_BLOCK = 64
ROPE_THETA = 500000.0
N_BRANCHES = 2
IN_SPLITS = (POOL_WIDTH, ATTN_WIDTH, KV_WIDTH, KV_WIDTH, IDX_HEADS * IDX_DIM, IDX_DIM, IDX_HEADS, N_BRANCHES * D_MODEL)
IN_WIDTH = POOL_WIDTH + ATTN_WIDTH + 2 * KV_WIDTH + IDX_HEADS * IDX_DIM + IDX_DIM + IDX_HEADS + N_BRANCHES * D_MODEL
N_EXPERTS = 32
TOP_K = 4
D_FF = D_MODEL
SWIGLU_ALPHA = 1.702
SWIGLU_LIMIT = 7.0
MOE_BLOCK = 256
N_MOD = 6
EPS = 1e-6

kernel_name = 'hybrid_pool_dsa_moe_block'


def rms_norm(x, g):
    xf = x.astype(jnp.float32)
    y = xf * lax.rsqrt(jnp.mean(xf * xf, axis=-1, keepdims=True) + EPS)
    return (y * g.astype(jnp.float32)).astype(x.dtype)


def rope_tables(seq, rot_dim):
    inv = ROPE_THETA ** (-jnp.arange(0, rot_dim, 2, dtype=jnp.float32) / rot_dim)
    ang = jnp.arange(seq, dtype=jnp.float32)[:, None] * inv[None, :]
    return jnp.cos(ang), jnp.sin(ang)


def partial_rope(x, cos, sin):
    half = cos.shape[-1]
    rot = 2 * half
    shape = (1, x.shape[1]) + (1,) * (x.ndim - 3) + (half,)
    c = cos.reshape(shape).astype(x.dtype)
    s = sin.reshape(shape).astype(x.dtype)
    x1 = x[..., :half]
    x2 = x[..., half:rot]
    return jnp.concatenate([x1 * c - x2 * s, x2 * c + x1 * s, x[..., rot:]], axis=-1)


def pool_mixer(u, w_grp, scale):
    b_, s_, _ = u.shape
    uf = u.astype(jnp.float32).reshape(b_, s_, POOL_GROUPS, POOL_GROUP_DIM)
    cs = jnp.concatenate([jnp.zeros_like(uf[:, :1]), jnp.cumsum(uf, axis=1)], axis=1)
    t = jnp.arange(s_)
    outs = []
    for g, w in enumerate(POOL_WINDOWS):
        csg = cs[:, :, g]
        lo = jnp.maximum(t + 1 - w, 0)
        cnt = jnp.minimum(t + 1, w).astype(jnp.float32)[None, :, None]
        outs.append((csg[:, t + 1] - csg[:, lo]) / cnt)
    pooled = jnp.stack(outs, axis=2)
    mixed = (pooled - uf).astype(u.dtype)
    y = jnp.einsum('bsgc,gcd->bsgd', mixed, w_grp).reshape(b_, s_, POOL_WIDTH)
    return y * scale


def dsa_attention(q, k, v, qi, ki, wi):
    b_, s_ = q.shape[0], q.shape[1]
    n_keep = min(TOPK_MAX, s_ // 4)
    n_blk = s_ // Q_BLOCK
    grp = N_HEADS // N_KV_HEADS
    gather = jax.vmap(lambda a, i: a[i])
    key_pos = jnp.arange(s_)

    def block(bi):
        start = bi * Q_BLOCK
        qb = lax.dynamic_slice_in_dim(q, start, Q_BLOCK, axis=1)
        qib = lax.dynamic_slice_in_dim(qi, start, Q_BLOCK, axis=1)
        wib = lax.dynamic_slice_in_dim(wi, start, Q_BLOCK, axis=1)
        t = start + jnp.arange(Q_BLOCK)
        causal = key_pos[None, :] <= t[:, None]
        dots = jnp.einsum('bqhd,bsd->bqhs', qib, ki, preferred_element_type=jnp.float32)
        score = jnp.einsum('bqhs,bqh->bqs', jax.nn.relu(dots), wib.astype(jnp.float32))
        score = jnp.where(causal[None], score, -jnp.inf)
        _, idx = lax.top_k(score, n_keep)
        valid = idx <= t[None, :, None]
        ks = gather(k, idx)
        vs = gather(v, idx)
        qg = qb.reshape(b_, Q_BLOCK, N_KV_HEADS, grp, HEAD_DIM)
        logits = jnp.einsum('bqgrd,bqkgd->bqgrk', qg, ks, preferred_element_type=jnp.float32) * (HEAD_DIM ** -0.5)
        logits = jnp.where(valid[:, :, None, None, :], logits, -jnp.inf)
        p = jax.nn.softmax(logits, axis=-1)
        o = jnp.einsum('bqgrk,bqkgd->bqgrd', p.astype(vs.dtype), vs)
        return o.reshape(b_, Q_BLOCK, ATTN_WIDTH)

    out = lax.map(block, jnp.arange(n_blk))
    return jnp.transpose(out, (1, 0, 2, 3)).reshape(b_, s_, ATTN_WIDTH)


def token_mixer(h, w_in, w_pool_grp, pool_scale, w_up_pool, w_up_attn, w_out, rope_a, rope_i):
    b_, s_, _ = h.shape
    proj = h @ w_in
    offs = [int(o) for o in np.cumsum(IN_SPLITS)[:-1]]
    u, q, k, v, qi, ki, wi, gl = jnp.split(proj, offs, axis=-1)
    q = partial_rope(q.reshape(b_, s_, N_HEADS, HEAD_DIM), *rope_a)
    k = partial_rope(k.reshape(b_, s_, N_KV_HEADS, HEAD_DIM), *rope_a)
    v = v.reshape(b_, s_, N_KV_HEADS, HEAD_DIM)
    qi = partial_rope(qi.reshape(b_, s_, IDX_HEADS, IDX_DIM), *rope_i)
    ki = partial_rope(ki, *rope_i)
    wi = wi * (IDX_HEADS ** -0.5 * IDX_DIM ** -0.5)
    y_pool = pool_mixer(u, w_pool_grp, pool_scale)
    y_attn = dsa_attention(q, k, v, qi, ki, wi)
    g_pool, g_attn = jnp.split(jax.nn.sigmoid(gl), N_BRANCHES, axis=-1)
    merged = g_pool * (y_pool @ w_up_pool) + g_attn * (y_attn @ w_up_attn)
    return merged @ w_out


def moe_ffn(h, w_router, b_router, w1, b1, w2, b2):
    b_, s_, d_ = h.shape
    xt = h.reshape(-1, d_)
    n_tok = xt.shape[0]
    logits = (xt @ w_router + b_router).astype(jnp.float32)
    top_val, top_idx = lax.top_k(logits, TOP_K)
    gates = jax.nn.softmax(top_val, axis=-1)
    n_slots = n_tok * TOP_K
    e_flat = top_idx.reshape(-1)
    order = jnp.argsort(e_flat)
    sorted_e = e_flat[order]
    sorted_tok = order // TOP_K
    counts = jnp.zeros((N_EXPERTS,), jnp.int32).at[e_flat].add(1)
    starts = jnp.cumsum(counts) - counts
    padded = (counts + MOE_BLOCK - 1) // MOE_BLOCK * MOE_BLOCK
    pad_end = jnp.cumsum(padded)
    pad_start = pad_end - padded
    dest_sorted = pad_start[sorted_e] + (jnp.arange(n_slots) - starts[sorted_e])
    n_blocks = -(-n_slots // MOE_BLOCK) + N_EXPERTS
    n_rows = n_blocks * MOE_BLOCK
    row_tok = jnp.zeros((n_rows,), jnp.int32).at[dest_sorted].set(sorted_tok.astype(jnp.int32))
    row_gate = jnp.zeros((n_rows,), jnp.float32).at[dest_sorted].set(gates.reshape(-1)[order])
    blk_start = jnp.arange(n_blocks) * MOE_BLOCK
    blk_expert = jnp.minimum(jnp.searchsorted(pad_end, blk_start, side='right'), N_EXPERTS - 1)
    xs = xt[row_tok].reshape(n_blocks, MOE_BLOCK, d_)

    def expert_block(args):
        xb, e = args
        hb = xb @ w1[e] + b1[e]
        glu = jnp.minimum(hb[:, :D_FF], SWIGLU_LIMIT)
        lin = jnp.clip(hb[:, D_FF:], -SWIGLU_LIMIT, SWIGLU_LIMIT)
        act = glu * jax.nn.sigmoid(SWIGLU_ALPHA * glu) * (lin + 1)
        return act @ w2[e] + b2[e]

    ys = lax.map(expert_block, (xs, blk_expert)).reshape(n_rows, d_)
    y = jax.ops.segment_sum(ys * row_gate[:, None].astype(ys.dtype), row_tok, num_segments=n_tok)
    return y.reshape(b_, s_, d_)


def setup_inputs(seed: int = 0) -> dict:
    key = jax.random.key(seed)
    ks = jax.random.split(key, 20)
    f32 = jnp.float32
    nrm = lambda k, shape, s: jax.random.normal(k, shape, f32) * s
    L = DEPTH
    return {
        'x': nrm(ks[0], (BATCH, SEQ, D_MODEL), 1.0),
        'c': nrm(ks[1], (BATCH, D_MODEL), 1.0),
        'w_ada': nrm(ks[2], (L, D_MODEL, N_MOD * D_MODEL), 0.5 * D_MODEL ** -0.5),
        'b_ada': nrm(ks[3], (L, N_MOD * D_MODEL), 0.01),
        'g_pre_mix': 1.0 + nrm(ks[4], (L, D_MODEL), 0.02),
        'g_post_mix': 1.0 + nrm(ks[5], (L, D_MODEL), 0.02),
        'w_in': nrm(ks[6], (L, D_MODEL, IN_WIDTH), D_MODEL ** -0.5),
        'w_pool_grp': nrm(ks[7], (L, POOL_GROUPS, POOL_GROUP_DIM, POOL_GROUP_DIM), POOL_GROUP_DIM ** -0.5),
        'pool_scale': 1.0 + nrm(ks[8], (L, POOL_WIDTH), 0.02),
        'w_up_pool': nrm(ks[9], (L, POOL_WIDTH, D_MODEL), POOL_WIDTH ** -0.5),
        'w_up_attn': nrm(ks[10], (L, ATTN_WIDTH, D_MODEL), ATTN_WIDTH ** -0.5),
        'w_out': nrm(ks[11], (L, D_MODEL, D_MODEL), D_MODEL ** -0.5),
        'g_pre_ffn': 1.0 + nrm(ks[12], (L, D_MODEL), 0.02),
        'g_post_ffn': 1.0 + nrm(ks[13], (L, D_MODEL), 0.02),
        'w_router': nrm(ks[14], (L, D_MODEL, N_EXPERTS), D_MODEL ** -0.5),
        'b_router': nrm(ks[15], (L, N_EXPERTS), 0.01),
        'w1': nrm(ks[16], (L, N_EXPERTS, D_MODEL, 2 * D_FF), D_MODEL ** -0.5),
        'b1': nrm(ks[17], (L, N_EXPERTS, 2 * D_FF), 0.01),
        'w2': nrm(ks[18], (L, N_EXPERTS, D_FF, D_MODEL), D_FF ** -0.5),
        'b2': nrm(ks[19], (L, N_EXPERTS, D_MODEL), 0.01),
    }


def reference(x, c, w_ada, b_ada, g_pre_mix, g_post_mix, w_in, w_pool_grp, pool_scale, w_up_pool, w_up_attn, w_out, g_pre_ffn, g_post_ffn, w_router, b_router, w1, b1, w2, b2):
    s_ = x.shape[1]
    rope_a = rope_tables(s_, ROT_DIM)
    rope_i = rope_tables(s_, IDX_ROT_DIM)
    c_act = jax.nn.silu(c)
    for layer in range(DEPTH):
        mod = (c_act @ w_ada[layer] + b_ada[layer])[:, None, :]
        sh1, sc1, gt1, sh2, sc2, gt2 = jnp.split(mod, N_MOD, axis=-1)
        h = rms_norm(x, g_pre_mix[layer]) * (1 + sc1) + sh1
        y = token_mixer(h, w_in[layer], w_pool_grp[layer], pool_scale[layer], w_up_pool[layer], w_up_attn[layer], w_out[layer], rope_a, rope_i)
        x = x + gt1 * rms_norm(y, g_post_mix[layer])
        h = rms_norm(x, g_pre_ffn[layer]) * (1 + sc2) + sh2
        y = moe_ffn(h, w_router[layer], b_router[layer], w1[layer], b1[layer], w2[layer], b2[layer])
        x = x + gt2 * rms_norm(y, g_post_ffn[layer])
    return x
```

```cpp
#include <hip/hip_runtime.h>
#include <cstdio>
#include <cstdint>
#include <cmath>

#ifndef MK_N_LAUNCHES
#define MK_N_LAUNCHES 1
#endif

#define GAS __attribute__((address_space(1)))
#define LAS __attribute__((address_space(3)))
typedef unsigned short bf16;
typedef unsigned v4u __attribute__((ext_vector_type(4)));
typedef unsigned v2u __attribute__((ext_vector_type(2)));
typedef float f32x4 __attribute__((ext_vector_type(4)));
typedef float f32x2 __attribute__((ext_vector_type(2)));
typedef short bf16x8 __attribute__((ext_vector_type(8)));
#define LDS_WAIT() asm volatile("s_waitcnt lgkmcnt(0)" ::: "memory")
#define VM_WAIT() asm volatile("s_waitcnt vmcnt(0)" ::: "memory")

constexpr int NB = 8, SEQ = 2048, D = 2048, T = NB * SEQ;
constexpr int NPROJ = 9472;
constexpr int NE = 32, TOPK = 4, DFF = 2048;
constexpr int MAXTILES = (T * TOPK) / 256 + NE;
constexpr int MAXROWS = MAXTILES * 256;
constexpr int NKEEP = 256;
constexpr float EPS = 1e-6f;
constexpr int NWAVES = 8;
#ifndef ATT_END
#define ATT_END T
#endif

constexpr size_t MiB = 1u << 20;
constexpr size_t WS_CTL = 0, CTL_ZERO_BYTES = 1 * MiB;
constexpr size_t WS_MOD = 1 * MiB;
constexpr size_t WS_WRT = 1 * MiB + 512 * 1024;
constexpr size_t WS_ROPA = 2 * MiB;
constexpr size_t WS_ROPI = 2 * MiB + 512 * 1024;
constexpr size_t WS_TOPI = 3 * MiB;
constexpr size_t WS_GATE = 3 * MiB + 256 * 1024;
constexpr size_t WS_SLOT = 3 * MiB + 512 * 1024;
constexpr size_t WS_WTPOOL = 4 * MiB;
constexpr size_t WS_WTUPP = 5 * MiB;
constexpr size_t WS_WTUPA = 9 * MiB;
constexpr size_t WS_WTOUT = 17 * MiB;
constexpr size_t WS_WTIN = 25 * MiB;
constexpr size_t WS_W1T = 64 * MiB;
constexpr size_t WS_W2T = 576 * MiB;
constexpr size_t WS_H = 832 * MiB;
constexpr size_t WS_Q = 896 * MiB;
constexpr size_t WS_K = 960 * MiB;
constexpr size_t WS_V = 976 * MiB;
constexpr size_t WS_U = 992 * MiB;
constexpr size_t WS_GL = 1024 * MiB;
constexpr size_t WS_QI = 1152 * MiB;
constexpr size_t WS_KW = 1184 * MiB;
constexpr size_t WS_MIX = 1192 * MiB;
constexpr size_t WS_YPOOL = 1224 * MiB;
constexpr size_t WS_YATTN = 1256 * MiB;
constexpr size_t WS_TMP = 1320 * MiB;
constexpr size_t WS_MERGED = 1448 * MiB;
constexpr size_t WS_Y = 1512 * MiB;
constexpr size_t WS_X1 = 1640 * MiB;
constexpr size_t WS_XS = 1768 * MiB;
constexpr size_t WS_ACT = 2056 * MiB;
constexpr size_t WS_YS = 2344 * MiB;
constexpr size_t WS_MASK = 2632 * MiB;
constexpr size_t WS_END = 2636 * MiB;
constexpr int CW_BAR = 4096;
constexpr int CW_CNT = 16384;
constexpr int CW_CUR = 20480;

constexpr int RING_BYTES = 131072;
constexpr int TOK_OFF = RING_BYTES;
constexpr int MISC_OFF = 155648;
constexpr int TILE_E_OFF = MISC_OFF + 64;
constexpr int LDS_BYTES = MISC_OFF + 4096;

__device__ __forceinline__ float bf2f(unsigned b) { return __uint_as_float(b << 16); }
__device__ __forceinline__ unsigned f2bf(float f) { unsigned u = __float_as_uint(f); return (u + 0x7fffu + ((u >> 16) & 1u)) >> 16; }
__device__ __forceinline__ unsigned pk2(float lo, float hi) { return f2bf(lo) | (f2bf(hi) << 16); }
__device__ __forceinline__ float lo16(unsigned w) { return __uint_as_float(w << 16); }
__device__ __forceinline__ float hi16(unsigned w) { return __uint_as_float(w & 0xffff0000u); }
__device__ __forceinline__ float wave_sum(float v) {
#pragma unroll
    for (int o = 1; o < 64; o <<= 1) v += __shfl_xor(v, o);
    return v;
}
__device__ __forceinline__ float wave_max(float v) {
#pragma unroll
    for (int o = 1; o < 64; o <<= 1) v = fmaxf(v, __shfl_xor(v, o));
    return v;
}
__device__ __forceinline__ int wave_min_i(int v) {
#pragma unroll
    for (int o = 1; o < 64; o <<= 1) { int t = __shfl_xor(v, o); v = t < v ? t : v; }
    return v;
}
__device__ __forceinline__ unsigned pk4_fp8(float a, float b, float c, float d) {
    int w = __builtin_amdgcn_cvt_pk_fp8_f32(a, b, 0, false); w = __builtin_amdgcn_cvt_pk_fp8_f32(c, d, w, true); return (unsigned)w; }
#ifndef GL_FP8
#define GL_FP8 1
#endif
#ifndef UPP_FP8
#define UPP_FP8 1
#endif
#ifndef UPA_FP8
#define UPA_FP8 1
#endif
#ifndef OUT_FP8
#define OUT_FP8 1
#endif
constexpr float W8_SCALE = 64.0f, ACT8_SCALE = 4.0f, YA8_SCALE = 4.0f, YS8_SCALE = 4.0f;
template <int CTRL> __device__ __forceinline__ float dppf(float v) { return __builtin_bit_cast(float, __builtin_amdgcn_update_dpp(0, __builtin_bit_cast(int, v), CTRL, 0xF, 0xF, true)); }
template <int CTRL> __device__ __forceinline__ int dppi(int v) { return __builtin_amdgcn_update_dpp(0, v, CTRL, 0xF, 0xF, true); }
__device__ __forceinline__ float row_sum16(float v) { v += dppf<0x128>(v); v += dppf<0x124>(v); v += dppf<0x122>(v); v += dppf<0x121>(v); return v; }
__device__ __forceinline__ float row_max16(float v) { v = __builtin_fmaxf(v, dppf<0x128>(v)); v = __builtin_fmaxf(v, dppf<0x124>(v)); v = __builtin_fmaxf(v, dppf<0x122>(v)); v = __builtin_fmaxf(v, dppf<0x121>(v)); return v; }
__device__ __forceinline__ int row_min16i(int v) { int t = dppi<0x128>(v); v = t < v ? t : v; t = dppi<0x124>(v); v = t < v ? t : v; t = dppi<0x122>(v); v = t < v ? t : v; t = dppi<0x121>(v); v = t < v ? t : v; return v; }
__device__ __forceinline__ float sigmoidf_(float x) { return __builtin_amdgcn_rcpf(1.0f + __builtin_amdgcn_exp2f(-1.4426950408889634f * x)); }

#define XB_TMO      128
#define XB_XCNT(j)  (256  + 64 * (j))
#define XB_XSUB(j)  (1280 + 64 * (j))
#define XB_XGEN(j)  (2304 + 64 * (j))
#define XB_TOP      3328
#define XB_TOPGEN   3392
#define XCD_BAR_WORDS 3456
#define XB_SPIN_CAP (1u << 22)

__device__ __forceinline__ unsigned xb_ld(unsigned* p)              { return __hip_atomic_load(p, __ATOMIC_RELAXED, __HIP_MEMORY_SCOPE_AGENT); }
__device__ __forceinline__ unsigned xb_add(unsigned* p, unsigned v) { return __hip_atomic_fetch_add(p, v, __ATOMIC_RELAXED, __HIP_MEMORY_SCOPE_AGENT); }
__device__ __forceinline__ unsigned xb_xcc_id() { return (unsigned)__builtin_amdgcn_s_getreg((3 << 11) | 20) & 0xFu; }
#define XB_SPIN(cond, bar) do { unsigned _sp = 0; while (cond) { __builtin_amdgcn_s_sleep(1); \
    if ((++_sp & 255u) == 0u) { if (xb_ld(&(bar)[XB_TMO])) break; if (_sp > XB_SPIN_CAP) { atomicAdd(&(bar)[XB_TMO], 1u); break; } } } } while (0)

struct XcdBarrier { unsigned* bar; unsigned x; volatile LAS unsigned* st; };

__device__ __forceinline__ XcdBarrier xcd_barrier_post(unsigned* bar, volatile LAS unsigned* st) {
    XcdBarrier b; b.bar = bar; b.x = xb_xcc_id(); b.st = st;
    if (threadIdx.x == 0) (void)xb_add(&bar[XB_XCNT(b.x)], 1u);
    return b;
}
__device__ __forceinline__ void xcd_barrier_complete(unsigned* bar, unsigned x, unsigned& nloc, unsigned& nx) {
    const unsigned G = gridDim.x * gridDim.y * gridDim.z;
    unsigned sum, cnt, mine, sp = 0u;
    for (;;) {
        sum = 0u; cnt = 0u; mine = 0u;
#pragma unroll
        for (unsigned j = 0; j < 16; ++j) { const unsigned c = xb_ld(&bar[XB_XCNT(j)]); sum += c; cnt += (c > 0u) ? 1u : 0u; mine = (j == x) ? c : mine; }
        if (sum == G) break;
        __builtin_amdgcn_s_sleep(1);
        if ((++sp & 255u) == 0u) { if (xb_ld(&bar[XB_TMO])) break; if (sp > XB_SPIN_CAP) { atomicAdd(&bar[XB_TMO], 1u); break; } }
    }
    nloc = mine > 0u ? mine : 1u; nx = cnt > 0u ? cnt : 1u;
}
__device__ __forceinline__ void xcd_barrier(const XcdBarrier& b) {
    asm volatile("s_waitcnt vmcnt(0)" ::: "memory");
    __syncthreads();
    if (threadIdx.x == 0) {
        unsigned* bar = b.bar;
        __builtin_amdgcn_s_waitcnt(0);
        unsigned nloc = b.st[0], nx = b.st[1];
        if (nloc == 0u) { xcd_barrier_complete(bar, b.x, nloc, nx); b.st[0] = nloc; b.st[1] = nx; }
        const unsigned old = xb_add(&bar[XB_XSUB(b.x)], 1u);
        const unsigned gen = old / nloc;
        if (old + 1u == (gen + 1u) * nloc) {
            __builtin_amdgcn_fence(__ATOMIC_RELEASE, "agent");
            asm volatile("s_waitcnt vmcnt(0)" ::: "memory");
            const unsigned og = xb_add(&bar[XB_TOP], 1u);
            const unsigned tg = og / nx;
            if (og + 1u == (tg + 1u) * nx) xb_add(&bar[XB_TOPGEN], 1u);
            else XB_SPIN(xb_ld(&bar[XB_TOPGEN]) == tg, bar);
            __builtin_amdgcn_fence(__ATOMIC_ACQUIRE, "agent");
            xb_add(&bar[XB_XGEN(b.x)], 1u);
            asm volatile("s_waitcnt vmcnt(0)" ::: "memory");
        } else {
            XB_SPIN(xb_ld(&bar[XB_XGEN(b.x)]) == gen, bar);
            __builtin_amdgcn_fence(__ATOMIC_ACQUIRE, "agent");
            asm volatile("s_waitcnt vmcnt(0)" ::: "memory");
        }
    }
    __syncthreads();
}

namespace pg8 {
constexpr int BM = 256, BK = 64, HALF = 128, HTB = HALF * BK * 2, STAGE_BYTES = 8 * HTB, NXCD = 8, WGM = 8;
__host__ __device__ __forceinline__ int lds_byte(int r, int c) { const int st = (r >> 4) * 2 + (c >> 5), rr = r & 15, cc = c & 31, ob = rr * 64 + cc * 2; return st * 1024 + (ob ^ (((ob >> 9) & 1) << 5)); }
__host__ __device__ __forceinline__ void stage_rc(int b, int& R, int& C) { const int st = b / 1024, sb = b % 1024, swz = sb ^ (((sb >> 9) & 1) << 5); R = (st >> 1) * 16 + swz / 64; C = (st & 1) * 32 + (swz % 64) / 2; }
__host__ __device__ __forceinline__ int perm32(int rho) { const int n = rho >> 4, i = rho & 15; return 8 * (i >> 2) + 4 * n + (i & 3); }
struct Unit { int pm, pn, half, roff, sub; };
struct Gemm { int Kb, lda, ldb; };

__device__ __forceinline__ void order_map(int L, int nM, int nN, Unit& u) {
    const int nwg = nM * nN;
    int wgid = L; { const int q = nwg / NXCD, r = nwg % NXCD, xcd = wgid % NXCD, off = wgid / NXCD; wgid = (xcd < r ? xcd * (q + 1) : r * (q + 1) + (xcd - r) * q) + off; }
    const int nig = WGM * nN, gid = wgid / nig, fm = gid * WGM, gsz = (nM - fm) < WGM ? (nM - fm) : WGM;
    u.pm = fm + ((wgid % nig) % gsz); u.pn = (wgid % nig) / gsz; u.half = 0; u.roff = 0; u.sub = 0;
}
__device__ __forceinline__ bool order_next(int i, int G, int c, int nM, int nN, Unit& u) {
    const int nwg = nM * nN; const long L = (long)i * G + c; if (L >= nwg) return false;
    order_map((int)L, nM, nN, u); return true;
}
__device__ __forceinline__ unsigned cvt_pk_bf16(float lo, float hi) { unsigned r; asm volatile("v_cvt_pk_bf16_f32 %0, %1, %2" : "=v"(r) : "v"(lo), "v"(hi)); return r; }

typedef int v4i_t __attribute__((ext_vector_type(4)));
typedef int v8i_t __attribute__((ext_vector_type(8)));
template <class Epi, class Sched, bool FP8 = false, bool GATHER = false>
__device__ __forceinline__ void gemm_phase(LAS unsigned char* lds, const Gemm g, const Sched& S, const Epi& E) {
    const int tid = threadIdx.x, wid = __builtin_amdgcn_readfirstlane(tid >> 6), lane = tid & 63, wr = wid >> 2, wc = wid & 3, fr = lane & 15, fq = lane >> 4;
    const int nt0 = g.Kb / 128;
    unsigned vA0[2], vA1[2], nA0[2], nA1[2], voffB[2]; int RA[2], CA[2];
#pragma unroll
    for (int i = 0; i < 2; ++i) { int R, C; stage_rc(tid * 16 + i * 8192, R, C); const int Rb = Epi::PERM ? ((R & ~31) + perm32(R & 31)) : R;
        RA[i] = R; CA[i] = C * 2; voffB[i] = (unsigned)(Rb * g.ldb + C * 2);
        if constexpr (GATHER) { vA0[i] = (unsigned)(S.tok(0, R) * g.lda + C * 2); vA1[i] = (unsigned)(S.tok(0, HALF + R) * g.lda + C * 2); }
        else { vA0[i] = (unsigned)(R * g.lda + C * 2); vA1[i] = (unsigned)((HALF + R) * g.lda + C * 2); }
        nA0[i] = vA0[i]; nA1[i] = vA1[i]; }
    const size_t kstep = (size_t)(BK * 2);
    const size_t hstepB = (size_t)HALF * g.ldb;
    const unsigned ldsw = (unsigned)wid * 1024u;
    const int aoff = lds_byte(wr * 64 + fr, fq * 8), boff = lds_byte(wc * 32 + fr, fq * 8);
#define PG8_SA(b, h) (((b) * 2 + (h)) * HTB)
#define PG8_SB(b, h) ((4 + (b) * 2 + (h)) * HTB)
#define PG8_STAGE(bufoff, gbase, voff) do { _Pragma("unroll") for (int _i = 0; _i < 2; ++_i) \
        __builtin_amdgcn_global_load_lds((const unsigned*)((const char*)(gbase) + (voff)[_i]), (LAS unsigned*)(lds + (bufoff) + ldsw + _i * 8192), 16, 0, 0); } while (0)
#define PG8_LD8(p) __builtin_shufflevector(*(const LAS v4i_t*)(p), *(const LAS v4i_t*)((p) + 1024), 0, 1, 2, 3, 4, 5, 6, 7)
#define PG8_LDA(dst, b, h) do { _Pragma("unroll") for (int m = 0; m < 4; ++m) { if constexpr (FP8) dst##8[m] = PG8_LD8(lds + PG8_SA(b, h) + aoff + m * 2048); else { _Pragma("unroll") for (int k = 0; k < 2; ++k) dst[m][k] = *(const LAS bf16x8*)(lds + PG8_SA(b, h) + aoff + m * 2048 + k * 1024); } } } while (0)
#define PG8_LDB(dst, b, h) do { _Pragma("unroll") for (int n = 0; n < 2; ++n) { if constexpr (FP8) dst##8[n] = PG8_LD8(lds + PG8_SB(b, h) + boff + n * 2048); else { _Pragma("unroll") for (int k = 0; k < 2; ++k) dst[n][k] = *(const LAS bf16x8*)(lds + PG8_SB(b, h) + boff + n * 2048 + k * 1024); } } } while (0)
#define PG8_MMA(ai, bj, At, Bt) do { __builtin_amdgcn_s_setprio(1); _Pragma("unroll") for (int m = 0; m < 4; ++m) _Pragma("unroll") for (int n = 0; n < 2; ++n) { \
        if constexpr (FP8) asm volatile("v_mfma_f32_16x16x128_f8f6f4 %0, %1, %2, %0" : "+v"(acc[ai][bj][m][n]) : "v"(Bt##8[n]), "v"(At##8[m])); \
        else { _Pragma("unroll") for (int k = 0; k < 2; ++k) acc[ai][bj][m][n] = __builtin_amdgcn_mfma_f32_16x16x32_bf16(Bt[n][k], At[m][k], acc[ai][bj][m][n], 0, 0, 0); } } \
        __builtin_amdgcn_s_setprio(0); } while (0)
#define PG8_WAIT_V(n) asm volatile("s_waitcnt vmcnt(" #n ")" ::: "memory")
#define PG8_WAIT_L(n) asm volatile("s_waitcnt lgkmcnt(" #n ")" ::: "memory")
#define PG8_BAR __builtin_amdgcn_s_barrier()
#define PG8_SCHED __builtin_amdgcn_sched_barrier(0)
    Unit cur, nxt; int ui = 0;
    if (!S.next(0, cur)) return;
    f32x4 acc[2][2][4][2];
#pragma unroll
    for (int a = 0; a < 2; ++a)
#pragma unroll
        for (int b = 0; b < 2; ++b)
#pragma unroll
            for (int m = 0; m < 4; ++m)
#pragma unroll
                for (int n = 0; n < 2; ++n) acc[a][b][m][n] = (f32x4){0.f, 0.f, 0.f, 0.f};
    const int one_scale = 0x7f7f7f7f;
    bf16x8 At[4][2], B0[2][2], B1[2][2]; v8i_t At8[4], B08[2], B18[2];
    const char* cA = S.a_ptr(cur); const char* cB = S.b_ptr(cur);
    PG8_STAGE(PG8_SB(0, 0), cB, voffB); PG8_STAGE(PG8_SB(0, 1), cB + hstepB, voffB); PG8_STAGE(PG8_SA(0, 0), cA, vA0); PG8_STAGE(PG8_SA(0, 1), cA, vA1);
    if (wr == 1) PG8_BAR;
    PG8_WAIT_V(2); PG8_BAR;
    PG8_STAGE(PG8_SB(1, 0), cB + kstep, voffB); PG8_STAGE(PG8_SA(1, 0), cA + kstep, vA0); PG8_STAGE(PG8_SB(1, 1), cB + hstepB + kstep, voffB);
    PG8_WAIT_V(6); PG8_BAR;
    for (;;) {
        const bool has_next = S.next(ui + 1, nxt); const bool hf = __builtin_amdgcn_readfirstlane(cur.half) != 0;
        const char* nA = has_next ? S.a_ptr(nxt) : cA; const char* nB = has_next ? S.b_ptr(nxt) : cB;
        int nt = nt0; if constexpr (Epi::FUSED) nt = S.nt(ui);
        if constexpr (GATHER) { if (has_next) {
#pragma unroll
            for (int i = 0; i < 2; ++i) { nA0[i] = (unsigned)(S.tok(ui + 1, RA[i]) * g.lda + CA[i]); nA1[i] = (unsigned)(S.tok(ui + 1, HALF + RA[i]) * g.lda + CA[i]); } } }
#pragma unroll 1
        for (int t = 0; t < nt; t += 2) {
            const bool last = (t == nt - 2);
            const char* a1 = cA + (size_t)(t + 1) * kstep;
            const char* a2 = last ? nA : cA + (size_t)(t + 2) * kstep; const char* b2 = last ? nB : cB + (size_t)(t + 2) * kstep;
            const char* a3 = a2 + kstep; const char* b3 = b2 + kstep;
            unsigned sA0[2], sA1[2];
#pragma unroll
            for (int i = 0; i < 2; ++i) { sA0[i] = (GATHER && last) ? nA0[i] : vA0[i]; sA1[i] = (GATHER && last) ? nA1[i] : vA1[i]; }
            PG8_LDB(B0, 0, 0); PG8_LDB(B1, 0, 1); PG8_SCHED; PG8_LDA(At, 0, 0); PG8_STAGE(PG8_SA(1, 1), a1, vA1);
            PG8_WAIT_V(8); PG8_WAIT_L(0); PG8_BAR; PG8_MMA(0, 0, At, B0); PG8_MMA(0, 1, At, B1); PG8_BAR; PG8_SCHED;
            if (!hf) { PG8_LDA(At, 0, 1); } PG8_STAGE(PG8_SB(0, 0), b2, voffB); PG8_STAGE(PG8_SB(0, 1), b2 + hstepB, voffB); PG8_STAGE(PG8_SA(0, 0), a2, sA0);
            PG8_WAIT_V(8); PG8_WAIT_L(0); PG8_BAR; if (!hf) { PG8_MMA(1, 0, At, B0); PG8_MMA(1, 1, At, B1); } PG8_BAR; PG8_SCHED;
            PG8_LDB(B0, 1, 0); PG8_LDB(B1, 1, 1); PG8_SCHED; PG8_LDA(At, 1, 0); PG8_STAGE(PG8_SA(0, 1), a2, sA1);
            PG8_WAIT_V(8); PG8_WAIT_L(0); PG8_BAR; PG8_MMA(0, 0, At, B0); PG8_MMA(0, 1, At, B1); PG8_BAR; PG8_SCHED;
            if (!hf) { PG8_LDA(At, 1, 1); } PG8_STAGE(PG8_SB(1, 0), b3, voffB); PG8_STAGE(PG8_SB(1, 1), b3 + hstepB, voffB); PG8_STAGE(PG8_SA(1, 0), a3, sA0);
            PG8_WAIT_V(8); PG8_WAIT_L(0); PG8_BAR; if (!hf) { PG8_MMA(1, 0, At, B0); PG8_MMA(1, 1, At, B1); } PG8_BAR; PG8_SCHED;
        }
        if (wr == 0) PG8_BAR;
        if constexpr (FP8) asm volatile("s_nop 15\n\ts_nop 15" ::: "memory");
        bool keep = false;
        if constexpr (Epi::FUSED) { if ((ui & 1) == 0) { E.mid(acc, cur, wr, wc, fr, fq); keep = true; } else E(acc, cur, wr, wc, fr, fq); }
        else E(acc, cur, wr, wc, fr, fq);
        if (!has_next) break;
        if (!keep)
#pragma unroll
        for (int a = 0; a < 2; ++a)
#pragma unroll
            for (int b = 0; b < 2; ++b)
#pragma unroll
                for (int m = 0; m < 4; ++m)
#pragma unroll
                    for (int n = 0; n < 2; ++n) acc[a][b][m][n] = (f32x4){0.f, 0.f, 0.f, 0.f};
        cur = nxt; cA = nA; cB = nB; ++ui;
#pragma unroll
        for (int i = 0; i < 2; ++i) { vA0[i] = nA0[i]; vA1[i] = nA1[i]; }
        if (wr == 1) PG8_BAR;
    }
    PG8_WAIT_V(0);
    PG8_BAR;
#undef PG8_SA
#undef PG8_SB
#undef PG8_STAGE
#undef PG8_LDA
#undef PG8_LDB
#undef PG8_MMA
#undef PG8_LD8
#undef PG8_WAIT_V
#undef PG8_WAIT_L
#undef PG8_BAR
#undef PG8_SCHED
}
}
using pg8::Unit; using pg8::cvt_pk_bf16;

struct DenseOrder {
    int nM, nN, G, c; const char* A; const char* Bt; size_t astep, astepn, bstep;
    __device__ __forceinline__ bool next(int i, Unit& u) const { return pg8::order_next(i, G, c, nM, nN, u); }
    __device__ __forceinline__ const char* a_ptr(const Unit& u) const { return A + (size_t)u.pm * astep + (size_t)u.pn * astepn; }
    __device__ __forceinline__ const char* b_ptr(const Unit& u) const { return Bt + (size_t)u.pn * bstep; }
};
template <int PART> struct ProjOrder {
    int nM, G, c; const char* A; const char* Bt; size_t astep, bstep;
    __device__ __forceinline__ bool next(int i, Unit& u) const {
        if (PART == 0) { if (!pg8::order_next(i, G, c, nM, 9, u)) return false; }
        else {
            const int nwg = nM * 28, extra = (nM * 9) % G, full = nwg / G - 1; int L;
            if (i < full) L = i * G + c; else { if (c < extra) return false; L = full * G + (i - full) * (G - extra) + (c - extra); if (L >= nwg) return false; }
            pg8::order_map(L, nM, 28, u); }
        const int j = u.pn; u.pn = PART ? (j < 12 ? j : j + 4) : (j < 4 ? 12 + j : j < 8 ? 28 + j : 36); return true; }
    __device__ __forceinline__ const char* a_ptr(const Unit& u) const { return A + (size_t)u.pm * astep; }
    __device__ __forceinline__ const char* b_ptr(const Unit& u) const { return Bt + (size_t)(PART ? (u.pn < 12 ? u.pn : u.pn - 4) : u.pn) * bstep; }
};
struct MoeOrder {
    int nM, nN, G, c; const char* A; const char* Bt; size_t astep, bstep_e, bstep; const LAS int* tile_e; const LAS int* tokL; const LAS int* tile_rows; int split;
    __device__ __forceinline__ bool next(int i, Unit& u) const {
        const int nwg = nM * nN, nfull = split ? (nwg / G) * G : nwg, L = i * G + c;
        if (L < nfull) { pg8::order_map(L, nM, nN, u); u.half = tile_rows[u.pm] <= 128 ? 1 : 0; return true; }
        const int rem = nwg - nfull, idx = L - nfull;
        if (2 * rem <= G) { if (idx >= 2 * rem) return false; pg8::order_map(nfull + (idx >> 1), nM, nN, u); u.half = 1; u.roff = (idx & 1) * 128; return true; }
        if (L >= nwg) return false;
        pg8::order_map(L, nM, nN, u); u.half = tile_rows[u.pm] <= 128 ? 1 : 0; return true; }
    __device__ __forceinline__ const char* a_ptr(const Unit& u) const { return A + (size_t)u.pm * astep + (size_t)u.roff * (astep >> 8); }
    __device__ __forceinline__ const char* b_ptr(const Unit& u) const { return Bt + (size_t)tile_e[u.pm] * bstep_e + (size_t)u.pn * bstep; }
    __device__ __forceinline__ int tok(int ui, int r) const { return tokL[ui * 256 + r]; }
};

struct EpiProj {
    static constexpr bool PERM = true; static constexpr bool FUSED = false;
    bf16 *Q, *K, *V, *U, *GL, *QI, *KW; const float* ropa; const float* ropi; float oscale;
    __device__ __forceinline__ void operator()(const f32x4 (&acc)[2][2][4][2], const Unit& u, int wr, int wc, int fr, int fq) const {
        const int pn = u.pn; bf16* base; int ldc, c0, mode = 0;
        if (pn < 8) { base = Q; ldc = 2048; c0 = pn * 256; mode = 1; }
        else if (pn < 10) { base = K; ldc = 512; c0 = (pn - 8) * 256; mode = 1; }
        else if (pn < 12) { base = V; ldc = 512; c0 = (pn - 10) * 256; }
        else if (pn < 16) { base = U; ldc = 1024; c0 = (pn - 12) * 256; }
        else if (pn < 32) { base = GL; ldc = 4096; c0 = (pn - 16) * 256; }
        else if (pn < 36) { base = QI; ldc = 1024; c0 = (pn - 32) * 256; mode = 2; }
        else { base = KW; ldc = 256; c0 = 0; mode = 3; }
        const int row0 = u.pm * 256 + wr * 64 + fr, col0 = c0 + wc * 32 + 8 * fq;
        const bool ropeA = (mode == 1) && (wc == 0);
        const bool ropeI = ((mode == 2) && ((wc & 1) == 0)) || ((mode == 3) && (wc == 0));
        const bool wsc = (mode == 3) && (wc == 2) && (fq < 2);
        const bool anyrope = ropeA || ropeI; const float* tab = ropeA ? ropa + 8 * (fq & 1) : ropi; const int tstride = ropeA ? 32 : 16, soff = ropeA ? 16 : 8;
        f32x4 tc[4];
        if (anyrope) { const float* cs = tab + (row0 & (SEQ - 1)) * tstride; tc[0] = *(const f32x4*)cs; tc[1] = *(const f32x4*)(cs + 4); tc[2] = *(const f32x4*)(cs + soff); tc[3] = *(const f32x4*)(cs + soff + 4); }
#pragma unroll
        for (int it = 0; it < 8; ++it) { const int ai = it >> 2, m = it & 3; const int row = row0 + ai * 128 + m * 16; bf16* rowp = base + (size_t)row * ldc + col0;
            v4u w[2];
#pragma unroll
            for (int bj = 0; bj < 2; ++bj) { f32x4 v0 = acc[ai][bj][m][0] * oscale, v1 = acc[ai][bj][m][1] * oscale;
                if (ropeA) {
                    const float sg = (fq < 2) ? -1.f : 1.f;
                    const f32x4 c0v = tc[0], c1v = tc[1], s0v = tc[2] * sg, s1v = tc[3] * sg;
                    f32x4 p0, p1;
#pragma unroll
                    for (int j = 0; j < 4; ++j) { p0[j] = __shfl_xor(v0[j], 32); p1[j] = __shfl_xor(v1[j], 32); }
                    v0 = v0 * c0v + p0 * s0v; v1 = v1 * c1v + p1 * s1v;
                } else if (ropeI && (mode == 2 || bj == 0)) {
                    const float sg = (fq == 0) ? -1.f : 1.f;
                    const f32x4 c0v = tc[0], c1v = tc[1], s0v = tc[2] * sg, s1v = tc[3] * sg;
                    f32x4 p0, p1;
#pragma unroll
                    for (int j = 0; j < 4; ++j) { p0[j] = __shfl_xor(v0[j], 16); p1[j] = __shfl_xor(v1[j], 16); }
                    if (fq < 2) { v0 = v0 * c0v + p0 * s0v; v1 = v1 * c1v + p1 * s1v; }
                } else if (wsc && bj == 0) { v0 = v0 * 0.03125f; v1 = v1 * 0.03125f; }
                w[bj].x = cvt_pk_bf16(v0[0], v0[1]); w[bj].y = cvt_pk_bf16(v0[2], v0[3]); w[bj].z = cvt_pk_bf16(v1[0], v1[1]); w[bj].w = cvt_pk_bf16(v1[2], v1[3]); }
            asm volatile("" ::: "memory");
            if (anyrope && it < 7) { const int rown = row0 + ((it + 1) >> 2) * 128 + ((it + 1) & 3) * 16; const float* cs = tab + (rown & (SEQ - 1)) * tstride;
                tc[0] = *(const f32x4*)cs; tc[1] = *(const f32x4*)(cs + 4); tc[2] = *(const f32x4*)(cs + soff); tc[3] = *(const f32x4*)(cs + soff + 4); }
            asm volatile("" ::: "memory");
            *(v4u*)rowp = w[0]; *(v4u*)(rowp + 128) = w[1];
            asm volatile("" ::: "memory"); }
    }
};
struct EpiPool {
    static constexpr bool PERM = true; static constexpr bool FUSED = false;
    bf16* O; const float* scale;
    __device__ __forceinline__ void operator()(const f32x4 (&acc)[2][2][4][2], const Unit& u, int wr, int wc, int fr, int fq) const {
        const int row0 = u.pm * 256 + wr * 64 + fr, col0 = u.pn * 256 + wc * 32 + 8 * fq;
#pragma unroll
        for (int bj = 0; bj < 2; ++bj) {
            const f32x4 s0 = *(const f32x4*)(scale + col0 + bj * 128), s1 = *(const f32x4*)(scale + col0 + bj * 128 + 4);
#pragma unroll
            for (int ai = 0; ai < 2; ++ai)
#pragma unroll
                for (int m = 0; m < 4; ++m) { const size_t off = (size_t)(row0 + ai * 128 + m * 16) * 1024 + col0 + bj * 128;
                    const f32x4 v0 = acc[ai][bj][m][0] * s0, v1 = acc[ai][bj][m][1] * s1;
#if UPP_FP8
                    v2u w; w.x = pk4_fp8(v0[0], v0[1], v0[2], v0[3]); w.y = pk4_fp8(v1[0], v1[1], v1[2], v1[3]);
                    *(v2u*)((unsigned char*)O + off) = w;
#else
                    v4u w; w.x = cvt_pk_bf16(v0[0], v0[1]); w.y = cvt_pk_bf16(v0[2], v0[3]); w.z = cvt_pk_bf16(v1[0], v1[1]); w.w = cvt_pk_bf16(v1[2], v1[3]);
                    *(v4u*)(O + off) = w;
#endif
                }
            asm volatile("" ::: "memory"); }
    }
};
template <int MODE> struct EpiUp {
    static constexpr bool PERM = true; static constexpr bool FUSED = false;
    float* TMP; bf16* MERGED; const bf16* GL;
    __device__ __forceinline__ void operator()(const f32x4 (&acc)[2][2][4][2], const Unit& u, int wr, int wc, int fr, int fq) const {
        const int row0 = u.pm * 256 + wr * 64 + fr, col0 = u.pn * 256 + wc * 32 + 8 * fq;
        constexpr float IS = MODE ? (UPA_FP8 ? 1.0f / (W8_SCALE * YA8_SCALE) : 1.0f) : (UPP_FP8 ? 1.0f / W8_SCALE : 1.0f), RIS = 1.0f / IS;
        v4u gwn[2], twn[2];
#pragma unroll
        for (int bj = 0; bj < 2; ++bj) { const size_t row = (size_t)row0; const int col = col0 + bj * 128;
            gwn[bj] = *(const v4u*)(GL + row * 4096 + (MODE ? 2048 : 0) + col); if (MODE) twn[bj] = *(const v4u*)((const bf16*)TMP + row * 2048 + col); }
#pragma unroll
        for (int it = 0; it < 8; ++it) { const int ai = it >> 2, m = it & 3; const size_t row = (size_t)(row0 + ai * 128 + m * 16);
            v4u gwc[2] = {gwn[0], gwn[1]}, twc[2]; if (MODE) { twc[0] = twn[0]; twc[1] = twn[1]; }
            if (it < 7) { const size_t rown = (size_t)(row0 + ((it + 1) >> 2) * 128 + ((it + 1) & 3) * 16);
#pragma unroll
                for (int bj = 0; bj < 2; ++bj) { const int col = col0 + bj * 128;
                    gwn[bj] = *(const v4u*)(GL + rown * 4096 + (MODE ? 2048 : 0) + col); if (MODE) twn[bj] = *(const v4u*)((const bf16*)TMP + rown * 2048 + col); } }
            asm volatile("" ::: "memory");
#pragma unroll
            for (int bj = 0; bj < 2; ++bj) { const int col = col0 + bj * 128;
                const unsigned gwv[4] = {gwc[bj].x, gwc[bj].y, gwc[bj].z, gwc[bj].w}; f32x2 gs[4];
#pragma unroll
                for (int q = 0; q < 4; ++q) { const f32x2 ea = (f32x2){lo16(gwv[q]), hi16(gwv[q])} * (f32x2){-1.4426950408889634f, -1.4426950408889634f};
                    const f32x2 den = (f32x2){__builtin_amdgcn_exp2f(ea.x), __builtin_amdgcn_exp2f(ea.y)} * (f32x2){RIS, RIS} + (f32x2){RIS, RIS};
                    gs[q] = (f32x2){__builtin_amdgcn_rcpf(den.x), __builtin_amdgcn_rcpf(den.y)}; }
                const f32x4 a0 = acc[ai][bj][m][0], a1 = acc[ai][bj][m][1];
                f32x2 p[4] = {(f32x2){a0[0], a0[1]} * gs[0], (f32x2){a0[2], a0[3]} * gs[1], (f32x2){a1[0], a1[1]} * gs[2], (f32x2){a1[2], a1[3]} * gs[3]};
                if (MODE == 0) { v4u w; w.x = cvt_pk_bf16(p[0].x, p[0].y); w.y = cvt_pk_bf16(p[1].x, p[1].y); w.z = cvt_pk_bf16(p[2].x, p[2].y); w.w = cvt_pk_bf16(p[3].x, p[3].y); *(v4u*)((bf16*)TMP + row * 2048 + col) = w; }
                else { const v4u tw = twc[bj]; p[0] += (f32x2){lo16(tw.x), hi16(tw.x)}; p[1] += (f32x2){lo16(tw.y), hi16(tw.y)}; p[2] += (f32x2){lo16(tw.z), hi16(tw.z)}; p[3] += (f32x2){lo16(tw.w), hi16(tw.w)};
#if OUT_FP8
                    v2u w; w.x = pk4_fp8(p[0].x, p[0].y, p[1].x, p[1].y); w.y = pk4_fp8(p[2].x, p[2].y, p[3].x, p[3].y);
                    *(v2u*)((unsigned char*)MERGED + row * 2048 + col) = w; }
#else
                    v4u w; w.x = cvt_pk_bf16(p[0].x, p[0].y); w.y = cvt_pk_bf16(p[1].x, p[1].y); w.z = cvt_pk_bf16(p[2].x, p[2].y); w.w = cvt_pk_bf16(p[3].x, p[3].y);
                    *(v4u*)(MERGED + row * 2048 + col) = w; }
#endif
            }
            asm volatile("" ::: "memory"); }
    }
};
struct UpOrder {
    int nM, nN, G, c; const char* A0; const char* A1; const char* B0; const char* B1;
    __device__ __forceinline__ bool next(int i, Unit& u) const { if (!pg8::order_next(i >> 1, G, c, nM, nN, u)) return false; u.sub = i & 1; return true; }
    __device__ __forceinline__ const char* a_ptr(const Unit& u) const { return u.sub ? A1 + (size_t)u.pm * (256 * 2048) : A0 + (size_t)u.pm * (256 * 1024); }
    __device__ __forceinline__ const char* b_ptr(const Unit& u) const { return (u.sub ? B1 : B0) + (size_t)u.pn * (256 * 2048); }
    __device__ __forceinline__ int tok(int ui, int r) const { return (ui & 1) ? 2 * r : r; }
    __device__ __forceinline__ int nt(int ui) const { return (ui & 1) ? 16 : 8; }
};
struct EpiUpF {
    static constexpr bool PERM = true; static constexpr bool FUSED = true;
    bf16* MERGED; const bf16* GL;
    __device__ __forceinline__ void mid(f32x4 (&acc)[2][2][4][2], const Unit& u, int wr, int wc, int fr, int fq) const {
        const int row0 = u.pm * 256 + wr * 64 + fr, col0 = u.pn * 256 + wc * 32 + 8 * fq;
        constexpr float RS = (1.0f / W8_SCALE) / (1.0f / (W8_SCALE * YA8_SCALE));
        v4u an[2], bn[2];
#pragma unroll
        for (int bj = 0; bj < 2; ++bj) { const bf16* gp = GL + (size_t)row0 * 4096 + col0 + bj * 128; an[bj] = *(const v4u*)gp; bn[bj] = *(const v4u*)(gp + 2048); }
#pragma unroll
        for (int it = 0; it < 8; ++it) { const int ai = it >> 2, m = it & 3;
            v4u ac[2] = {an[0], an[1]}, bc[2] = {bn[0], bn[1]};
            if (it < 7) { const size_t rown = (size_t)(row0 + ((it + 1) >> 2) * 128 + ((it + 1) & 3) * 16);
#pragma unroll
                for (int bj = 0; bj < 2; ++bj) { const bf16* gp = GL + rown * 4096 + col0 + bj * 128; an[bj] = *(const v4u*)gp; bn[bj] = *(const v4u*)(gp + 2048); } }
            asm volatile("" ::: "memory");
#pragma unroll
            for (int bj = 0; bj < 2; ++bj) { const unsigned av[4] = {ac[bj].x, ac[bj].y, ac[bj].z, ac[bj].w}, bv[4] = {bc[bj].x, bc[bj].y, bc[bj].z, bc[bj].w};
#pragma unroll
                for (int q = 0; q < 4; ++q) { const f32x2 ea = (f32x2){lo16(av[q]), hi16(av[q])} * (f32x2){-1.4426950408889634f, -1.4426950408889634f}, eb = (f32x2){lo16(bv[q]), hi16(bv[q])} * (f32x2){-1.4426950408889634f, -1.4426950408889634f};
                    const f32x2 da = (f32x2){__builtin_amdgcn_exp2f(ea.x), __builtin_amdgcn_exp2f(ea.y)} + (f32x2){1.0f, 1.0f};
                    const f32x2 db = (f32x2){__builtin_amdgcn_exp2f(eb.x), __builtin_amdgcn_exp2f(eb.y)} * (f32x2){RS, RS} + (f32x2){RS, RS};
                    const f32x2 r = db * (f32x2){__builtin_amdgcn_rcpf(da.x), __builtin_amdgcn_rcpf(da.y)};
                    f32x4& t = acc[ai][bj][m][q >> 1];
                    if (q & 1) { t[2] *= r.x; t[3] *= r.y; } else { t[0] *= r.x; t[1] *= r.y; } } }
            asm volatile("" ::: "memory"); }
    }
    __device__ __forceinline__ void operator()(const f32x4 (&acc)[2][2][4][2], const Unit& u, int wr, int wc, int fr, int fq) const {
        const int row0 = u.pm * 256 + wr * 64 + fr, col0 = u.pn * 256 + wc * 32 + 8 * fq;
        constexpr float RIS = W8_SCALE * YA8_SCALE;
        v4u bn[2];
#pragma unroll
        for (int bj = 0; bj < 2; ++bj) bn[bj] = *(const v4u*)(GL + (size_t)row0 * 4096 + 2048 + col0 + bj * 128);
#pragma unroll
        for (int it = 0; it < 8; ++it) { const int ai = it >> 2, m = it & 3; const size_t row = (size_t)(row0 + ai * 128 + m * 16);
            v4u bc[2] = {bn[0], bn[1]};
            if (it < 7) { const size_t rown = (size_t)(row0 + ((it + 1) >> 2) * 128 + ((it + 1) & 3) * 16);
#pragma unroll
                for (int bj = 0; bj < 2; ++bj) bn[bj] = *(const v4u*)(GL + rown * 4096 + 2048 + col0 + bj * 128); }
            asm volatile("" ::: "memory");
#pragma unroll
            for (int bj = 0; bj < 2; ++bj) { const int col = col0 + bj * 128; const unsigned bv[4] = {bc[bj].x, bc[bj].y, bc[bj].z, bc[bj].w}; f32x2 gs[4];
#pragma unroll
                for (int q = 0; q < 4; ++q) { const f32x2 eb = (f32x2){lo16(bv[q]), hi16(bv[q])} * (f32x2){-1.4426950408889634f, -1.4426950408889634f};
                    const f32x2 den = (f32x2){__builtin_amdgcn_exp2f(eb.x), __builtin_amdgcn_exp2f(eb.y)} * (f32x2){RIS, RIS} + (f32x2){RIS, RIS};
                    gs[q] = (f32x2){__builtin_amdgcn_rcpf(den.x), __builtin_amdgcn_rcpf(den.y)}; }
                const f32x4 a0 = acc[ai][bj][m][0], a1 = acc[ai][bj][m][1];
                const f32x2 p[4] = {(f32x2){a0[0], a0[1]} * gs[0], (f32x2){a0[2], a0[3]} * gs[1], (f32x2){a1[0], a1[1]} * gs[2], (f32x2){a1[2], a1[3]} * gs[3]};
                v2u w; w.x = pk4_fp8(p[0].x, p[0].y, p[1].x, p[1].y); w.y = pk4_fp8(p[2].x, p[2].y, p[3].x, p[3].y);
                *(v2u*)((unsigned char*)MERGED + row * 2048 + col) = w; }
            asm volatile("" ::: "memory"); }
    }
};
struct EpiY16 {
    static constexpr bool PERM = true; static constexpr bool FUSED = false;
    bf16* C;
    __device__ __forceinline__ void operator()(const f32x4 (&acc)[2][2][4][2], const Unit& u, int wr, int wc, int fr, int fq) const {
        const int row0 = u.pm * 256 + wr * 64 + fr, col0 = u.pn * 256 + wc * 32 + 8 * fq;
#pragma unroll
        for (int ai = 0; ai < 2; ++ai)
#pragma unroll
            for (int m = 0; m < 4; ++m) { bf16* rowp = C + (size_t)(row0 + ai * 128 + m * 16) * 2048 + col0;
#pragma unroll
                for (int bj = 0; bj < 2; ++bj) { constexpr float IS = OUT_FP8 ? 1.0f / W8_SCALE : 1.0f; const f32x4 v0 = acc[ai][bj][m][0] * IS, v1 = acc[ai][bj][m][1] * IS;
                    v4u w; w.x = cvt_pk_bf16(v0[0], v0[1]); w.y = cvt_pk_bf16(v0[2], v0[3]); w.z = cvt_pk_bf16(v1[0], v1[1]); w.w = cvt_pk_bf16(v1[2], v1[3]);
                    *(v4u*)(rowp + bj * 128) = w; } }
    }
};
struct EpiAct {
    static constexpr bool PERM = true; static constexpr bool FUSED = false;
    unsigned char* ACT8; const float* b1; const LAS int* tile_e;
    __device__ __forceinline__ void operator()(const f32x4 (&acc)[2][2][4][2], const Unit& u, int wr, int wc, int fr, int fq) const {
        const int e = tile_e[u.pm];
        const int row0 = u.pm * 256 + u.roff + wr * 64 + fr, col0 = u.pn * 128 + wc * 32 + 8 * fq;
        const float* bg = b1 + (size_t)e * 4096 + col0; const float* bl = bg + 2048;
        const f32x4 bg0 = *(const f32x4*)bg, bg1 = *(const f32x4*)(bg + 4), bl0 = *(const f32x4*)bl, bl1 = *(const f32x4*)(bl + 4);
        constexpr float IS = 1.0f / W8_SCALE;
#pragma unroll
        for (int ai = 0; ai < 2; ++ai) { if (ai == 1 && u.half) break;
#pragma unroll
            for (int m = 0; m < 4; ++m) { unsigned char* rowp = ACT8 + (size_t)(row0 + ai * 128 + m * 16) * 2048 + col0;
                f32x2 o[2][2];
#pragma unroll
                for (int n = 0; n < 2; ++n)
#pragma unroll
                    for (int h = 0; h < 2; ++h) { const f32x4 ga = acc[ai][0][m][n], la = acc[ai][1][m][n], bgn = n ? bg1 : bg0, bln = n ? bl1 : bl0;
                        const f32x2 gv = (f32x2){ga[2 * h], ga[2 * h + 1]} * (f32x2){IS, IS} + (f32x2){bgn[2 * h], bgn[2 * h + 1]};
                        const f32x2 lv = (f32x2){la[2 * h], la[2 * h + 1]} * (f32x2){IS, IS} + (f32x2){bln[2 * h], bln[2 * h + 1]};
                        const f32x2 gg = {__builtin_amdgcn_fmed3f(gv.x, -3.0e38f, 7.0f), __builtin_amdgcn_fmed3f(gv.y, -3.0e38f, 7.0f)};
                        const f32x2 ll = {__builtin_amdgcn_fmed3f(lv.x, -7.0f, 7.0f), __builtin_amdgcn_fmed3f(lv.y, -7.0f, 7.0f)};
                        const f32x2 ea = gg * (f32x2){-1.702f * 1.4426950408889634f, -1.702f * 1.4426950408889634f};
                        const f32x2 den = (f32x2){__builtin_amdgcn_exp2f(ea.x), __builtin_amdgcn_exp2f(ea.y)} + (f32x2){1.0f, 1.0f};
                        const f32x2 sg = {__builtin_amdgcn_rcpf(den.x), __builtin_amdgcn_rcpf(den.y)};
                        o[n][h] = (gg * sg) * (ll * (f32x2){ACT8_SCALE, ACT8_SCALE} + (f32x2){ACT8_SCALE, ACT8_SCALE}); }
                v2u w; w.x = pk4_fp8(o[0][0].x, o[0][0].y, o[0][1].x, o[0][1].y); w.y = pk4_fp8(o[1][0].x, o[1][0].y, o[1][1].x, o[1][1].y);
                *(v2u*)rowp = w; } }
    }
};
struct EpiYs {
    static constexpr bool PERM = true; static constexpr bool FUSED = false;
    unsigned char* YS8; const float* b2; const LAS int* tile_e;
    __device__ __forceinline__ void operator()(const f32x4 (&acc)[2][2][4][2], const Unit& u, int wr, int wc, int fr, int fq) const {
        const int e = tile_e[u.pm];
        const int row0 = u.pm * 256 + u.roff + wr * 64 + fr, col0 = u.pn * 256 + wc * 32 + 8 * fq;
        f32x4 bv[2][2];
#pragma unroll
        for (int bj = 0; bj < 2; ++bj)
#pragma unroll
            for (int n = 0; n < 2; ++n) bv[bj][n] = *(const f32x4*)(b2 + (size_t)e * 2048 + col0 + bj * 128 + 4 * n) * YS8_SCALE;
#pragma unroll
        for (int ai = 0; ai < 2; ++ai) { if (ai == 1 && u.half) break;
#pragma unroll
            for (int m = 0; m < 4; ++m) { unsigned char* rowp = YS8 + (size_t)(row0 + ai * 128 + m * 16) * 2048 + col0;
#pragma unroll
                for (int bj = 0; bj < 2; ++bj) { constexpr float IS = YS8_SCALE / (W8_SCALE * ACT8_SCALE); const f32x4 v0 = acc[ai][bj][m][0] * IS + bv[bj][0], v1 = acc[ai][bj][m][1] * IS + bv[bj][1];
                    v2u w; w.x = pk4_fp8(v0[0], v0[1], v0[2], v0[3]); w.y = pk4_fp8(v1[0], v1[1], v1[2], v1[3]);
                    *(v2u*)(rowp + bj * 128) = w; } } }
    }
};


typedef float f32x16 __attribute__((ext_vector_type(16)));
#define DPP_ADD(v, ctrl) v += __builtin_amdgcn_update_dpp(0, v, ctrl, 0xF, 0xF, true)
__device__ __forceinline__ void indexer_task(const bf16* QI, const bf16* KW, unsigned* MW, int b, int tp, int tmaxb, LAS unsigned char* lds, int wave, int lane_in) {
    int lane = lane_in; asm volatile("" : "+v"(lane));
    const int c = lane & 31, kg = lane >> 5;
    const int t0 = 2 * tp; const size_t rowbase = (size_t)b * SEQ;
    const int arow_q = (c >> 2) & 1, ahead = 4 * (c >> 3) + (c & 3);
    const bf16* qa = QI + (rowbase + t0 + arow_q) * 1024 + ahead * 64 + 8 * kg;
    bf16x8 af[4];
#pragma unroll
    for (int kk = 0; kk < 4; ++kk) af[kk] = *(const bf16x8*)(qa + 16 * kk);
    float wf[16];
    { const bf16* wp = KW + (rowbase + t0 + kg) * 256 + 64; const v4u w0 = *(const v4u*)wp, w1 = *(const v4u*)(wp + 8);
      wf[0] = lo16(w0.x); wf[1] = hi16(w0.x); wf[2] = lo16(w0.y); wf[3] = hi16(w0.y); wf[4] = lo16(w0.z); wf[5] = hi16(w0.z); wf[6] = lo16(w0.w); wf[7] = hi16(w0.w);
      wf[8] = lo16(w1.x); wf[9] = hi16(w1.x); wf[10] = lo16(w1.y); wf[11] = hi16(w1.y); wf[12] = lo16(w1.z); wf[13] = hi16(w1.z); wf[14] = lo16(w1.w); wf[15] = hi16(w1.w); }
    asm volatile("s_waitcnt vmcnt(0)" ::: "memory");
    const int tq = t0 + kg, maxblk = (t0 + 1) >> 5;
    const bf16* dsrc = KW + (rowbase + 64 * wave + (lane >> 3)) * 256 + (((lane & 7) ^ ((lane >> 3) & 7)) * 8);
#define IDX_DMA(ch) do { _Pragma("unroll") for (int i_ = 0; i_ < 8; ++i_) \
        __builtin_amdgcn_global_load_lds((const unsigned*)(dsrc + ((size_t)(512 * (ch)) + 8 * i_) * 256), (LAS unsigned*)(lds + ((ch) & 1) * 65536 + (64 * wave + 8 * i_) * 128), 16, 0, 0); } while (0)
    const int krd = c * 128;
    unsigned key[64];
    IDX_DMA(0);
#pragma unroll
    for (int ch = 0; ch < 4; ++ch) {
        if (512 * ch <= tmaxb) {
            if (512 * (ch + 1) <= tmaxb) { IDX_DMA(ch + 1); asm volatile("s_waitcnt vmcnt(8)" ::: "memory"); }
            else asm volatile("s_waitcnt vmcnt(0)" ::: "memory");
            __builtin_amdgcn_s_barrier(); asm volatile("" ::: "memory");
            const LAS unsigned char* kb_ = lds + (ch & 1) * 65536 + krd;
#pragma unroll
            for (int bi = 0; bi < 16; ++bi) { const int blk = ch * 16 + bi;
                key[blk] = 0u;
                if (blk <= maxblk) {
                    f32x16 acc = {};
#pragma unroll
                    for (int kk = 0; kk < 4; ++kk) { const bf16x8 bf = *(const LAS bf16x8*)(kb_ + bi * 4096 + (((2 * kk + kg) ^ (c & 7)) * 16));
                        acc = __builtin_amdgcn_mfma_f32_32x32x16_bf16(af[kk], bf, acc, 0, 0, 0); }
                    float sc = 0.f;
#pragma unroll
                    for (int i = 0; i < 16; ++i) sc = __builtin_fmaf(wf[i], __builtin_amdgcn_fmed3f(acc[i], 0.f, 3.0e38f), sc);
                    const unsigned u = __float_as_uint(sc); const unsigned k2 = (u >> 31) ? ~u : (u | 0x80000000u);
                    key[blk] = (blk * 32 + c <= tq) ? k2 : 0u;
                }
            }
            asm volatile("s_waitcnt lgkmcnt(0)" ::: "memory"); __builtin_amdgcn_s_barrier(); asm volatile("" ::: "memory");
        } else {
#pragma unroll
            for (int bi = 0; bi < 16; ++bi) key[ch * 16 + bi] = 0u;
        }
    }
#undef IDX_DMA
    unsigned tau = 0u; bool act = (tq + 1) > NKEEP, exact = false;
    for (int bit = 31; bit >= 0; --bit) {
        if (!__any(act)) break;
        const unsigned cand = tau | (1u << bit);
        int cnt = 0;
#pragma unroll
        for (int g4 = 0; g4 < 4; ++g4) { if (16 * g4 <= maxblk) {
#pragma unroll
            for (int bi = 0; bi < 16; bi += 4) {
                unsigned long long m0, m1, m2, m3;
                asm volatile("v_cmp_ge_u32_e64 %1, %5, %9\n\tv_cmp_ge_u32_e64 %2, %6, %9\n\tv_cmp_ge_u32_e64 %3, %7, %9\n\tv_cmp_ge_u32_e64 %4, %8, %9\n\t"
                             "v_addc_co_u32_e64 %0, %1, %0, 0, %1\n\tv_addc_co_u32_e64 %0, %2, %0, 0, %2\n\tv_addc_co_u32_e64 %0, %3, %0, 0, %3\n\tv_addc_co_u32_e64 %0, %4, %0, 0, %4"
                             : "+v"(cnt), "=&s"(m0), "=&s"(m1), "=&s"(m2), "=&s"(m3)
                             : "v"(key[16 * g4 + bi]), "v"(key[16 * g4 + bi + 1]), "v"(key[16 * g4 + bi + 2]), "v"(key[16 * g4 + bi + 3]), "v"(cand)); } } }
        DPP_ADD(cnt, 0x128); DPP_ADD(cnt, 0x124); DPP_ADD(cnt, 0x122); DPP_ADD(cnt, 0x121);
        const int r0 = __builtin_amdgcn_readlane(cnt, 0), r1 = __builtin_amdgcn_readlane(cnt, 16), r2 = __builtin_amdgcn_readlane(cnt, 32), r3 = __builtin_amdgcn_readlane(cnt, 48);
        const int tot = kg ? (r2 + r3) : (r0 + r1);
        if (act && tot >= NKEEP) tau = cand;
        if (act && tot == NKEEP) { act = false; exact = true; }
    }
    int need = 0; const bool anyt = __any(act);
    if (anyt) {
        int cnt = 0; const unsigned cand = tau + 1u;
#pragma unroll
        for (int blk = 0; blk < 64; ++blk) cnt += (key[blk] >= cand) ? 1 : 0;
        DPP_ADD(cnt, 0x128); DPP_ADD(cnt, 0x124); DPP_ADD(cnt, 0x122); DPP_ADD(cnt, 0x121);
        const int r0 = __builtin_amdgcn_readlane(cnt, 0), r1 = __builtin_amdgcn_readlane(cnt, 16), r2 = __builtin_amdgcn_readlane(cnt, 32), r3 = __builtin_amdgcn_readlane(cnt, 48);
        const int tot = kg ? (r2 + r3) : (r0 + r1);
        need = act ? NKEEP - tot : 0;
    }
    const unsigned tauX = act ? tau : (exact ? tau - 1u : 0u);
    unsigned mA = 0u, mB = 0u; int tiesb = 0;
#pragma unroll
    for (int blk = 0; blk < 64; ++blk) {
        if (blk <= maxblk) {
            bool sel = key[blk] > tauX;
            if (anyt) {
                const bool eq = act && key[blk] == tauX;
                const unsigned long long em = __ballot(eq);
                const unsigned e32 = kg ? (unsigned)(em >> 32) : (unsigned)em;
                const int rank = tiesb + __popc(e32 & ((1u << c) - 1u));
                sel = sel || (eq && rank < need);
                tiesb += __popc(e32);
            }
            const unsigned long long sm = __ballot(sel);
            if (lane == blk) { mA = (unsigned)sm; mB = (unsigned)(sm >> 32); }
        }
    }
    MW[(rowbase + t0) * 64 + lane] = mA; MW[(rowbase + t0 + 1) * 64 + lane] = mB;
}

namespace att {
constexpr int NW = 8, QBLK = 32, KVBLK = 64;
constexpr float SCALE = 0.088388347648318440f, THR = 8.f;
constexpr int LDQ = 2048, LDK = 512, LDO = 2048;
constexpr int SHM_V = KVBLK * 128 * 2, SHM_K = KVBLK * 128 * 2, SHM_ATTN = 2 * SHM_V + 2 * SHM_K + NW * 64 * 4;
typedef short s16x4 __attribute__((ext_vector_type(4)));
#define KSWZ(row, colB) ((row) * 256 + ((colB) ^ (((row) & 7) << 4)))
#define SBAR() __builtin_amdgcn_sched_barrier(0)
__device__ __forceinline__ int crow(int r, int hi) { return (r & 3) + 8 * (r >> 2) + 4 * hi; }
__device__ __forceinline__ unsigned cvtpk(float lo, float hi) { unsigned r; asm volatile("v_cvt_pk_bf16_f32 %0, %1, %2" : "=v"(r) : "v"(lo), "v"(hi)); return r; }
__device__ __forceinline__ void partialSM(f32x16& p0, f32x16& p1, float& m_reg, float& mn, float& alpha) {
  constexpr float C = SCALE * 1.4426950408889634f;
  float pmax = p0[0]; for (int r = 1; r < 16; ++r) pmax = fmaxf(pmax, p0[r]); for (int r = 0; r < 16; ++r) pmax = fmaxf(pmax, p1[r]);
  { auto rr = __builtin_amdgcn_permlane32_swap(__float_as_uint(pmax), __float_as_uint(pmax), false, false);
    pmax = fmaxf(__uint_as_float(rr[0]), __uint_as_float(rr[1])); }
  if (__builtin_expect(__all(pmax - m_reg <= THR / SCALE), 1)) { mn = m_reg; alpha = 1.f; }
  else { mn = fmaxf(m_reg, pmax); alpha = __builtin_amdgcn_exp2f((m_reg - mn) * C); m_reg = mn; }
  float mnC = -mn * C;
  for (int r = 0; r < 16; ++r) p0[r] = fmaf(p0[r], C, mnC); for (int r = 0; r < 16; ++r) p1[r] = fmaf(p1[r], C, mnC);
  for (int r = 0; r < 16; ++r) p0[r] = __builtin_amdgcn_exp2f(p0[r]);
}
__device__ __forceinline__ void finishSM(f32x16& p0, f32x16& p1, float alpha, float& l_reg, bf16x8& pa0, bf16x8& pa1, bf16x8& pa2, bf16x8& pa3) {
  for (int r = 0; r < 16; ++r) p1[r] = __builtin_amdgcn_exp2f(p1[r]);
  float ps = 0; for (int r = 0; r < 16; ++r) ps += p0[r]; for (int r = 0; r < 16; ++r) ps += p1[r];
  { auto rr = __builtin_amdgcn_permlane32_swap(__float_as_uint(ps), __float_as_uint(ps), false, false);
    ps = __uint_as_float(rr[0]) + __uint_as_float(rr[1]); }
  l_reg = l_reg * alpha + ps;
#define PK4(P, BASE, OUT) do { unsigned a0 = cvtpk(P[BASE + 0], P[BASE + 1]), a1 = cvtpk(P[BASE + 2], P[BASE + 3]);   \
    unsigned b0 = cvtpk(P[BASE + 4], P[BASE + 5]), b1 = cvtpk(P[BASE + 6], P[BASE + 7]);                              \
    auto r0 = __builtin_amdgcn_permlane32_swap(a0, b0, false, false); auto r1 = __builtin_amdgcn_permlane32_swap(a1, b1, false, false); \
    v4u w = {r0[0], r1[0], r0[1], r1[1]}; OUT = *reinterpret_cast<bf16x8*>(&w); } while (0)
  PK4(p0, 0, pa0); PK4(p0, 8, pa1); PK4(p1, 0, pa2); PK4(p1, 8, pa3);
#undef PK4
}
__device__ __forceinline__ void qkt(f32x16& p0, f32x16& p1, const char* Ks, const bf16x8* qr, int r32, int hi) {
  p0 = f32x16{}; p1 = f32x16{};
  for (int d0 = 0; d0 < 8; ++d0) { int cb = (d0 * 16 + hi * 8) * 2;
    bf16x8 b0 = *reinterpret_cast<const bf16x8*>(Ks + KSWZ(r32, cb));
    bf16x8 b1 = *reinterpret_cast<const bf16x8*>(Ks + KSWZ(32 + r32, cb));
    p0 = __builtin_amdgcn_mfma_f32_32x32x16_bf16(b0, qr[d0], p0, 0, 0, 0);
    p1 = __builtin_amdgcn_mfma_f32_32x32x16_bf16(b1, qr[d0], p1, 0, 0, 0); }
}
__device__ __forceinline__ void mask_apply(f32x16& p0, f32x16& p1, unsigned m0, unsigned m1) {
#pragma unroll
  for (int r = 0; r < 16; ++r) { const int cb = (r & 3) + 8 * (r >> 2);
    const unsigned s0 = (unsigned)(((int)(m0 << (31 - cb))) >> 31), s1 = (unsigned)(((int)(m1 << (31 - cb))) >> 31);
    p0[r] = __uint_as_float((__float_as_uint(p0[r]) & s0) | (0xFF800000u & ~s0));
    p1[r] = __uint_as_float((__float_as_uint(p1[r]) & s1) | (0xFF800000u & ~s1)); }
}
__device__ __forceinline__ int v_st(int k, int c) { const int kk = (k & ~0xC) | ((k & 4) << 1) | ((k & 8) >> 1); return ((kk >> 3) * 4 + (c >> 5)) * 512 + ((kk & 7) * 32 + (c & 31)) * 2; }
__device__ __forceinline__ int v_rd_base(int lane) { return ((lane & 3) << 3) | (((lane >> 2) & 3) << 6) | (((lane >> 4) & 1) << 5) | (((lane >> 5) & 1) << 8); }
constexpr int v_rd_off(int d0, int ks, int half) { return d0 * 512 + ks * 4096 + half * 2048; }
template <int OFF> __device__ __forceinline__ s16x4 tr_read(int vb) {
  s16x4 r; asm volatile("ds_read_b64_tr_b16 %0, %1 offset:%2" : "=&v"(r) : "v"(vb), "i"(OFF) : "memory"); return r;
}
template <int D0> __device__ __forceinline__ void pv_one(f32x16& od, int vb, bf16x8 pa0, bf16x8 pa1, bf16x8 pa2, bf16x8 pa3) {
  const s16x4 l0 = tr_read<v_rd_off(D0, 0, 0)>(vb), h0 = tr_read<v_rd_off(D0, 0, 1)>(vb), l1 = tr_read<v_rd_off(D0, 1, 0)>(vb), h1 = tr_read<v_rd_off(D0, 1, 1)>(vb);
  const s16x4 l2 = tr_read<v_rd_off(D0, 2, 0)>(vb), h2 = tr_read<v_rd_off(D0, 2, 1)>(vb), l3 = tr_read<v_rd_off(D0, 3, 0)>(vb), h3 = tr_read<v_rd_off(D0, 3, 1)>(vb);
  asm volatile("s_waitcnt lgkmcnt(0)" ::: "memory"); SBAR();
#define PK(L, H) (bf16x8){L[0], L[1], L[2], L[3], H[0], H[1], H[2], H[3]}
  od = __builtin_amdgcn_mfma_f32_32x32x16_bf16(pa0, PK(l0, h0), od, 0, 0, 0);
  od = __builtin_amdgcn_mfma_f32_32x32x16_bf16(pa1, PK(l1, h1), od, 0, 0, 0);
  od = __builtin_amdgcn_mfma_f32_32x32x16_bf16(pa2, PK(l2, h2), od, 0, 0, 0);
  od = __builtin_amdgcn_mfma_f32_32x32x16_bf16(pa3, PK(l3, h3), od, 0, 0, 0);
#undef PK
}
__device__ __forceinline__ void pv_d0(f32x16* o, int vb, bf16x8 pa0, bf16x8 pa1, bf16x8 pa2, bf16x8 pa3) {
  pv_one<0>(o[0], vb, pa0, pa1, pa2, pa3); pv_one<1>(o[1], vb, pa0, pa1, pa2, pa3); pv_one<2>(o[2], vb, pa0, pa1, pa2, pa3); pv_one<3>(o[3], vb, pa0, pa1, pa2, pa3);
}
constexpr int ATT_K0 = 0, ATT_V0 = 2 * SHM_K, ATT_WS = ATT_V0 + 3 * SHM_V, ATT_M0 = ATT_WS + NW * 64 * 4, ATT_END = ATT_M0 + 65536;
__device__ __forceinline__ void attn_masked_body(const bf16* __restrict__ Qb, const bf16* __restrict__ Kh, const bf16* __restrict__ Vh, bf16* __restrict__ Ob,
                                                 const unsigned* __restrict__ Mq, int seq, LAS unsigned char* ldsl) {
  char* lds = (char*)ldsl;
  int tid = threadIdx.x; asm volatile("" : "+v"(tid));
  const int wid = __builtin_amdgcn_readfirstlane(tid >> 6), lane = tid & 63, r32 = lane & 31, hi = lane >> 5;
  char* K_lds = lds + ATT_K0; char* V_lds = lds + ATT_V0;
  float* ws = (float*)(lds + ATT_WS) + wid * 64; float* li_l = ws; float* al_l = ws + 32;
  float m_reg = -1e30f, l_reg = 0; f32x16 o[4] = {}; bf16x8 qr[8];
  const int NT = seq / KVBLK, sh4 = 4 * hi;
  unsigned offK[2], offV[2];
#pragma unroll
  for (int q = 0; q < 2; ++q) {
      const int krow = 8 * wid + 4 * q + (lane >> 4);
      offK[q] = (unsigned)((krow * LDK + 8 * ((lane & 15) ^ (krow & 7))) * 2);
      const int kk = 8 * wid + ((lane & 31) >> 2), vk = (kk & ~0xC) | ((kk & 4) << 1) | ((kk & 8) >> 1);
      offV[q] = (unsigned)((vk * LDK + 32 * (2 * q + (lane >> 5)) + 8 * (lane & 3)) * 2);
  }
#define DMA_TILE(t, kbuf, vbuf) do { const char* kt_ = (const char*)Kh + (size_t)(t) * (KVBLK * LDK * 2); const char* vt_ = (const char*)Vh + (size_t)(t) * (KVBLK * LDK * 2); \
    _Pragma("unroll") for (int q_ = 0; q_ < 2; ++q_) { \
      __builtin_amdgcn_global_load_lds((const unsigned*)(kt_ + offK[q_]), (LAS unsigned*)(ldsl + ATT_K0 + (kbuf) * SHM_K + (2 * wid + q_) * 1024), 16, 0, 0); \
      __builtin_amdgcn_global_load_lds((const unsigned*)(vt_ + offV[q_]), (LAS unsigned*)(ldsl + ATT_V0 + (vbuf) * SHM_V + (2 * wid + q_) * 1024), 16, 0, 0); } } while (0)
#define TILE_SYNC() do { asm volatile("s_waitcnt vmcnt(0)" ::: "memory"); __builtin_amdgcn_s_barrier(); asm volatile("" ::: "memory"); } while (0)
  DMA_TILE(0, 0, 0);
  const bf16* Qw = Qb + (long)(wid * QBLK + r32) * LDQ + hi * 8;
#pragma unroll
  for (int d0 = 0; d0 < 8; ++d0) qr[d0] = *reinterpret_cast<const bf16x8*>(Qw + d0 * 16);
  char* M_lds = lds + ATT_M0;
  { v2u mw[32];
#pragma unroll
    for (int rr = 0; rr < 32; ++rr) { const int r = wid * QBLK + rr; mw[rr] = (lane < NT) ? ((const v2u*)(Mq + (size_t)r * 64))[lane] : (v2u){0u, 0u}; }
#pragma unroll
    for (int rr = 0; rr < 32; ++rr) { const int r = wid * QBLK + rr; if (lane < NT) *(v2u*)(M_lds + r * 256 + ((lane ^ rr) << 3)) = mw[rr]; } }
  const char* mrow = M_lds + (wid * QBLK + r32) * 256;
#define MLOAD(j) (*(const v2u*)(mrow + ((((j)) ^ r32) << 3)))
  const int vbase = (int)(uintptr_t)V_lds + v_rd_base(lane);
#define RESC(a) do { if (__any((a) < 1.f)) { if (hi == 0) al_l[r32] = (a); asm volatile("s_waitcnt lgkmcnt(0)" ::: "memory"); \
    for (int d = 0; d < 4; ++d) for (int r = 0; r < 16; ++r) o[d][r] *= al_l[crow(r, hi)]; } } while (0)
  f32x16 pA0, pA1, pB0, pB1; float mnA, mnB, alA, alB; bf16x8 pa0, pa1, pa2, pa3;
  TILE_SYNC();
  DMA_TILE(1, 1, 1);
  qkt(pA0, pA1, K_lds, qr, r32, hi); { const v2u mk = MLOAD(0); mask_apply(pA0, pA1, mk.x >> sh4, mk.y >> sh4); } partialSM(pA0, pA1, m_reg, mnA, alA);
  TILE_SYNC();
  int vprev = 0;
  for (int j = 1; j + 1 < NT; j += 2) {
    const int vcur = vprev == 2 ? 0 : vprev + 1, vnxt = vcur == 2 ? 0 : vcur + 1;
    DMA_TILE(j + 1, 0, vnxt);
    SBAR(); qkt(pB0, pB1, K_lds + SHM_K, qr, r32, hi);
    finishSM(pA0, pA1, alA, l_reg, pa0, pa1, pa2, pa3); SBAR();
    pv_d0(o, vbase + vprev * (int)SHM_V, pa0, pa1, pa2, pa3); { const v2u mk = MLOAD(j); mask_apply(pB0, pB1, mk.x >> sh4, mk.y >> sh4); } partialSM(pB0, pB1, m_reg, mnB, alB);
    RESC(alB); TILE_SYNC();
    DMA_TILE(j + 2, 1, vprev);
    SBAR(); qkt(pA0, pA1, K_lds, qr, r32, hi);
    finishSM(pB0, pB1, alB, l_reg, pa0, pa1, pa2, pa3); SBAR();
    pv_d0(o, vbase + vcur * (int)SHM_V, pa0, pa1, pa2, pa3); { const v2u mk = MLOAD(j + 1); mask_apply(pA0, pA1, mk.x >> sh4, mk.y >> sh4); } partialSM(pA0, pA1, m_reg, mnA, alA);
    RESC(alA); TILE_SYNC();
    vprev = vnxt;
  }
  { const int vcur = vprev == 2 ? 0 : vprev + 1;
    SBAR(); qkt(pB0, pB1, K_lds + SHM_K, qr, r32, hi);
    finishSM(pA0, pA1, alA, l_reg, pa0, pa1, pa2, pa3); SBAR();
    pv_d0(o, vbase + vprev * (int)SHM_V, pa0, pa1, pa2, pa3); { const v2u mk = MLOAD(NT - 1); mask_apply(pB0, pB1, mk.x >> sh4, mk.y >> sh4); } partialSM(pB0, pB1, m_reg, mnB, alB);
    RESC(alB);
    finishSM(pB0, pB1, alB, l_reg, pa0, pa1, pa2, pa3); SBAR();
    pv_d0(o, vbase + vcur * (int)SHM_V, pa0, pa1, pa2, pa3); }
  if (hi == 0) li_l[r32] = l_reg; asm volatile("s_waitcnt lgkmcnt(0)" ::: "memory");
  float rli[16];
#pragma unroll
  for (int r = 0; r < 16; ++r) rli[r] = __builtin_amdgcn_rcpf(li_l[crow(r, hi)]);
  bf16* Ow = Ob + (long)(wid * QBLK) * LDO;
#pragma unroll
  for (int r = 0; r < 16; ++r) { const int orow = crow(r, hi);
#pragma unroll
    for (int d0 = 0; d0 < 4; ++d0) { const float v = o[d0][r] * rli[r];
#if UPA_FP8
      ((unsigned char*)Ob)[(long)(wid * QBLK + orow) * LDO + d0 * 32 + r32] = (unsigned char)(__builtin_amdgcn_cvt_pk_fp8_f32(v * YA8_SCALE, 0.f, 0, false) & 0xff);
#else
      const float vn = __shfl_xor(v, 1);
      if ((r32 & 1) == 0) *(unsigned*)(Ow + (long)orow * LDO + d0 * 32 + r32) = cvtpk(v, vn);
#endif
    } }
  (void)Ow;
#undef DMA_TILE
#undef TILE_SYNC
#undef RESC
#undef MLOAD
}
#undef KSWZ
#undef SBAR
}

struct Args { const float* in[20]; float* out; unsigned char* ws; float inv_a[16]; float inv_i[8]; int ph_lo, ph_hi; };
enum { I_X = 0, I_C, I_WADA, I_BADA, I_GPREMIX, I_GPOSTMIX, I_WIN, I_WPOOL, I_POOLSCALE, I_WUPP, I_WUPA, I_WOUT, I_GPREFFN, I_GPOSTFFN, I_WROUTER, I_BROUTER, I_W1, I_B1, I_W2, I_B2 };

__device__ __forceinline__ void tr_item(const float* W, int ldw, int nvalid, bf16* WT, int ldt, LAS float* scr, int lane) {
    const int kr = lane >> 3, n4 = (lane & 7) * 4;
    f32x4 v[8];
#pragma unroll
    for (int i = 0; i < 8; ++i) v[i] = (n4 < nvalid) ? *(const f32x4*)(W + (size_t)(8 * i + kr) * ldw + n4) : (f32x4){0.f, 0.f, 0.f, 0.f};
#pragma unroll
    for (int i = 0; i < 8; ++i) { LAS float* d = scr + (8 * i + kr) * 33 + n4; d[0] = v[i].x; d[1] = v[i].y; d[2] = v[i].z; d[3] = v[i].w; }
    LDS_WAIT(); asm volatile("" ::: "memory");
    const int c = lane & 7;
#pragma unroll
    for (int j = 0; j < 4; ++j) { const int n = (lane >> 3) + 8 * j; const LAS float* s = scr + (8 * c) * 33 + n;
        v4u o; o.x = pk2(s[0 * 33], s[1 * 33]); o.y = pk2(s[2 * 33], s[3 * 33]); o.z = pk2(s[4 * 33], s[5 * 33]); o.w = pk2(s[6 * 33], s[7 * 33]);
        *(v4u*)(WT + (size_t)n * ldt + 8 * c) = o; }
    LDS_WAIT(); asm volatile("" ::: "memory");
}
__device__ __forceinline__ void tr_item8(const float* W, int ldw, unsigned char* WT, int ldt, float scale, LAS float* scr, int lane) {
    { const int kr = lane >> 3, s = lane & 7;
#pragma unroll
      for (int i = 0; i < 16; ++i) { const int c = 2 * (i >> 2) + (kr & 1), ip = 4 * (i & 3) + (kr >> 1), k = 16 * c + ip, g = s ^ (2 * (i >> 2));
          __builtin_amdgcn_global_load_lds((const unsigned*)(W + (size_t)k * ldw + 4 * g), (LAS unsigned*)(scr + i * 256), 16, 0, 2); } }
    VM_WAIT(); asm volatile("" ::: "memory");
    const int c = lane & 7;
#pragma unroll
    for (int j = 0; j < 4; ++j) { const int n = (lane >> 3) + 8 * j; const LAS float* sp = scr + 1024 * (c >> 1) + 32 * (c & 1) + 4 * ((n >> 2) ^ (2 * (c >> 1))) + (n & 3);
        float f[16];
#pragma unroll
        for (int ip = 0; ip < 16; ++ip) f[ip] = sp[256 * (ip >> 2) + 64 * (ip & 3)] * scale;
        v4u o; o.x = pk4_fp8(f[0], f[1], f[2], f[3]); o.y = pk4_fp8(f[4], f[5], f[6], f[7]); o.z = pk4_fp8(f[8], f[9], f[10], f[11]); o.w = pk4_fp8(f[12], f[13], f[14], f[15]);
        __builtin_nontemporal_store(o, (v4u*)(WT + (size_t)n * ldt + 16 * c)); asm volatile("" ::: "memory"); }
    LDS_WAIT(); asm volatile("" ::: "memory");
}

__device__ __forceinline__ void sincos_d(float angf, float& c_out, float& s_out) {
    const double a = (double)angf;
    const double kq = __builtin_rint(a * 0.63661977236758134308);
    double r = __builtin_fma(-kq, 1.57079632679489655800, a);
    r = __builtin_fma(-kq, 6.12323399573676603587e-17, r);
    const int q = ((int)kq) & 3;
    const double r2 = r * r;
    double sp = 1.0 / 6227020800.0; sp = sp * r2 - 1.0 / 39916800.0; sp = sp * r2 + 1.0 / 362880.0; sp = sp * r2 - 1.0 / 5040.0; sp = sp * r2 + 1.0 / 120.0; sp = sp * r2 - 1.0 / 6.0; sp = sp * r2 + 1.0;
    const double sr = sp * r;
    double cp = -1.0 / 87178291200.0; cp = cp * r2 + 1.0 / 479001600.0; cp = cp * r2 - 1.0 / 3628800.0; cp = cp * r2 + 1.0 / 40320.0; cp = cp * r2 - 1.0 / 720.0; cp = cp * r2 + 1.0 / 24.0; cp = cp * r2 - 0.5; cp = cp * r2 + 1.0;
    const double cr = cp;
    double c, s;
    if (q == 0) { c = cr; s = sr; } else if (q == 1) { c = -sr; s = cr; } else if (q == 2) { c = -cr; s = -sr; } else { c = sr; s = -cr; }
    c_out = (float)c; s_out = (float)s;
}


#define WSP(off) (wsb + (off))
#define MOD ((float*)WSP(WS_MOD))
#define WRT ((float*)WSP(WS_WRT))
#define ROPA ((float*)WSP(WS_ROPA))
#define ROPI ((float*)WSP(WS_ROPI))
#define TOPI ((int*)WSP(WS_TOPI))
#define GATE ((float*)WSP(WS_GATE))
#define SLOT ((int*)WSP(WS_SLOT))
#define WTPOOL ((bf16*)WSP(WS_WTPOOL))
#define WTUPP ((bf16*)WSP(WS_WTUPP))
#define WTUPA ((bf16*)WSP(WS_WTUPA))
#define WTOUT ((bf16*)WSP(WS_WTOUT))
#define WTIN ((bf16*)WSP(WS_WTIN))
#define W1T ((bf16*)WSP(WS_W1T))
#define W2T ((bf16*)WSP(WS_W2T))
#define Hb ((bf16*)WSP(WS_H))
#define Qb ((bf16*)WSP(WS_Q))
#define Kb ((bf16*)WSP(WS_K))
#define Vb ((bf16*)WSP(WS_V))
#define Ub ((bf16*)WSP(WS_U))
#define GLb ((bf16*)WSP(WS_GL))
#define QIb ((bf16*)WSP(WS_QI))
#define KWb ((bf16*)WSP(WS_KW))
#define MIXb ((bf16*)WSP(WS_MIX))
#define YPOOL ((bf16*)WSP(WS_YPOOL))
#define YATTN ((bf16*)WSP(WS_YATTN))
#define TMP ((float*)WSP(WS_TMP))
#define MERGED ((bf16*)WSP(WS_MERGED))
#define Yf ((float*)WSP(WS_Y))
#define X1 ((float*)WSP(WS_X1))
#define XS ((bf16*)WSP(WS_XS))
#define ACT ((bf16*)WSP(WS_ACT))
#define YS ((bf16*)WSP(WS_YS))
#define MASKW ((unsigned*)WSP(WS_MASK))
#define H8A ((unsigned char*)WSP(WS_XS + 1 * MiB))
#define WTIN8 ((unsigned char*)WSP(WS_XS + 64 * MiB))
#define ELIST ((int*)WSP(WS_XS + 40 * MiB))
#define ROWTOK ((int*)WSP(WS_XS))
#define PHASE_BASE() GAS unsigned char* wsg_ = (GAS unsigned char*)KA->ws; asm volatile("" : "+s"(wsg_)); unsigned char* wsb = (unsigned char*)wsg_; unsigned* ctl = (unsigned*)(wsb + WS_CTL); (void)ctl
#define INP(i) ((const float*)(const GAS float*)KA->in[i])
#define OUTP ((float*)(GAS float*)KA->out)
#define CAS __attribute__((address_space(4)))
extern __shared__ __attribute__((aligned(16))) unsigned char lds_raw[];
#define PH_PROLOG() \
    const CAS Args* KA = (const CAS Args*)__builtin_amdgcn_kernarg_segment_ptr(); LAS unsigned char* lds = (LAS unsigned char*)lds_raw; \
    volatile LAS unsigned* MISC = (volatile LAS unsigned*)(lds + MISC_OFF); (void)MISC; \
    const int wave = __builtin_amdgcn_readfirstlane((int)threadIdx.x >> 6); \
    const int lane = (int)__builtin_amdgcn_mbcnt_hi(~0u, __builtin_amdgcn_mbcnt_lo(~0u, 0u)), tid = wave * 64 + lane; \
    const int G = gridDim.x, bx = blockIdx.x; const int gw = bx * NWAVES + wave, NGW = G * NWAVES; (void)tid; (void)gw; (void)NGW; (void)lane

constexpr int FIRST_T_OFF = MISC_OFF + 1280, CNT_E_OFF = MISC_OFF + 1408, TILE_ROWS_OFF = MISC_OFF + 1536;
static_assert(TILE_ROWS_OFF + MAXTILES * 4 <= LDS_BYTES, "tile tables overflow the LDS block");
constexpr int FIRST_T_OFF_ = 0;
__device__ __forceinline__ void moe_tiles() {
    PH_PROLOG();
        PHASE_BASE();
        LAS int* tile_e = (LAS int*)(lds + TILE_E_OFF);
        if (wave == 0) {
            int myc = 0; if (lane < NE) myc = (int)__hip_atomic_load(ctl + CW_CUR + 64 * lane, __ATOMIC_RELAXED, __HIP_MEMORY_SCOPE_AGENT);
            const int ntl = (myc + 255) >> 8; int incl = ntl;
#pragma unroll
            for (int o = 1; o < 32; o <<= 1) { const int t = __shfl_up(incl, o); if ((lane & 31) >= o) incl += t; }
            if (lane < NE) { for (int i = incl - ntl; i < incl; ++i) { tile_e[i] = lane; const int lv = myc - (i - (incl - ntl)) * 256; ((LAS int*)(lds + TILE_ROWS_OFF))[i] = lv < 256 ? lv : 256; }
                ((LAS int*)(lds + FIRST_T_OFF))[lane] = incl - ntl; ((LAS int*)(lds + CNT_E_OFF))[lane] = myc; }
            if (lane == NE - 1) MISC[4] = (unsigned)incl;
        }
        __syncthreads();
}

__device__ __forceinline__ void phase0() {
    PH_PROLOG();
        PHASE_BASE();
        LAS float* scr = (LAS float*)(lds + wave * 16896);
        constexpr int I_IN = 296 * 32, I_PL = 128, I_UPP = UPP_FP8 ? 512 : 1024, I_UPA = UPA_FP8 ? 1024 : 2048, I_OUT = OUT_FP8 ? 1024 : 2048, I_1 = 32 * 2048, I_2 = 32 * 1024;
        constexpr int I_IN8 = GL_FP8 ? 16 * 224 : 0;
        constexpr int NIT = I_IN + I_IN8 + I_PL + I_UPP + I_UPA + I_OUT + I_1 + I_2;
        for (int it = gw; it < NIT; it += NGW) {
            int r = it;
            if (r < I_IN) { const int nb = r >> 5, kb = r & 31, d0 = 32 * nb; int src = 0, nv = 32;
                if (GL_FP8 && ((d0 >> 8) < 12 || ((d0 >> 8) >= 16 && (d0 >> 8) < 32))) continue;
                if (d0 < 2048) src = 1024 + d0; else if (d0 < 2560) src = 3072 + (d0 - 2048); else if (d0 < 3072) src = 3584 + (d0 - 2560); else if (d0 < 4096) src = d0 - 3072;
                else if (d0 < 8192) src = 5200 + (d0 - 4096); else if (d0 < 9216) src = 4096 + (d0 - 8192); else if (d0 < 9280) src = 5120 + (d0 - 9216); else if (d0 < 9312) { src = 5184; nv = 16; } else { src = 0; nv = 0; }
                tr_item(INP(I_WIN) + (size_t)(64 * kb) * 9296 + src, 9296, nv, WTIN + (size_t)d0 * 2048 + 64 * kb, 2048, scr, lane); continue; }
            r -= I_IN;
#if GL_FP8
            if (r < I_IN8) { const int kb = r / 224, nb = r % 224, p0 = 32 * nb;
                const int src = p0 < 2048 ? 1024 + p0 : p0 < 2560 ? 3072 + (p0 - 2048) : p0 < 3072 ? 3584 + (p0 - 2560) : 5200 + (p0 - 3072);
                tr_item8(INP(I_WIN) + (size_t)(128 * kb) * 9296 + src, 9296, WTIN8 + (size_t)p0 * 2048 + 128 * kb, 2048, W8_SCALE, scr, lane); continue; }
            r -= I_IN8;
#endif
            if (r < I_PL) { const int gI = r >> 5, q = r & 31, kb = q >> 3, nb = q & 7;
                tr_item(INP(I_WPOOL) + (size_t)gI * 65536 + (size_t)(64 * kb) * 256 + 32 * nb, 256, 32, WTPOOL + (size_t)gI * 65536 + (size_t)(32 * nb) * 256 + 64 * kb, 256, scr, lane); continue; }
            r -= I_PL;
            if (r < I_UPP) {
#if UPP_FP8
                const int kb = r >> 6, nb = r & 63;
                tr_item8(INP(I_WUPP) + (size_t)(128 * kb) * 2048 + 32 * nb, 2048, (unsigned char*)WTUPP + (size_t)(32 * nb) * 2048 + 128 * kb, 2048, W8_SCALE, scr, lane);
#else
                const int nb = r >> 4, kb = r & 15;
                tr_item(INP(I_WUPP) + (size_t)(64 * kb) * 2048 + 32 * nb, 2048, 32, WTUPP + (size_t)(32 * nb) * 1024 + 64 * kb, 1024, scr, lane);
#endif
                continue; }
            r -= I_UPP;
            if (r < I_UPA) {
#if UPA_FP8
                const int kb = r >> 6, nb = r & 63;
                tr_item8(INP(I_WUPA) + (size_t)(128 * kb) * 2048 + 32 * nb, 2048, (unsigned char*)WTUPA + (size_t)(32 * nb) * 2048 + 128 * kb, 2048, W8_SCALE, scr, lane);
#else
                const int nb = r >> 5, kb = r & 31;
                tr_item(INP(I_WUPA) + (size_t)(64 * kb) * 2048 + 32 * nb, 2048, 32, WTUPA + (size_t)(32 * nb) * 2048 + 64 * kb, 2048, scr, lane);
#endif
                continue; }
            r -= I_UPA;
            if (r < I_OUT) {
#if OUT_FP8
                const int kb = r >> 6, nb = r & 63;
                tr_item8(INP(I_WOUT) + (size_t)(128 * kb) * 2048 + 32 * nb, 2048, (unsigned char*)WTOUT + (size_t)(32 * nb) * 2048 + 128 * kb, 2048, W8_SCALE, scr, lane);
#else
                const int nb = r >> 5, kb = r & 31;
                tr_item(INP(I_WOUT) + (size_t)(64 * kb) * 2048 + 32 * nb, 2048, 32, WTOUT + (size_t)(32 * nb) * 2048 + 64 * kb, 2048, scr, lane);
#endif
                continue; }
            r -= I_OUT;
            if (r < I_1) { const int e = r >> 11, q = r & 2047, kb = q >> 7, nb = q & 127, c0 = 32 * nb;
                const int dst = c0 < 2048 ? 256 * (c0 >> 7) + (c0 & 127) : 256 * ((c0 - 2048) >> 7) + 128 + ((c0 - 2048) & 127);
                tr_item8(INP(I_W1) + (size_t)e * 2048 * 4096 + (size_t)(128 * kb) * 4096 + c0, 4096, (unsigned char*)W1T + ((size_t)e * 4096 + dst) * 2048 + 128 * kb, 2048, W8_SCALE, scr, lane); continue; }
            r -= I_1;
            { const int e = r >> 10, q = r & 1023, kb = q >> 6, nb = q & 63;
                tr_item8(INP(I_W2) + (size_t)e * 2048 * 2048 + (size_t)(128 * kb) * 2048 + 32 * nb, 2048, (unsigned char*)W2T + ((size_t)e * 2048 + 32 * nb) * 2048 + 128 * kb, 2048, W8_SCALE, scr, lane); }
        }
        for (int id = bx * 512 + tid; id < NE * D; id += G * 512) WRT[id] = INP(I_WROUTER)[(size_t)(id & 2047) * 32 + (id >> 11)];
        for (int id = bx * 512 + tid; id < SEQ * 24; id += G * 512) {
            if (id < SEQ * 16) { const int pos = id >> 4, i = id & 15; float c_, s_; sincos_d((float)pos * KA->inv_a[i], c_, s_); ROPA[pos * 32 + i] = c_; ROPA[pos * 32 + 16 + i] = s_; }
            else { const int id2 = id - SEQ * 16, pos = id2 >> 3, i = id2 & 7; float c_, s_; sincos_d((float)pos * KA->inv_i[i], c_, s_); ROPI[pos * 16 + i] = c_; ROPI[pos * 16 + 8 + i] = s_; }
        }
        __syncthreads();
        LAS float* cact = (LAS float*)lds;
        LAS float* red = (LAS float*)(lds + 65536);
        for (int i = tid; i < NB * D; i += 512) { const float cv = INP(I_C)[i]; cact[i] = cv / (1.0f + __expf(-cv)); }
        __syncthreads();
        for (int cb = bx; cb < 256; cb += G) {
            float a8[8];
#pragma unroll
            for (int b = 0; b < 8; ++b) a8[b] = 0.f;
            if (lane < 48) {
                const float* wp = INP(I_WADA) + cb * 48 + lane;
#pragma unroll 1
                for (int i0 = 0; i0 < 256; i0 += 16) { float wv[16];
#pragma unroll
                    for (int i = 0; i < 16; ++i) wv[i] = wp[(size_t)(wave + 8 * (i0 + i)) * 12288];
#pragma unroll
                    for (int i = 0; i < 16; ++i) { const int k = wave + 8 * (i0 + i);
#pragma unroll
                        for (int b = 0; b < 8; ++b) a8[b] += cact[b * 2048 + k] * wv[i]; } }
#pragma unroll
                for (int b = 0; b < 8; ++b) red[(wave * 8 + b) * 48 + lane] = a8[b];
            }
            __syncthreads();
            if (tid < 384) { const int b = tid / 48, cI = tid % 48; float s = 0.f;
#pragma unroll
                for (int w = 0; w < 8; ++w) s += red[(w * 8 + b) * 48 + cI];
                MOD[b * 12288 + cb * 48 + cI] = s + INP(I_BADA)[cb * 48 + cI]; }
            __syncthreads();
        }
}

__device__ __forceinline__ void phase1() {
    PH_PROLOG();
        PHASE_BASE();
        const float* gp = INP(I_GPREMIX);
        for (int m0 = gw; m0 < T; m0 += 2 * NGW) {
            f32x4 v[2][8]; float rstd[2];
#pragma unroll
            for (int u = 0; u < 2; ++u) { const f32x4* xr = (const f32x4*)(INP(I_X) + (size_t)(m0 + u * NGW) * D) + lane;
#pragma unroll
                for (int j = 0; j < 8; ++j) v[u][j] = xr[64 * j]; }
#pragma unroll
            for (int u = 0; u < 2; ++u) { float ss = 0.f;
#pragma unroll
                for (int j = 0; j < 8; ++j) ss += (v[u][j].x * v[u][j].x + v[u][j].y * v[u][j].y) + (v[u][j].z * v[u][j].z + v[u][j].w * v[u][j].w);
                rstd[u] = rsqrtf(wave_sum(ss) * (1.0f / D) + EPS); }
#pragma unroll
            for (int u = 0; u < 2; ++u) { const int m = m0 + u * NGW, b = m >> 11; const float* mod = MOD + b * 12288;
                v2u* o8 = (v2u*)(Hb + (size_t)m * D) + lane;
#pragma unroll
                for (int j = 0; j < 8; ++j) { const int col = 4 * (lane + 64 * j);
                    const f32x4 gv = *(const f32x4*)(gp + col), sc = *(const f32x4*)(mod + 2048 + col), sh = *(const f32x4*)(mod + col);
                    const f32x4 hv = (v[u][j] * rstd[u] * gv) * (sc + 1.0f) + sh;
                    v2u w; w.x = cvt_pk_bf16(hv.x, hv.y); w.y = cvt_pk_bf16(hv.z, hv.w); o8[64 * j] = w;
#if GL_FP8
                    ((unsigned*)(H8A + (size_t)m * D))[lane + 64 * j] = pk4_fp8(hv.x, hv.y, hv.z, hv.w);
#endif
                } }
        }
}

__device__ __forceinline__ void phase2() {
    PH_PROLOG();
        PHASE_BASE();
#if GL_FP8
        { pg8::Gemm g{2 * D, 2 * D, 2 * D};
          ProjOrder<0> S{T / 256, G, bx, (const char*)Hb, (const char*)WTIN, (size_t)256 * D * 2, (size_t)256 * D * 2};
          EpiProj E{Qb, Kb, Vb, Ub, GLb, QIb, KWb, ROPA, ROPI, 1.0f};
          pg8::gemm_phase<EpiProj, ProjOrder<0>>(lds, g, S, E); }
        __syncthreads();
        { pg8::Gemm g{D, D, D};
          ProjOrder<1> S{T / 256, G, bx, (const char*)H8A, (const char*)WTIN8, (size_t)256 * D, (size_t)256 * D};
          EpiProj E{Qb, Kb, Vb, Ub, GLb, QIb, KWb, ROPA, ROPI, 1.0f / W8_SCALE};
          pg8::gemm_phase<EpiProj, ProjOrder<1>, true>(lds, g, S, E); }
#else
        pg8::Gemm g{2 * D, 2 * D, 2 * D};
        DenseOrder S{T / 256, NPROJ / 256, G, bx, (const char*)Hb, (const char*)WTIN, (size_t)256 * D * 2, 0, (size_t)256 * D * 2};
        EpiProj E{Qb, Kb, Vb, Ub, GLb, QIb, KWb, ROPA, ROPI, 1.0f};
        pg8::gemm_phase<EpiProj, DenseOrder>(lds, g, S, E);
#endif
}

__device__ __forceinline__ void phase3() { }

__device__ __forceinline__ void phase4() {
    PH_PROLOG();
        PHASE_BASE();
        { Unit pu;
          if (pg8::order_next(0, G, bx, T / 256, 4, pu)) {
              { const int c8 = pu.pn * 32 + (tid & 31), seg = tid >> 5, w = 2 << pu.pn, trow0 = pu.pm * 256 + 16 * seg, pos0 = trow0 & 2047;
                const bf16* ucol = Ub + (size_t)c8 * 8;
                float S[8];
#pragma unroll
                for (int i = 0; i < 8; ++i) S[i] = 0.f;
                { const int c0 = pos0 < w ? pos0 : w;
                  for (int j = 1; j <= c0; ++j) { const v4u uv = *(const v4u*)(ucol + (size_t)(trow0 - j) * 1024);
                      S[0] += lo16(uv.x); S[1] += hi16(uv.x); S[2] += lo16(uv.y); S[3] += hi16(uv.y); S[4] += lo16(uv.z); S[5] += hi16(uv.z); S[6] += lo16(uv.w); S[7] += hi16(uv.w); } }
#pragma unroll 4
                for (int i = 0; i < 16; ++i) { const int t = trow0 + i, pos = pos0 + i;
                    const v4u uv = *(const v4u*)(ucol + (size_t)t * 1024);
                    const float f[8] = {lo16(uv.x), hi16(uv.x), lo16(uv.y), hi16(uv.y), lo16(uv.z), hi16(uv.z), lo16(uv.w), hi16(uv.w)};
#pragma unroll
                    for (int q = 0; q < 8; ++q) S[q] += f[q];
                    if (pos >= w) { const v4u lv = *(const v4u*)(ucol + (size_t)(t - w) * 1024);
                        S[0] -= lo16(lv.x); S[1] -= hi16(lv.x); S[2] -= lo16(lv.y); S[3] -= hi16(lv.y); S[4] -= lo16(lv.z); S[5] -= hi16(lv.z); S[6] -= lo16(lv.w); S[7] -= hi16(lv.w); }
                    const int cnt = (pos + 1) < w ? (pos + 1) : w; const float inv = __builtin_amdgcn_rcpf((float)cnt); v4u o;
                    o.x = pk2(S[0] * inv - f[0], S[1] * inv - f[1]); o.y = pk2(S[2] * inv - f[2], S[3] * inv - f[3]);
                    o.z = pk2(S[4] * inv - f[4], S[5] * inv - f[5]); o.w = pk2(S[6] * inv - f[6], S[7] * inv - f[7]);
                    *(v4u*)(MIXb + (size_t)t * 1024 + c8 * 8) = o; }
              }
          }
          VM_WAIT(); __syncthreads(); }
        { pg8::Gemm g{512, 2048, 512};
          DenseOrder S{T / 256, 4, G, bx, (const char*)MIXb, (const char*)WTPOOL, (size_t)256 * 1024 * 2, (size_t)256 * 2, (size_t)256 * 256 * 2};
          EpiPool E{YPOOL, INP(I_POOLSCALE)};
          pg8::gemm_phase<EpiPool, DenseOrder>(lds, g, S, E); }
        __syncthreads();
#pragma unroll 1
        for (int rnd = 0; rnd * NGW < NB * (SEQ / 2); ++rnd) {
            const int task = gw + rnd * NGW, b = task >> 10, mir = (b >> 1) & 1;
            const int tpr = task & 1023, tp = mir ? 1023 - tpr : tpr;
            const int tpr_lo = (bx * NWAVES) & 1023, tp_hi = mir ? 1023 - tpr_lo : tpr_lo + NWAVES - 1;
            indexer_task(QIb, KWb, MASKW, b, tp, 2 * tp_hi + 1, lds, wave, lane);
        }
}

__device__ __forceinline__ void phase5() {
    PH_PROLOG();
        PHASE_BASE();
#pragma unroll 1
        for (int L = bx; L < NB * 16 * 4; L += G) {
            const int b = L & 7, rest = L >> 3, h = rest >> 2, pair = rest & 3;
#pragma unroll 1
            for (int pass = 0; pass < 2; ++pass) {
                const int qb = pass ? pair : 7 - pair;
                const size_t r0 = (size_t)b * SEQ + (size_t)qb * 256;
                att::attn_masked_body(Qb + r0 * 2048 + h * 128, Kb + (size_t)b * SEQ * 512 + (h >> 2) * 128, Vb + (size_t)b * SEQ * 512 + (h >> 2) * 128,
                                      UPA_FP8 ? (bf16*)((unsigned char*)YATTN + r0 * 2048 + h * 128) : YATTN + r0 * 2048 + h * 128, MASKW + r0 * 64, (qb + 1) * 256, lds);
                __syncthreads();
            }
        }
}

__device__ __forceinline__ void phase6() {
    PH_PROLOG();
        PHASE_BASE();
        static_assert(UPP_FP8 && UPA_FP8 && OUT_FP8, "the fused up-projection runs on e4m3 operands and writes e4m3 merged");
        { pg8::Gemm g{1024, 1024, 2048};
          UpOrder S{T / 256, D / 256, G, bx, (const char*)YPOOL, (const char*)YATTN, (const char*)WTUPP, (const char*)WTUPA};
          EpiUpF E{MERGED, GLb};
          pg8::gemm_phase<EpiUpF, UpOrder, true, true>(lds, g, S, E); }
}

__device__ __forceinline__ void phase7() {
    PH_PROLOG();
        PHASE_BASE();
        pg8::Gemm g{OUT_FP8 ? D : 2 * D, OUT_FP8 ? D : 2 * D, OUT_FP8 ? D : 2 * D};
        DenseOrder S{T / 256, D / 256, G, bx, (const char*)MERGED, (const char*)WTOUT, (size_t)256 * (OUT_FP8 ? D : 2 * D), 0, (size_t)256 * (OUT_FP8 ? D : 2 * D)};
        EpiY16 E{(bf16*)Yf};
        pg8::gemm_phase<EpiY16, DenseOrder, OUT_FP8 != 0>(lds, g, S, E);
}

__device__ __forceinline__ void phase8() {
    PH_PROLOG();
        PHASE_BASE();
        const float* gpm = INP(I_GPOSTMIX); const float* gpf = INP(I_GPREFFN);
        { LAS f32x4* wl = (LAS f32x4*)lds; const f32x4* wg = (const f32x4*)WRT;
          for (int i = tid; i < 16 * D / 4; i += 512) wl[i] = wg[i];
          __syncthreads(); }
#pragma unroll 1
        for (int grp = gw; grp < T / 4; grp += NGW) {
            int lane = (int)__builtin_amdgcn_mbcnt_hi(~0u, __builtin_amdgcn_mbcnt_lo(~0u, 0u)); asm volatile("" : "+v"(lane));
            f32x4 hv[4][8];
#pragma unroll
            for (int r = 0; r < 4; ++r) {
                const int m = grp * 4 + r, b = m >> 11; const float* mod = MOD + b * 12288;
                const v2u* yr = (const v2u*)((const bf16*)Yf + (size_t)m * D) + lane; const f32x4* xr = (const f32x4*)(INP(I_X) + (size_t)m * D) + lane;
                v2u yw[8]; f32x4 xv[8];
#pragma unroll
                for (int j = 0; j < 8; ++j) yw[j] = yr[64 * j];
#pragma unroll
                for (int j = 0; j < 8; ++j) xv[j] = xr[64 * j];
                asm volatile("" ::: "memory");
                float ss = 0.f;
#pragma unroll
                for (int j = 0; j < 8; ++j) { const f32x4 t = {lo16(yw[j].x), hi16(yw[j].x), lo16(yw[j].y), hi16(yw[j].y)}; hv[r][j] = t; ss += (t.x * t.x + t.y * t.y) + (t.z * t.z + t.w * t.w); }
                const float rstd = rsqrtf(wave_sum(ss) * (1.0f / D) + EPS);
                float ss2 = 0.f; v2u* x1r = (v2u*)((bf16*)X1 + (size_t)m * D) + lane;
#pragma unroll
                for (int h = 0; h < 2; ++h) { f32x4 gv[4], gt[4];
#pragma unroll
                    for (int q = 0; q < 4; ++q) { const int col = 4 * (lane + 64 * (4 * h + q)); gv[q] = *(const f32x4*)(gpm + col); gt[q] = *(const f32x4*)(mod + 4096 + col); }
                    asm volatile("" ::: "memory");
#pragma unroll
                    for (int q = 0; q < 4; ++q) { const int j = 4 * h + q;
                        const f32x4 t = xv[j] + gt[q] * (hv[r][j] * rstd * gv[q]); hv[r][j] = t; { v2u w; w.x = cvt_pk_bf16(t.x, t.y); w.y = cvt_pk_bf16(t.z, t.w); x1r[64 * j] = w; }
                        ss2 += (t.x * t.x + t.y * t.y) + (t.z * t.z + t.w * t.w); }
                    asm volatile("" ::: "memory"); }
                const float rstd2 = rsqrtf(wave_sum(ss2) * (1.0f / D) + EPS);
                unsigned* o8 = (unsigned*)((unsigned char*)Hb + (size_t)m * D) + lane;
#pragma unroll
                for (int h = 0; h < 2; ++h) { f32x4 gv[4], sc[4], sh[4];
#pragma unroll
                    for (int q = 0; q < 4; ++q) { const int col = 4 * (lane + 64 * (4 * h + q)); gv[q] = *(const f32x4*)(gpf + col); sc[q] = *(const f32x4*)(mod + 8192 + col); sh[q] = *(const f32x4*)(mod + 6144 + col); }
                    asm volatile("" ::: "memory");
#pragma unroll
                    for (int q = 0; q < 4; ++q) { const int j = 4 * h + q;
                        const f32x4 t = (hv[r][j] * rstd2 * gv[q]) * (sc[q] + 1.0f) + sh[q]; hv[r][j] = t;
                        o8[64 * j] = pk4_fp8(t.x, t.y, t.z, t.w); }
                    asm volatile("" ::: "memory"); }
                asm volatile("" : "+v"(lane) :: "memory");
            }
            float lgA[4] = {0.f, 0.f, 0.f, 0.f}, lgB[4] = {0.f, 0.f, 0.f, 0.f};
            const int l15 = lane & 15;
#pragma unroll 1
            for (int e = 0; e < 16; ++e) {
                const LAS f32x4* wp = (const LAS f32x4*)lds + e * (D / 4) + lane;
                f32x2 p2[4] = {{0.f, 0.f}, {0.f, 0.f}, {0.f, 0.f}, {0.f, 0.f}};
#pragma unroll
                for (int j = 0; j < 8; ++j) { const f32x4 w = wp[64 * j]; const f32x2 w01 = {w.x, w.y}, w23 = {w.z, w.w};
#pragma unroll
                    for (int r = 0; r < 4; ++r) { p2[r] += (f32x2){hv[r][j].x, hv[r][j].y} * w01; p2[r] += (f32x2){hv[r][j].z, hv[r][j].w} * w23; } }
                const float p[4] = {p2[0].x + p2[0].y, p2[1].x + p2[1].y, p2[2].x + p2[2].y, p2[3].x + p2[3].y};
#pragma unroll
                for (int r = 0; r < 4; ++r) { const float sR = row_sum16(p[r]); lgA[r] = (l15 == e) ? sR : lgA[r]; }
            }
#pragma unroll 1
            for (int e = 0; e < 16; ++e) {
                const f32x4* wp = (const f32x4*)(WRT + (size_t)(16 + e) * D) + lane;
                f32x2 p2[4] = {{0.f, 0.f}, {0.f, 0.f}, {0.f, 0.f}, {0.f, 0.f}};
#pragma unroll
                for (int j = 0; j < 8; ++j) { const f32x4 w = wp[64 * j]; const f32x2 w01 = {w.x, w.y}, w23 = {w.z, w.w};
#pragma unroll
                    for (int r = 0; r < 4; ++r) { p2[r] += (f32x2){hv[r][j].x, hv[r][j].y} * w01; p2[r] += (f32x2){hv[r][j].z, hv[r][j].w} * w23; } }
                const float p[4] = {p2[0].x + p2[0].y, p2[1].x + p2[1].y, p2[2].x + p2[2].y, p2[3].x + p2[3].y};
#pragma unroll
                for (int r = 0; r < 4; ++r) { const float sR = row_sum16(p[r]); lgB[r] = (l15 == e) ? sR : lgB[r]; }
            }
#pragma unroll
            for (int r = 0; r < 4; ++r) { lgA[r] += __shfl_xor(lgA[r], 16); lgA[r] += __shfl_xor(lgA[r], 32); lgB[r] += __shfl_xor(lgB[r], 16); lgB[r] += __shfl_xor(lgB[r], 32); }
            const float brt = INP(I_BROUTER)[lane & 31];
            int tiA[4][4]; float gA[4][4];
#pragma unroll
            for (int r = 0; r < 4; ++r) {
                float lv = (lane < NE) ? ((lane < 16) ? lgA[r] : lgB[r]) + brt : -__builtin_inff();
                float tv[4];
#pragma unroll
                for (int k = 0; k < 4; ++k) {
                    float m1 = row_max16(lv); m1 = __builtin_fmaxf(m1, __shfl_xor(m1, 16));
                    const float mx = __builtin_bit_cast(float, __builtin_amdgcn_readlane(__builtin_bit_cast(int, m1), 0));
                    int c1 = row_min16i((lv == mx) ? lane : 99); { const int t = __shfl_xor(c1, 16); c1 = t < c1 ? t : c1; }
                    const int ie = __builtin_amdgcn_readlane(c1, 0);
                    tv[k] = mx; tiA[r][k] = ie; if (lane == ie) lv = -__builtin_inff(); }
                const float e1 = __expf(tv[1] - tv[0]), e2 = __expf(tv[2] - tv[0]), e3 = __expf(tv[3] - tv[0]); const float is = 1.0f / (1.0f + e1 + e2 + e3);
                gA[r][0] = is; gA[r][1] = e1 * is; gA[r][2] = e2 * is; gA[r][3] = e3 * is;
            }
            if (lane < 4) {
                const int m = grp * 4 + lane; int ti[4]; float gg[4];
#pragma unroll
                for (int k = 0; k < 4; ++k) { ti[k] = lane == 0 ? tiA[0][k] : lane == 1 ? tiA[1][k] : lane == 2 ? tiA[2][k] : tiA[3][k]; gg[k] = lane == 0 ? gA[0][k] : lane == 1 ? gA[1][k] : lane == 2 ? gA[2][k] : gA[3][k]; }
                *(int4*)(TOPI + (size_t)m * 4) = make_int4(ti[0], ti[1], ti[2], ti[3]); *(f32x4*)(GATE + (size_t)m * 4) = (f32x4){gg[0], gg[1], gg[2], gg[3]};
                int ps[4];
#pragma unroll
                for (int k = 0; k < 4; ++k) ps[k] = (int)xb_add(ctl + CW_CUR + 64 * ti[k], 1u);
#pragma unroll
                for (int k = 0; k < 4; ++k) ELIST[ti[k] * 16384 + ps[k]] = m;
                *(int4*)(SLOT + (size_t)m * 4) = make_int4(ps[0], ps[1], ps[2], ps[3]); }
        }
}

__device__ __forceinline__ void phase9() { }

__device__ __forceinline__ void phase10() {
    PH_PROLOG();
    moe_tiles();
        PHASE_BASE();
        const int ntiles = (int)MISC[4]; const LAS int* tile_e = (const LAS int*)(lds + TILE_E_OFF);
        pg8::Gemm g{D, D, D};
        LAS int* tokL = (LAS int*)(lds + TOK_OFF);
        MoeOrder S{ntiles, 16, G, bx, (const char*)Hb, (const char*)W1T, 0, (size_t)4096 * D, (size_t)256 * D, tile_e, tokL, (const LAS int*)(lds + TILE_ROWS_OFF), 1};
        { const LAS int* first_t = (const LAS int*)(lds + FIRST_T_OFF); const LAS int* cnt_e = (const LAS int*)(lds + CNT_E_OFF);
          int tv[10]; const int r8 = tid & 255;
#pragma unroll
          for (int q = 0; q < 10; ++q) { const int i = (tid >> 8) + 2 * q; Unit u; const bool ok = S.next(i, u); const int pm = ok ? u.pm : 0;
              const int rr = r8 + (ok ? u.roff : 0);
              const int e = tile_e[pm], r = (pm - first_t[e]) * 256 + rr; const bool live = ok && (rr < 256) && (r < cnt_e[e]);
              const int v = ELIST[live ? e * 16384 + r : 0]; tv[q] = live ? v : 0; }
#pragma unroll
          for (int q = 0; q < 10; ++q) { const int i = (tid >> 8) + 2 * q; tokL[i * 256 + r8] = tv[q]; } }
        __syncthreads();
        EpiAct E{(unsigned char*)ACT, INP(I_B1), tile_e};
        pg8::gemm_phase<EpiAct, MoeOrder, true, true>(lds, g, S, E);
}

__device__ __forceinline__ void phase11() {
    PH_PROLOG();
    moe_tiles();
        PHASE_BASE();
        const int ntiles = (int)MISC[4]; const LAS int* tile_e = (const LAS int*)(lds + TILE_E_OFF);
        pg8::Gemm g{DFF, DFF, DFF};
        MoeOrder S{ntiles, 8, G, bx, (const char*)ACT, (const char*)W2T, (size_t)256 * DFF, (size_t)2048 * DFF, (size_t)256 * DFF, tile_e, nullptr, (const LAS int*)(lds + TILE_ROWS_OFF), 1};
        EpiYs E{(unsigned char*)YS, INP(I_B2), tile_e};
        pg8::gemm_phase<EpiYs, MoeOrder, true>(lds, g, S, E);
}

__device__ __forceinline__ void phase12() {
    PH_PROLOG();
        PHASE_BASE();
        const float* gpo = INP(I_GPOSTFFN);
        int frow;
        { int myc = 0; if (lane < NE) myc = (int)__hip_atomic_load(ctl + CW_CUR + 64 * lane, __ATOMIC_RELAXED, __HIP_MEMORY_SCOPE_AGENT);
          const int padded = (myc + 255) & ~255; int incl = padded;
#pragma unroll
          for (int o = 1; o < 32; o <<= 1) { const int t = __shfl_up(incl, o); if ((lane & 31) >= o) incl += t; }
          frow = incl - padded; }
        int4 sl = *(const int4*)(SLOT + (size_t)gw * 4), te = *(const int4*)(TOPI + (size_t)gw * 4); f32x4 gt4 = *(const f32x4*)(GATE + (size_t)gw * 4);
#pragma unroll 1
        for (int m = gw; m < T; m += NGW) {
            int lane = (int)__builtin_amdgcn_mbcnt_hi(~0u, __builtin_amdgcn_mbcnt_lo(~0u, 0u)); asm volatile("" : "+v"(lane));
            const int b = m >> 11; const float* mod = MOD + b * 12288;
            const int sk[4] = {__shfl(frow, te.x) + sl.x, __shfl(frow, te.y) + sl.y, __shfl(frow, te.z) + sl.z, __shfl(frow, te.w) + sl.w}; constexpr float IYS = 1.0f / YS8_SCALE; const float gk[4] = {gt4.x * IYS, gt4.y * IYS, gt4.z * IYS, gt4.w * IYS};
            unsigned yw[4][8]; v2u xw[8];
#pragma unroll
            for (int k = 0; k < 4; ++k) { const unsigned* yp = (const unsigned*)((const unsigned char*)YS + (size_t)sk[k] * D) + lane;
#pragma unroll
                for (int j = 0; j < 8; ++j) yw[k][j] = yp[64 * j]; }
            const v2u* x1r = (const v2u*)((const bf16*)X1 + (size_t)m * D) + lane;
#pragma unroll
            for (int j = 0; j < 8; ++j) xw[j] = x1r[64 * j];
            { const int mn = (m + NGW < T) ? m + NGW : m; sl = *(const int4*)(SLOT + (size_t)mn * 4); te = *(const int4*)(TOPI + (size_t)mn * 4); gt4 = *(const f32x4*)(GATE + (size_t)mn * 4); }
            asm volatile("" ::: "memory");
            f32x4 a[8];
#pragma unroll
            for (int j = 0; j < 8; ++j) a[j] = (f32x4){0.f, 0.f, 0.f, 0.f};
#pragma unroll
            for (int k = 0; k < 4; ++k)
#pragma unroll
                for (int j = 0; j < 8; ++j) { const int w = (int)yw[k][j]; const f32x2 lo = __builtin_amdgcn_cvt_pk_f32_fp8(w, false), hi = __builtin_amdgcn_cvt_pk_f32_fp8(w, true);
                    a[j] += (f32x4){lo.x, lo.y, hi.x, hi.y} * gk[k]; }
            float ss = 0.f;
#pragma unroll
            for (int j = 0; j < 8; ++j) ss += (a[j].x * a[j].x + a[j].y * a[j].y) + (a[j].z * a[j].z + a[j].w * a[j].w);
            const float rstd = rsqrtf(wave_sum(ss) * (1.0f / D) + EPS);
            f32x4* orow = (f32x4*)(OUTP + (size_t)m * D) + lane;
#pragma unroll
            for (int j = 0; j < 8; ++j) { const int col = 4 * (lane + 64 * j);
                const f32x4 gv = *(const f32x4*)(gpo + col), gt = *(const f32x4*)(mod + 10240 + col);
                __builtin_nontemporal_store((f32x4){lo16(xw[j].x), hi16(xw[j].x), lo16(xw[j].y), hi16(xw[j].y)} + gt * (a[j] * rstd * gv), orow + 64 * j); }
        }
}

__global__ void __launch_bounds__(NWAVES * 64, 2) fwd_kernel(Args args) {
    LAS unsigned char* lds = (LAS unsigned char*)lds_raw;
    volatile LAS unsigned* MISC = (volatile LAS unsigned*)(lds + MISC_OFF);
    const int wave = __builtin_amdgcn_readfirstlane((int)threadIdx.x >> 6);
    const int lane = (int)__builtin_amdgcn_mbcnt_hi(~0u, __builtin_amdgcn_mbcnt_lo(~0u, 0u)), tid = wave * 64 + lane;
    unsigned* ctl0 = (unsigned*)(args.ws + WS_CTL);
    for (int u = tid; u < (LDS_BYTES - MISC_OFF) / 4; u += NWAVES * 64) ((LAS unsigned*)(lds + MISC_OFF))[u] = 0u;
    __syncthreads();
    XcdBarrier bar; bar.bar = ctl0 + CW_BAR; bar.x = 0; bar.st = nullptr;
    if (MK_N_LAUNCHES == 1) bar = xcd_barrier_post(ctl0 + CW_BAR, MISC);
    const int lo = args.ph_lo, hi = args.ph_hi;
#ifndef PHMASK
#define PHMASK 0xFFFF
#endif
#define IN(k) ((((PHMASK) >> (k)) & 1) && lo <= (k) && (k) < hi)
#define SEAM(k) do { if (IN(k) && IN((k) + 1)) xcd_barrier(bar); } while (0)
#ifndef PROBE_MASK
#define PROBE_MASK 0
#endif
#define REP(k) _Pragma("unroll") for (int rep_ = 0; rep_ < ((((PROBE_MASK) >> (k)) & 1) ? 2 : 1); ++rep_)

    if (IN(0)) REP(0) { if (rep_) __syncthreads(); phase0(); }
    SEAM(0);

    if (IN(1)) REP(1) { if (rep_) __syncthreads(); phase1(); }
    SEAM(1);

    if (IN(2)) REP(2) { if (rep_) __syncthreads(); phase2(); }
    SEAM(2);


    if (IN(4)) REP(4) { if (rep_) __syncthreads(); phase4(); }
    SEAM(4);
    if (IN(5)) REP(5) { if (rep_) __syncthreads(); phase5(); }
    SEAM(5);

    if (IN(6)) REP(6) { if (rep_) __syncthreads(); phase6(); }
    SEAM(6);

    if (IN(7)) REP(7) { if (rep_) __syncthreads(); phase7(); }
    SEAM(7);

    if (IN(8)) { phase8(); }
    SEAM(8);


    if (IN(10)) REP(10) { if (rep_) __syncthreads(); phase10(); }
    SEAM(10);
    if (IN(11)) REP(11) { if (rep_) __syncthreads(); phase11(); }
    SEAM(11);

    if (IN(12)) REP(12) { if (rep_) __syncthreads(); phase12(); }
#undef IN
#undef SEAM
}

constexpr int NPHASES = 13;
extern "C" void kernel_launch(void* const* d_in, const int* in_sizes, int n_in, void* d_out, int out_size, void* d_ws, size_t ws_size, hipStream_t stream) {
    static int grid = 0;
    if (grid == 0) {
        if (n_in != 20 || out_size != T * D || ws_size < WS_END) { fprintf(stderr, "kernel_launch: unexpected shapes (n_in %d out %d ws %zu need %zu)\n", n_in, out_size, ws_size, (size_t)WS_END); grid = -1; return; }
        int dev = 0, cus = 0, per_cu = 0;
        if (hipGetDevice(&dev) != hipSuccess || hipDeviceGetAttribute(&cus, hipDeviceAttributeMultiprocessorCount, dev) != hipSuccess) { grid = -1; return; }
        if (hipFuncSetAttribute((const void*)fwd_kernel, hipFuncAttributeMaxDynamicSharedMemorySize, LDS_BYTES) != hipSuccess) { fprintf(stderr, "kernel_launch: hipFuncSetAttribute failed\n"); grid = -1; return; }
        if (hipOccupancyMaxActiveBlocksPerMultiprocessor(&per_cu, (const void*)fwd_kernel, NWAVES * 64, LDS_BYTES) != hipSuccess || per_cu < 1)
            fprintf(stderr, "kernel_launch: occupancy query reports %d workgroups per CU\n", per_cu);
        (void)hipGetLastError();
        grid = cus;
        if (grid != 256) fprintf(stderr, "kernel_launch: %d CUs (built for 256)\n", grid);
    }
    if (grid < 0) return;
    (void)in_sizes;
    if (hipMemsetAsync((char*)d_ws + WS_CTL, 0, CTL_ZERO_BYTES, stream) != hipSuccess) { fprintf(stderr, "kernel_launch: memset failed\n"); return; }
    Args a{};
    for (int i = 0; i < 20; ++i) a.in[i] = (const float*)d_in[i];
    a.out = (float*)d_out; a.ws = (unsigned char*)d_ws;
    for (int i = 0; i < 16; ++i) a.inv_a[i] = (float)pow(500000.0, -(double)(2 * i) / 32.0);
    for (int i = 0; i < 8; ++i) a.inv_i[i] = (float)pow(500000.0, -(double)(2 * i) / 16.0);
#if MK_N_LAUNCHES == 1
    a.ph_lo = 0; a.ph_hi = NPHASES;
    hipLaunchKernelGGL(fwd_kernel, dim3(grid), dim3(NWAVES * 64), LDS_BYTES, stream, a);
#else
    for (int p = 0; p < NPHASES; ++p) { a.ph_lo = p; a.ph_hi = p + 1; hipLaunchKernelGGL(fwd_kernel, dim3(grid), dim3(NWAVES * 64), LDS_BYTES, stream, a); }
#endif
    const hipError_t le = hipPeekAtLastError();
    if (le != hipSuccess) fprintf(stderr, "kernel_launch: launch failed: %s\n", hipGetErrorName(le));
}
```

```cpp
#include <hip/hip_runtime.h>
#include <cstdio>
#include <cstdint>
#include <cmath>

#ifndef MK_N_LAUNCHES
#define MK_N_LAUNCHES 1
#endif

#define GAS __attribute__((address_space(1)))
#define LAS __attribute__((address_space(3)))
typedef unsigned short bf16;
typedef unsigned v4u __attribute__((ext_vector_type(4)));
typedef unsigned v2u __attribute__((ext_vector_type(2)));
typedef float f32x4 __attribute__((ext_vector_type(4)));
typedef float f32x2 __attribute__((ext_vector_type(2)));
typedef short bf16x8 __attribute__((ext_vector_type(8)));
#define LDS_WAIT() asm volatile("s_waitcnt lgkmcnt(0)" ::: "memory")
#define VM_WAIT() asm volatile("s_waitcnt vmcnt(0)" ::: "memory")

constexpr int NB = 8, SEQ = 2048, D = 2048, T = NB * SEQ;
constexpr int NPROJ = 9472;
constexpr int NE = 32, TOPK = 4, DFF = 2048;
constexpr int MAXTILES = (T * TOPK) / 256 + NE;
constexpr int MAXROWS = MAXTILES * 256;
constexpr int NKEEP = 256;
constexpr float EPS = 1e-6f;
constexpr int NWAVES = 8;
#ifndef ATT_END
#define ATT_END T
#endif

constexpr size_t MiB = 1u << 20;
constexpr size_t WS_CTL = 0, CTL_ZERO_BYTES = 1 * MiB;
constexpr size_t WS_MOD = 1 * MiB;
constexpr size_t WS_WRT = 1 * MiB + 512 * 1024;
constexpr size_t WS_ROPA = 2 * MiB;
constexpr size_t WS_ROPI = 2 * MiB + 512 * 1024;
constexpr size_t WS_TOPI = 3 * MiB;
constexpr size_t WS_GATE = 3 * MiB + 256 * 1024;
constexpr size_t WS_SLOT = 3 * MiB + 512 * 1024;
constexpr size_t WS_WTPOOL = 4 * MiB;
constexpr size_t WS_WTUPP = 5 * MiB;
constexpr size_t WS_WTUPA = 9 * MiB;
constexpr size_t WS_WTOUT = 17 * MiB;
constexpr size_t WS_WTIN = 25 * MiB;
constexpr size_t WS_W1T = 64 * MiB;
constexpr size_t WS_W2T = 576 * MiB;
constexpr size_t WS_H = 832 * MiB;
constexpr size_t WS_Q = 896 * MiB;
constexpr size_t WS_K = 960 * MiB;
constexpr size_t WS_V = 976 * MiB;
constexpr size_t WS_U = 992 * MiB;
constexpr size_t WS_GL = 1024 * MiB;
constexpr size_t WS_QI = 1152 * MiB;
constexpr size_t WS_KW = 1184 * MiB;
constexpr size_t WS_MIX = 1192 * MiB;
constexpr size_t WS_YPOOL = 1224 * MiB;
constexpr size_t WS_YATTN = 1256 * MiB;
constexpr size_t WS_TMP = 1320 * MiB;
constexpr size_t WS_MERGED = 1448 * MiB;
constexpr size_t WS_Y = 1512 * MiB;
constexpr size_t WS_X1 = 1640 * MiB;
constexpr size_t WS_XS = 1768 * MiB;
constexpr size_t WS_ACT = 2056 * MiB;
constexpr size_t WS_YS = 2344 * MiB;
constexpr size_t WS_MASK = 2632 * MiB;
constexpr size_t WS_END = 2636 * MiB;
constexpr int CW_BAR = 4096;
constexpr int CW_CNT = 16384;
constexpr int CW_CUR = 20480;

constexpr int RING_BYTES = 131072;
constexpr int TOK_OFF = RING_BYTES;
constexpr int MISC_OFF = 155648;
constexpr int TILE_E_OFF = MISC_OFF + 64;
constexpr int LDS_BYTES = MISC_OFF + 4096;

__device__ __forceinline__ float bf2f(unsigned b) { return __uint_as_float(b << 16); }
__device__ __forceinline__ unsigned f2bf(float f) { unsigned u = __float_as_uint(f); return (u + 0x7fffu + ((u >> 16) & 1u)) >> 16; }
__device__ __forceinline__ unsigned pk2(float lo, float hi) { return f2bf(lo) | (f2bf(hi) << 16); }
__device__ __forceinline__ float lo16(unsigned w) { return __uint_as_float(w << 16); }
__device__ __forceinline__ float hi16(unsigned w) { return __uint_as_float(w & 0xffff0000u); }
__device__ __forceinline__ float wave_sum(float v) {
#pragma unroll
    for (int o = 1; o < 64; o <<= 1) v += __shfl_xor(v, o);
    return v;
}
__device__ __forceinline__ float wave_max(float v) {
#pragma unroll
    for (int o = 1; o < 64; o <<= 1) v = fmaxf(v, __shfl_xor(v, o));
    return v;
}
__device__ __forceinline__ int wave_min_i(int v) {
#pragma unroll
    for (int o = 1; o < 64; o <<= 1) { int t = __shfl_xor(v, o); v = t < v ? t : v; }
    return v;
}
__device__ __forceinline__ unsigned pk4_fp8(float a, float b, float c, float d) {
    int w = __builtin_amdgcn_cvt_pk_fp8_f32(a, b, 0, false); w = __builtin_amdgcn_cvt_pk_fp8_f32(c, d, w, true); return (unsigned)w; }
#ifndef GL_FP8
#define GL_FP8 1
#endif
#ifndef UPP_FP8
#define UPP_FP8 1
#endif
#ifndef UPA_FP8
#define UPA_FP8 1
#endif
#ifndef OUT_FP8
#define OUT_FP8 1
#endif
constexpr float W8_SCALE = 64.0f, ACT8_SCALE = 4.0f, YA8_SCALE = 4.0f, YS8_SCALE = 4.0f;
template <int CTRL> __device__ __forceinline__ float dppf(float v) { return __builtin_bit_cast(float, __builtin_amdgcn_update_dpp(0, __builtin_bit_cast(int, v), CTRL, 0xF, 0xF, true)); }
template <int CTRL> __device__ __forceinline__ int dppi(int v) { return __builtin_amdgcn_update_dpp(0, v, CTRL, 0xF, 0xF, true); }
__device__ __forceinline__ float row_sum16(float v) { v += dppf<0x128>(v); v += dppf<0x124>(v); v += dppf<0x122>(v); v += dppf<0x121>(v); return v; }
__device__ __forceinline__ float row_max16(float v) { v = __builtin_fmaxf(v, dppf<0x128>(v)); v = __builtin_fmaxf(v, dppf<0x124>(v)); v = __builtin_fmaxf(v, dppf<0x122>(v)); v = __builtin_fmaxf(v, dppf<0x121>(v)); return v; }
__device__ __forceinline__ int row_min16i(int v) { int t = dppi<0x128>(v); v = t < v ? t : v; t = dppi<0x124>(v); v = t < v ? t : v; t = dppi<0x122>(v); v = t < v ? t : v; t = dppi<0x121>(v); v = t < v ? t : v; return v; }
__device__ __forceinline__ float sigmoidf_(float x) { return __builtin_amdgcn_rcpf(1.0f + __builtin_amdgcn_exp2f(-1.4426950408889634f * x)); }

#define XB_TMO      128
#define XB_XCNT(j)  (256  + 64 * (j))
#define XB_XSUB(j)  (1280 + 64 * (j))
#define XB_XGEN(j)  (2304 + 64 * (j))
#define XB_TOP      3328
#define XB_TOPGEN   3392
#define XCD_BAR_WORDS 3456
#define XB_SPIN_CAP (1u << 22)

__device__ __forceinline__ unsigned xb_ld(unsigned* p)              { return __hip_atomic_load(p, __ATOMIC_RELAXED, __HIP_MEMORY_SCOPE_AGENT); }
__device__ __forceinline__ unsigned xb_add(unsigned* p, unsigned v) { return __hip_atomic_fetch_add(p, v, __ATOMIC_RELAXED, __HIP_MEMORY_SCOPE_AGENT); }
__device__ __forceinline__ unsigned xb_xcc_id() { return (unsigned)__builtin_amdgcn_s_getreg((3 << 11) | 20) & 0xFu; }
#define XB_SPIN(cond, bar) do { unsigned _sp = 0; while (cond) { __builtin_amdgcn_s_sleep(1); \
    if ((++_sp & 255u) == 0u) { if (xb_ld(&(bar)[XB_TMO])) break; if (_sp > XB_SPIN_CAP) { atomicAdd(&(bar)[XB_TMO], 1u); break; } } } } while (0)

struct XcdBarrier { unsigned* bar; unsigned x; volatile LAS unsigned* st; };

__device__ __forceinline__ XcdBarrier xcd_barrier_post(unsigned* bar, volatile LAS unsigned* st) {
    XcdBarrier b; b.bar = bar; b.x = xb_xcc_id(); b.st = st;
    if (threadIdx.x == 0) (void)xb_add(&bar[XB_XCNT(b.x)], 1u);
    return b;
}
__device__ __forceinline__ void xcd_barrier_complete(unsigned* bar, unsigned x, unsigned& nloc, unsigned& nx) {
    const unsigned G = gridDim.x * gridDim.y * gridDim.z;
    unsigned sum, cnt, mine, sp = 0u;
    for (;;) {
        sum = 0u; cnt = 0u; mine = 0u;
#pragma unroll
        for (unsigned j = 0; j < 16; ++j) { const unsigned c = xb_ld(&bar[XB_XCNT(j)]); sum += c; cnt += (c > 0u) ? 1u : 0u; mine = (j == x) ? c : mine; }
        if (sum == G) break;
        __builtin_amdgcn_s_sleep(1);
        if ((++sp & 255u) == 0u) { if (xb_ld(&bar[XB_TMO])) break; if (sp > XB_SPIN_CAP) { atomicAdd(&bar[XB_TMO], 1u); break; } }
    }
    nloc = mine > 0u ? mine : 1u; nx = cnt > 0u ? cnt : 1u;
}
__device__ __forceinline__ void xcd_barrier(const XcdBarrier& b) {
    asm volatile("s_waitcnt vmcnt(0)" ::: "memory");
    __syncthreads();
    if (threadIdx.x == 0) {
        unsigned* bar = b.bar;
        __builtin_amdgcn_s_waitcnt(0);
        unsigned nloc = b.st[0], nx = b.st[1];
        if (nloc == 0u) { xcd_barrier_complete(bar, b.x, nloc, nx); b.st[0] = nloc; b.st[1] = nx; }
        const unsigned old = xb_add(&bar[XB_XSUB(b.x)], 1u);
        const unsigned gen = old / nloc;
        if (old + 1u == (gen + 1u) * nloc) {
            __builtin_amdgcn_fence(__ATOMIC_RELEASE, "agent");
            asm volatile("s_waitcnt vmcnt(0)" ::: "memory");
            const unsigned og = xb_add(&bar[XB_TOP], 1u);
            const unsigned tg = og / nx;
            if (og + 1u == (tg + 1u) * nx) xb_add(&bar[XB_TOPGEN], 1u);
            else XB_SPIN(xb_ld(&bar[XB_TOPGEN]) == tg, bar);
            __builtin_amdgcn_fence(__ATOMIC_ACQUIRE, "agent");
            xb_add(&bar[XB_XGEN(b.x)], 1u);
            asm volatile("s_waitcnt vmcnt(0)" ::: "memory");
        } else {
            XB_SPIN(xb_ld(&bar[XB_XGEN(b.x)]) == gen, bar);
            __builtin_amdgcn_fence(__ATOMIC_ACQUIRE, "agent");
            asm volatile("s_waitcnt vmcnt(0)" ::: "memory");
        }
    }
    __syncthreads();
}

namespace pg8 {
constexpr int BM = 256, BK = 64, HALF = 128, HTB = HALF * BK * 2, STAGE_BYTES = 8 * HTB, NXCD = 8, WGM = 8;
__host__ __device__ __forceinline__ int lds_byte(int r, int c) { const int st = (r >> 4) * 2 + (c >> 5), rr = r & 15, cc = c & 31, ob = rr * 64 + cc * 2; return st * 1024 + (ob ^ (((ob >> 9) & 1) << 5)); }
__host__ __device__ __forceinline__ void stage_rc(int b, int& R, int& C) { const int st = b / 1024, sb = b % 1024, swz = sb ^ (((sb >> 9) & 1) << 5); R = (st >> 1) * 16 + swz / 64; C = (st & 1) * 32 + (swz % 64) / 2; }
__host__ __device__ __forceinline__ int perm32(int rho) { const int n = rho >> 4, i = rho & 15; return 8 * (i >> 2) + 4 * n + (i & 3); }
struct Unit { int pm, pn, half, roff, sub; };
struct Gemm { int Kb, lda, ldb; };

__device__ __forceinline__ void order_map(int L, int nM, int nN, Unit& u) {
    const int nwg = nM * nN;
    int wgid = L; { const int q = nwg / NXCD, r = nwg % NXCD, xcd = wgid % NXCD, off = wgid / NXCD; wgid = (xcd < r ? xcd * (q + 1) : r * (q + 1) + (xcd - r) * q) + off; }
    const int nig = WGM * nN, gid = wgid / nig, fm = gid * WGM, gsz = (nM - fm) < WGM ? (nM - fm) : WGM;
    u.pm = fm + ((wgid % nig) % gsz); u.pn = (wgid % nig) / gsz; u.half = 0; u.roff = 0; u.sub = 0;
}
__device__ __forceinline__ bool order_next(int i, int G, int c, int nM, int nN, Unit& u) {
    const int nwg = nM * nN; const long L = (long)i * G + c; if (L >= nwg) return false;
    order_map((int)L, nM, nN, u); return true;
}
__device__ __forceinline__ unsigned cvt_pk_bf16(float lo, float hi) { unsigned r; asm volatile("v_cvt_pk_bf16_f32 %0, %1, %2" : "=v"(r) : "v"(lo), "v"(hi)); return r; }

typedef int v4i_t __attribute__((ext_vector_type(4)));
typedef int v8i_t __attribute__((ext_vector_type(8)));
template <class Epi, class Sched, bool FP8 = false, bool GATHER = false>
__device__ __forceinline__ void gemm_phase(LAS unsigned char* lds, const Gemm g, const Sched& S, const Epi& E) {
    const int tid = threadIdx.x, wid = __builtin_amdgcn_readfirstlane(tid >> 6), lane = tid & 63, wr = wid >> 2, wc = wid & 3, fr = lane & 15, fq = lane >> 4;
    const int nt0 = g.Kb / 128;
    unsigned vA0[2], vA1[2], nA0[2], nA1[2], voffB[2]; int RA[2], CA[2];
#pragma unroll
    for (int i = 0; i < 2; ++i) { int R, C; stage_rc(tid * 16 + i * 8192, R, C); const int Rb = Epi::PERM ? ((R & ~31) + perm32(R & 31)) : R;
        RA[i] = R; CA[i] = C * 2; voffB[i] = (unsigned)(Rb * g.ldb + C * 2);
        if constexpr (GATHER) { vA0[i] = (unsigned)(S.tok(0, R) * g.lda + C * 2); vA1[i] = (unsigned)(S.tok(0, HALF + R) * g.lda + C * 2); }
        else { vA0[i] = (unsigned)(R * g.lda + C * 2); vA1[i] = (unsigned)((HALF + R) * g.lda + C * 2); }
        nA0[i] = vA0[i]; nA1[i] = vA1[i]; }
    const size_t kstep = (size_t)(BK * 2);
    const size_t hstepB = (size_t)HALF * g.ldb;
    const unsigned ldsw = (unsigned)wid * 1024u;
    const int aoff = lds_byte(wr * 64 + fr, fq * 8), boff = lds_byte(wc * 32 + fr, fq * 8);
#define PG8_SA(b, h) (((b) * 2 + (h)) * HTB)
#define PG8_SB(b, h) ((4 + (b) * 2 + (h)) * HTB)
#define PG8_STAGE(bufoff, gbase, voff) do { _Pragma("unroll") for (int _i = 0; _i < 2; ++_i) \
        __builtin_amdgcn_global_load_lds((const unsigned*)((const char*)(gbase) + (voff)[_i]), (LAS unsigned*)(lds + (bufoff) + ldsw + _i * 8192), 16, 0, 0); } while (0)
#define PG8_LD8(p) __builtin_shufflevector(*(const LAS v4i_t*)(p), *(const LAS v4i_t*)((p) + 1024), 0, 1, 2, 3, 4, 5, 6, 7)
#define PG8_LDA(dst, b, h) do { _Pragma("unroll") for (int m = 0; m < 4; ++m) { if constexpr (FP8) dst##8[m] = PG8_LD8(lds + PG8_SA(b, h) + aoff + m * 2048); else { _Pragma("unroll") for (int k = 0; k < 2; ++k) dst[m][k] = *(const LAS bf16x8*)(lds + PG8_SA(b, h) + aoff + m * 2048 + k * 1024); } } } while (0)
#define PG8_LDB(dst, b, h) do { _Pragma("unroll") for (int n = 0; n < 2; ++n) { if constexpr (FP8) dst##8[n] = PG8_LD8(lds + PG8_SB(b, h) + boff + n * 2048); else { _Pragma("unroll") for (int k = 0; k < 2; ++k) dst[n][k] = *(const LAS bf16x8*)(lds + PG8_SB(b, h) + boff + n * 2048 + k * 1024); } } } while (0)
#define PG8_MMA(ai, bj, At, Bt) do { __builtin_amdgcn_s_setprio(1); _Pragma("unroll") for (int m = 0; m < 4; ++m) _Pragma("unroll") for (int n = 0; n < 2; ++n) { \
        if constexpr (FP8) asm volatile("v_mfma_f32_16x16x128_f8f6f4 %0, %1, %2, %0" : "+v"(acc[ai][bj][m][n]) : "v"(Bt##8[n]), "v"(At##8[m])); \
        else { _Pragma("unroll") for (int k = 0; k < 2; ++k) acc[ai][bj][m][n] = __builtin_amdgcn_mfma_f32_16x16x32_bf16(Bt[n][k], At[m][k], acc[ai][bj][m][n], 0, 0, 0); } } \
        __builtin_amdgcn_s_setprio(0); } while (0)
#define PG8_WAIT_V(n) asm volatile("s_waitcnt vmcnt(" #n ")" ::: "memory")
#define PG8_WAIT_L(n) asm volatile("s_waitcnt lgkmcnt(" #n ")" ::: "memory")
#define PG8_BAR __builtin_amdgcn_s_barrier()
#define PG8_SCHED __builtin_amdgcn_sched_barrier(0)
    Unit cur, nxt; int ui = 0;
    if (!S.next(0, cur)) return;
    f32x4 acc[2][2][4][2];
#pragma unroll
    for (int a = 0; a < 2; ++a)
#pragma unroll
        for (int b = 0; b < 2; ++b)
#pragma unroll
            for (int m = 0; m < 4; ++m)
#pragma unroll
                for (int n = 0; n < 2; ++n) acc[a][b][m][n] = (f32x4){0.f, 0.f, 0.f, 0.f};
    const int one_scale = 0x7f7f7f7f;
    bf16x8 At[4][2], B0[2][2], B1[2][2]; v8i_t At8[4], B08[2], B18[2];
    if constexpr (Epi::PREF) { cur.sub = 0; if (wid == 0) E.prefetch(cur, lane); }
    const char* cA = S.a_ptr(cur); const char* cB = S.b_ptr(cur);
    PG8_STAGE(PG8_SB(0, 0), cB, voffB); PG8_STAGE(PG8_SB(0, 1), cB + hstepB, voffB); PG8_STAGE(PG8_SA(0, 0), cA, vA0); PG8_STAGE(PG8_SA(0, 1), cA, vA1);
    if (wr == 1) PG8_BAR;
    PG8_WAIT_V(2); PG8_BAR;
    PG8_STAGE(PG8_SB(1, 0), cB + kstep, voffB); PG8_STAGE(PG8_SA(1, 0), cA + kstep, vA0); PG8_STAGE(PG8_SB(1, 1), cB + hstepB + kstep, voffB);
    PG8_WAIT_V(6); PG8_BAR;
    for (;;) {
        const bool has_next = S.next(ui + 1, nxt); const bool hf = __builtin_amdgcn_readfirstlane(cur.half) != 0;
        const char* nA = has_next ? S.a_ptr(nxt) : cA; const char* nB = has_next ? S.b_ptr(nxt) : cB;
        int nt = nt0; if constexpr (Epi::FUSED) nt = S.nt(ui);
        if constexpr (GATHER) { if (has_next) {
#pragma unroll
            for (int i = 0; i < 2; ++i) { nA0[i] = (unsigned)(S.tok(ui + 1, RA[i]) * g.lda + CA[i]); nA1[i] = (unsigned)(S.tok(ui + 1, HALF + RA[i]) * g.lda + CA[i]); } } }
#pragma unroll 1
        for (int t = 0; t < nt; t += 2) {
            const bool last = (t == nt - 2);
            const char* a1 = cA + (size_t)(t + 1) * kstep;
            const char* a2 = last ? nA : cA + (size_t)(t + 2) * kstep; const char* b2 = last ? nB : cB + (size_t)(t + 2) * kstep;
            const char* a3 = a2 + kstep; const char* b3 = b2 + kstep;
            unsigned sA0[2], sA1[2];
#pragma unroll
            for (int i = 0; i < 2; ++i) { sA0[i] = (GATHER && last) ? nA0[i] : vA0[i]; sA1[i] = (GATHER && last) ? nA1[i] : vA1[i]; }
            PG8_LDB(B0, 0, 0); PG8_LDB(B1, 0, 1); PG8_SCHED; PG8_LDA(At, 0, 0); PG8_STAGE(PG8_SA(1, 1), a1, vA1);
            PG8_WAIT_V(8); PG8_WAIT_L(0); PG8_BAR; PG8_MMA(0, 0, At, B0); PG8_MMA(0, 1, At, B1); PG8_BAR; PG8_SCHED;
            if (!hf) { PG8_LDA(At, 0, 1); } PG8_STAGE(PG8_SB(0, 0), b2, voffB); PG8_STAGE(PG8_SB(0, 1), b2 + hstepB, voffB); PG8_STAGE(PG8_SA(0, 0), a2, sA0);
            PG8_WAIT_V(8); PG8_WAIT_L(0); PG8_BAR; if (!hf) { PG8_MMA(1, 0, At, B0); PG8_MMA(1, 1, At, B1); } PG8_BAR; PG8_SCHED;
            PG8_LDB(B0, 1, 0); PG8_LDB(B1, 1, 1); PG8_SCHED; PG8_LDA(At, 1, 0); PG8_STAGE(PG8_SA(0, 1), a2, sA1);
            PG8_WAIT_V(8); PG8_WAIT_L(0); PG8_BAR; PG8_MMA(0, 0, At, B0); PG8_MMA(0, 1, At, B1); PG8_BAR; PG8_SCHED;
            if (!hf) { PG8_LDA(At, 1, 1); } PG8_STAGE(PG8_SB(1, 0), b3, voffB); PG8_STAGE(PG8_SB(1, 1), b3 + hstepB, voffB); PG8_STAGE(PG8_SA(1, 0), a3, sA0);
            PG8_WAIT_V(8); PG8_WAIT_L(0); PG8_BAR; if (!hf) { PG8_MMA(1, 0, At, B0); PG8_MMA(1, 1, At, B1); } PG8_BAR; PG8_SCHED;
        }
        if constexpr (Epi::PREF) { if (has_next) { nxt.sub = (ui + 1) & 1; if (wid == 0) E.prefetch(nxt, lane); } }
        if (wr == 0) PG8_BAR;
        if constexpr (FP8) asm volatile("s_nop 15\n\ts_nop 15" ::: "memory");
        bool keep = false;
        if constexpr (Epi::FUSED) { if ((ui & 1) == 0) { E.mid(acc, cur, wr, wc, fr, fq); keep = true; } else E(acc, cur, wr, wc, fr, fq); }
        else E(acc, cur, wr, wc, fr, fq);
        if (!has_next) break;
        if (!keep)
#pragma unroll
        for (int a = 0; a < 2; ++a)
#pragma unroll
            for (int b = 0; b < 2; ++b)
#pragma unroll
                for (int m = 0; m < 4; ++m)
#pragma unroll
                    for (int n = 0; n < 2; ++n) acc[a][b][m][n] = (f32x4){0.f, 0.f, 0.f, 0.f};
        cur = nxt; cA = nA; cB = nB; ++ui;
#pragma unroll
        for (int i = 0; i < 2; ++i) { vA0[i] = nA0[i]; vA1[i] = nA1[i]; }
        if (wr == 1) PG8_BAR;
    }
    PG8_WAIT_V(0);
    PG8_BAR;
#undef PG8_SA
#undef PG8_SB
#undef PG8_STAGE
#undef PG8_LDA
#undef PG8_LDB
#undef PG8_MMA
#undef PG8_LD8
#undef PG8_WAIT_V
#undef PG8_WAIT_L
#undef PG8_BAR
#undef PG8_SCHED
}
}
using pg8::Unit; using pg8::cvt_pk_bf16;

struct DenseOrder {
    int nM, nN, G, c; const char* A; const char* Bt; size_t astep, astepn, bstep;
    __device__ __forceinline__ bool next(int i, Unit& u) const { return pg8::order_next(i, G, c, nM, nN, u); }
    __device__ __forceinline__ const char* a_ptr(const Unit& u) const { return A + (size_t)u.pm * astep + (size_t)u.pn * astepn; }
    __device__ __forceinline__ const char* b_ptr(const Unit& u) const { return Bt + (size_t)u.pn * bstep; }
};
template <int PART> struct ProjOrder {
    int nM, G, c; const char* A; const char* Bt; size_t astep, bstep;
    __device__ __forceinline__ bool next(int i, Unit& u) const {
        if (PART == 0) { if (!pg8::order_next(i, G, c, nM, 9, u)) return false; }
        else {
            const int nwg = nM * 28, extra = (nM * 9) % G, full = nwg / G - 1; int L;
            if (i < full) L = i * G + c; else { if (c < extra) return false; L = full * G + (i - full) * (G - extra) + (c - extra); if (L >= nwg) return false; }
            pg8::order_map(L, nM, 28, u); }
        const int j = u.pn; u.pn = PART ? (j < 12 ? j : j + 4) : (j < 4 ? 12 + j : j < 8 ? 28 + j : 36); return true; }
    __device__ __forceinline__ const char* a_ptr(const Unit& u) const { return A + (size_t)u.pm * astep; }
    __device__ __forceinline__ const char* b_ptr(const Unit& u) const { return Bt + (size_t)(PART ? (u.pn < 12 ? u.pn : u.pn - 4) : u.pn) * bstep; }
};
struct MoeOrder {
    int nM, nN, G, c; const char* A; const char* Bt; size_t astep, bstep_e, bstep; const LAS int* tile_e; const LAS int* tokL; const LAS int* tile_rows; int split;
    __device__ __forceinline__ bool next(int i, Unit& u) const {
        const int nwg = nM * nN, nfull = split ? (nwg / G) * G : nwg, L = i * G + c;
        if (L < nfull) { pg8::order_map(L, nM, nN, u); u.half = tile_rows[u.pm] <= 128 ? 1 : 0; return true; }
        const int rem = nwg - nfull, idx = L - nfull;
        if (2 * rem <= G) { if (idx >= 2 * rem) return false; pg8::order_map(nfull + (idx >> 1), nM, nN, u); u.half = 1; u.roff = (idx & 1) * 128; return true; }
        if (L >= nwg) return false;
        pg8::order_map(L, nM, nN, u); u.half = tile_rows[u.pm] <= 128 ? 1 : 0; return true; }
    __device__ __forceinline__ const char* a_ptr(const Unit& u) const { return A + (size_t)u.pm * astep + (size_t)u.roff * (astep >> 8); }
    __device__ __forceinline__ const char* b_ptr(const Unit& u) const { return Bt + (size_t)tile_e[u.pm] * bstep_e + (size_t)u.pn * bstep; }
    __device__ __forceinline__ int tok(int ui, int r) const { return tokL[ui * 256 + r]; }
};

struct EpiProj {
    static constexpr bool PERM = true; static constexpr bool FUSED = false; static constexpr bool PREF = false;
    bf16 *Q, *K, *V, *U, *GL, *QI, *KW; const float* ropa; const float* ropi; float oscale;
    __device__ __forceinline__ void operator()(const f32x4 (&acc)[2][2][4][2], const Unit& u, int wr, int wc, int fr, int fq) const {
        const int pn = u.pn; bf16* base; int ldc, c0, mode = 0;
        if (pn < 8) { base = Q; ldc = 2048; c0 = pn * 256; mode = 1; }
        else if (pn < 10) { base = K; ldc = 512; c0 = (pn - 8) * 256; mode = 1; }
        else if (pn < 12) { base = V; ldc = 512; c0 = (pn - 10) * 256; }
        else if (pn < 16) { base = U; ldc = 1024; c0 = (pn - 12) * 256; }
        else if (pn < 32) { base = GL; ldc = 4096; c0 = (pn - 16) * 256; }
        else if (pn < 36) { base = QI; ldc = 1024; c0 = (pn - 32) * 256; mode = 2; }
        else { base = KW; ldc = 256; c0 = 0; mode = 3; }
        const int row0 = u.pm * 256 + wr * 64 + fr, col0 = c0 + wc * 32 + 8 * fq;
        const bool ropeA = (mode == 1) && (wc == 0);
        const bool ropeI = ((mode == 2) && ((wc & 1) == 0)) || ((mode == 3) && (wc == 0));
        const bool wsc = (mode == 3) && (wc == 2) && (fq < 2);
        const bool anyrope = ropeA || ropeI; const float* tab = ropeA ? ropa + 8 * (fq & 1) : ropi; const int tstride = ropeA ? 32 : 16, soff = ropeA ? 16 : 8;
        f32x4 tc[4];
        if (anyrope) { const float* cs = tab + (row0 & (SEQ - 1)) * tstride; tc[0] = *(const f32x4*)cs; tc[1] = *(const f32x4*)(cs + 4); tc[2] = *(const f32x4*)(cs + soff); tc[3] = *(const f32x4*)(cs + soff + 4); }
#pragma unroll
        for (int it = 0; it < 8; ++it) { const int ai = it >> 2, m = it & 3; const int row = row0 + ai * 128 + m * 16; bf16* rowp = base + (size_t)row * ldc + col0;
            v4u w[2];
#pragma unroll
            for (int bj = 0; bj < 2; ++bj) { f32x4 v0 = acc[ai][bj][m][0] * oscale, v1 = acc[ai][bj][m][1] * oscale;
                if (ropeA) {
                    const float sg = (fq < 2) ? -1.f : 1.f;
                    const f32x4 c0v = tc[0], c1v = tc[1], s0v = tc[2] * sg, s1v = tc[3] * sg;
                    f32x4 p0, p1;
#pragma unroll
                    for (int j = 0; j < 4; ++j) { p0[j] = __shfl_xor(v0[j], 32); p1[j] = __shfl_xor(v1[j], 32); }
                    v0 = v0 * c0v + p0 * s0v; v1 = v1 * c1v + p1 * s1v;
                } else if (ropeI && (mode == 2 || bj == 0)) {
                    const float sg = (fq == 0) ? -1.f : 1.f;
                    const f32x4 c0v = tc[0], c1v = tc[1], s0v = tc[2] * sg, s1v = tc[3] * sg;
                    f32x4 p0, p1;
#pragma unroll
                    for (int j = 0; j < 4; ++j) { p0[j] = __shfl_xor(v0[j], 16); p1[j] = __shfl_xor(v1[j], 16); }
                    if (fq < 2) { v0 = v0 * c0v + p0 * s0v; v1 = v1 * c1v + p1 * s1v; }
                } else if (wsc && bj == 0) { v0 = v0 * 0.03125f; v1 = v1 * 0.03125f; }
                w[bj].x = cvt_pk_bf16(v0[0], v0[1]); w[bj].y = cvt_pk_bf16(v0[2], v0[3]); w[bj].z = cvt_pk_bf16(v1[0], v1[1]); w[bj].w = cvt_pk_bf16(v1[2], v1[3]); }
            asm volatile("" ::: "memory");
            if (anyrope && it < 7) { const int rown = row0 + ((it + 1) >> 2) * 128 + ((it + 1) & 3) * 16; const float* cs = tab + (rown & (SEQ - 1)) * tstride;
                tc[0] = *(const f32x4*)cs; tc[1] = *(const f32x4*)(cs + 4); tc[2] = *(const f32x4*)(cs + soff); tc[3] = *(const f32x4*)(cs + soff + 4); }
            asm volatile("" ::: "memory");
            *(v4u*)rowp = w[0]; *(v4u*)(rowp + 128) = w[1];
            asm volatile("" ::: "memory"); }
    }
};
struct EpiPool {
    static constexpr bool PERM = true; static constexpr bool FUSED = false; static constexpr bool PREF = false;
    bf16* O; const float* scale;
    __device__ __forceinline__ void operator()(const f32x4 (&acc)[2][2][4][2], const Unit& u, int wr, int wc, int fr, int fq) const {
        const int row0 = u.pm * 256 + wr * 64 + fr, col0 = u.pn * 256 + wc * 32 + 8 * fq;
#pragma unroll
        for (int bj = 0; bj < 2; ++bj) {
            const f32x4 s0 = *(const f32x4*)(scale + col0 + bj * 128), s1 = *(const f32x4*)(scale + col0 + bj * 128 + 4);
#pragma unroll
            for (int ai = 0; ai < 2; ++ai)
#pragma unroll
                for (int m = 0; m < 4; ++m) { const size_t off = (size_t)(row0 + ai * 128 + m * 16) * 1024 + col0 + bj * 128;
                    const f32x4 v0 = acc[ai][bj][m][0] * s0, v1 = acc[ai][bj][m][1] * s1;
#if UPP_FP8
                    v2u w; w.x = pk4_fp8(v0[0], v0[1], v0[2], v0[3]); w.y = pk4_fp8(v1[0], v1[1], v1[2], v1[3]);
                    *(v2u*)((unsigned char*)O + off) = w;
#else
                    v4u w; w.x = cvt_pk_bf16(v0[0], v0[1]); w.y = cvt_pk_bf16(v0[2], v0[3]); w.z = cvt_pk_bf16(v1[0], v1[1]); w.w = cvt_pk_bf16(v1[2], v1[3]);
                    *(v4u*)(O + off) = w;
#endif
                }
            asm volatile("" ::: "memory"); }
    }
};
template <int MODE> struct EpiUp {
    static constexpr bool PERM = true; static constexpr bool FUSED = false; static constexpr bool PREF = false;
    float* TMP; bf16* MERGED; const bf16* GL;
    __device__ __forceinline__ void operator()(const f32x4 (&acc)[2][2][4][2], const Unit& u, int wr, int wc, int fr, int fq) const {
        const int row0 = u.pm * 256 + wr * 64 + fr, col0 = u.pn * 256 + wc * 32 + 8 * fq;
        constexpr float IS = MODE ? (UPA_FP8 ? 1.0f / (W8_SCALE * YA8_SCALE) : 1.0f) : (UPP_FP8 ? 1.0f / W8_SCALE : 1.0f), RIS = 1.0f / IS;
        v4u gwn[2], twn[2];
#pragma unroll
        for (int bj = 0; bj < 2; ++bj) { const size_t row = (size_t)row0; const int col = col0 + bj * 128;
            gwn[bj] = *(const v4u*)(GL + row * 4096 + (MODE ? 2048 : 0) + col); if (MODE) twn[bj] = *(const v4u*)((const bf16*)TMP + row * 2048 + col); }
#pragma unroll
        for (int it = 0; it < 8; ++it) { const int ai = it >> 2, m = it & 3; const size_t row = (size_t)(row0 + ai * 128 + m * 16);
            v4u gwc[2] = {gwn[0], gwn[1]}, twc[2]; if (MODE) { twc[0] = twn[0]; twc[1] = twn[1]; }
            if (it < 7) { const size_t rown = (size_t)(row0 + ((it + 1) >> 2) * 128 + ((it + 1) & 3) * 16);
#pragma unroll
                for (int bj = 0; bj < 2; ++bj) { const int col = col0 + bj * 128;
                    gwn[bj] = *(const v4u*)(GL + rown * 4096 + (MODE ? 2048 : 0) + col); if (MODE) twn[bj] = *(const v4u*)((const bf16*)TMP + rown * 2048 + col); } }
            asm volatile("" ::: "memory");
#pragma unroll
            for (int bj = 0; bj < 2; ++bj) { const int col = col0 + bj * 128;
                const unsigned gwv[4] = {gwc[bj].x, gwc[bj].y, gwc[bj].z, gwc[bj].w}; f32x2 gs[4];
#pragma unroll
                for (int q = 0; q < 4; ++q) { const f32x2 ea = (f32x2){lo16(gwv[q]), hi16(gwv[q])} * (f32x2){-1.4426950408889634f, -1.4426950408889634f};
                    const f32x2 den = (f32x2){__builtin_amdgcn_exp2f(ea.x), __builtin_amdgcn_exp2f(ea.y)} * (f32x2){RIS, RIS} + (f32x2){RIS, RIS};
                    gs[q] = (f32x2){__builtin_amdgcn_rcpf(den.x), __builtin_amdgcn_rcpf(den.y)}; }
                const f32x4 a0 = acc[ai][bj][m][0], a1 = acc[ai][bj][m][1];
                f32x2 p[4] = {(f32x2){a0[0], a0[1]} * gs[0], (f32x2){a0[2], a0[3]} * gs[1], (f32x2){a1[0], a1[1]} * gs[2], (f32x2){a1[2], a1[3]} * gs[3]};
                if (MODE == 0) { v4u w; w.x = cvt_pk_bf16(p[0].x, p[0].y); w.y = cvt_pk_bf16(p[1].x, p[1].y); w.z = cvt_pk_bf16(p[2].x, p[2].y); w.w = cvt_pk_bf16(p[3].x, p[3].y); *(v4u*)((bf16*)TMP + row * 2048 + col) = w; }
                else { const v4u tw = twc[bj]; p[0] += (f32x2){lo16(tw.x), hi16(tw.x)}; p[1] += (f32x2){lo16(tw.y), hi16(tw.y)}; p[2] += (f32x2){lo16(tw.z), hi16(tw.z)}; p[3] += (f32x2){lo16(tw.w), hi16(tw.w)};
#if OUT_FP8
                    v2u w; w.x = pk4_fp8(p[0].x, p[0].y, p[1].x, p[1].y); w.y = pk4_fp8(p[2].x, p[2].y, p[3].x, p[3].y);
                    *(v2u*)((unsigned char*)MERGED + row * 2048 + col) = w; }
#else
                    v4u w; w.x = cvt_pk_bf16(p[0].x, p[0].y); w.y = cvt_pk_bf16(p[1].x, p[1].y); w.z = cvt_pk_bf16(p[2].x, p[2].y); w.w = cvt_pk_bf16(p[3].x, p[3].y);
                    *(v4u*)(MERGED + row * 2048 + col) = w; }
#endif
            }
            asm volatile("" ::: "memory"); }
    }
};
struct UpOrder {
    int nM, nN, G, c; const char* A0; const char* A1; const char* B0; const char* B1;
    __device__ __forceinline__ bool next(int i, Unit& u) const { if (!pg8::order_next(i >> 1, G, c, nM, nN, u)) return false; u.sub = i & 1; return true; }
    __device__ __forceinline__ const char* a_ptr(const Unit& u) const { return u.sub ? A1 + (size_t)u.pm * (256 * 2048) : A0 + (size_t)u.pm * (256 * 1024); }
    __device__ __forceinline__ const char* b_ptr(const Unit& u) const { return (u.sub ? B1 : B0) + (size_t)u.pn * (256 * 2048); }
    __device__ __forceinline__ int tok(int ui, int r) const { return (ui & 1) ? 2 * r : r; }
    __device__ __forceinline__ int nt(int ui) const { return (ui & 1) ? 16 : 8; }
};
struct EpiUpF {
    static constexpr bool PERM = true; static constexpr bool FUSED = true; static constexpr bool PREF = false;
    bf16* MERGED; const bf16* GL;
    __device__ __forceinline__ void mid(f32x4 (&acc)[2][2][4][2], const Unit& u, int wr, int wc, int fr, int fq) const {
        const int row0 = u.pm * 256 + wr * 64 + fr, col0 = u.pn * 256 + wc * 32 + 8 * fq;
        constexpr float RS = (1.0f / W8_SCALE) / (1.0f / (W8_SCALE * YA8_SCALE));
        v4u an[2], bn[2];
#pragma unroll
        for (int bj = 0; bj < 2; ++bj) { const bf16* gp = GL + (size_t)row0 * 4096 + col0 + bj * 128; an[bj] = *(const v4u*)gp; bn[bj] = *(const v4u*)(gp + 2048); }
#pragma unroll
        for (int it = 0; it < 8; ++it) { const int ai = it >> 2, m = it & 3;
            v4u ac[2] = {an[0], an[1]}, bc[2] = {bn[0], bn[1]};
            if (it < 7) { const size_t rown = (size_t)(row0 + ((it + 1) >> 2) * 128 + ((it + 1) & 3) * 16);
#pragma unroll
                for (int bj = 0; bj < 2; ++bj) { const bf16* gp = GL + rown * 4096 + col0 + bj * 128; an[bj] = *(const v4u*)gp; bn[bj] = *(const v4u*)(gp + 2048); } }
            asm volatile("" ::: "memory");
#pragma unroll
            for (int bj = 0; bj < 2; ++bj) { const unsigned av[4] = {ac[bj].x, ac[bj].y, ac[bj].z, ac[bj].w}, bv[4] = {bc[bj].x, bc[bj].y, bc[bj].z, bc[bj].w};
#pragma unroll
                for (int q = 0; q < 4; ++q) { const f32x2 ea = (f32x2){lo16(av[q]), hi16(av[q])} * (f32x2){-1.4426950408889634f, -1.4426950408889634f}, eb = (f32x2){lo16(bv[q]), hi16(bv[q])} * (f32x2){-1.4426950408889634f, -1.4426950408889634f};
                    const f32x2 da = (f32x2){__builtin_amdgcn_exp2f(ea.x), __builtin_amdgcn_exp2f(ea.y)} + (f32x2){1.0f, 1.0f};
                    const f32x2 db = (f32x2){__builtin_amdgcn_exp2f(eb.x), __builtin_amdgcn_exp2f(eb.y)} * (f32x2){RS, RS} + (f32x2){RS, RS};
                    const f32x2 r = db * (f32x2){__builtin_amdgcn_rcpf(da.x), __builtin_amdgcn_rcpf(da.y)};
                    f32x4& t = acc[ai][bj][m][q >> 1];
                    if (q & 1) { t[2] *= r.x; t[3] *= r.y; } else { t[0] *= r.x; t[1] *= r.y; } } }
            asm volatile("" ::: "memory"); }
    }
    __device__ __forceinline__ void operator()(const f32x4 (&acc)[2][2][4][2], const Unit& u, int wr, int wc, int fr, int fq) const {
        const int row0 = u.pm * 256 + wr * 64 + fr, col0 = u.pn * 256 + wc * 32 + 8 * fq;
        constexpr float RIS = W8_SCALE * YA8_SCALE;
        v4u bn[2];
#pragma unroll
        for (int bj = 0; bj < 2; ++bj) bn[bj] = *(const v4u*)(GL + (size_t)row0 * 4096 + 2048 + col0 + bj * 128);
#pragma unroll
        for (int it = 0; it < 8; ++it) { const int ai = it >> 2, m = it & 3; const size_t row = (size_t)(row0 + ai * 128 + m * 16);
            v4u bc[2] = {bn[0], bn[1]};
            if (it < 7) { const size_t rown = (size_t)(row0 + ((it + 1) >> 2) * 128 + ((it + 1) & 3) * 16);
#pragma unroll
                for (int bj = 0; bj < 2; ++bj) bn[bj] = *(const v4u*)(GL + rown * 4096 + 2048 + col0 + bj * 128); }
            asm volatile("" ::: "memory");
#pragma unroll
            for (int bj = 0; bj < 2; ++bj) { const int col = col0 + bj * 128; const unsigned bv[4] = {bc[bj].x, bc[bj].y, bc[bj].z, bc[bj].w}; f32x2 gs[4];
#pragma unroll
                for (int q = 0; q < 4; ++q) { const f32x2 eb = (f32x2){lo16(bv[q]), hi16(bv[q])} * (f32x2){-1.4426950408889634f, -1.4426950408889634f};
                    const f32x2 den = (f32x2){__builtin_amdgcn_exp2f(eb.x), __builtin_amdgcn_exp2f(eb.y)} * (f32x2){RIS, RIS} + (f32x2){RIS, RIS};
                    gs[q] = (f32x2){__builtin_amdgcn_rcpf(den.x), __builtin_amdgcn_rcpf(den.y)}; }
                const f32x4 a0 = acc[ai][bj][m][0], a1 = acc[ai][bj][m][1];
                const f32x2 p[4] = {(f32x2){a0[0], a0[1]} * gs[0], (f32x2){a0[2], a0[3]} * gs[1], (f32x2){a1[0], a1[1]} * gs[2], (f32x2){a1[2], a1[3]} * gs[3]};
                v2u w; w.x = pk4_fp8(p[0].x, p[0].y, p[1].x, p[1].y); w.y = pk4_fp8(p[2].x, p[2].y, p[3].x, p[3].y);
                *(v2u*)((unsigned char*)MERGED + row * 2048 + col) = w; }
            asm volatile("" ::: "memory"); }
    }
};
struct EpiY16 {
    static constexpr bool PERM = true; static constexpr bool FUSED = false; static constexpr bool PREF = false;
    bf16* C;
    __device__ __forceinline__ void operator()(const f32x4 (&acc)[2][2][4][2], const Unit& u, int wr, int wc, int fr, int fq) const {
        const int row0 = u.pm * 256 + wr * 64 + fr, col0 = u.pn * 256 + wc * 32 + 8 * fq;
#pragma unroll
        for (int ai = 0; ai < 2; ++ai)
#pragma unroll
            for (int m = 0; m < 4; ++m) { bf16* rowp = C + (size_t)(row0 + ai * 128 + m * 16) * 2048 + col0;
#pragma unroll
                for (int bj = 0; bj < 2; ++bj) { constexpr float IS = OUT_FP8 ? 1.0f / W8_SCALE : 1.0f; const f32x4 v0 = acc[ai][bj][m][0] * IS, v1 = acc[ai][bj][m][1] * IS;
                    v4u w; w.x = cvt_pk_bf16(v0[0], v0[1]); w.y = cvt_pk_bf16(v0[2], v0[3]); w.z = cvt_pk_bf16(v1[0], v1[1]); w.w = cvt_pk_bf16(v1[2], v1[3]);
                    *(v4u*)(rowp + bj * 128) = w; } }
    }
};
struct EpiAct {
    static constexpr bool PERM = true; static constexpr bool FUSED = false; static constexpr bool PREF = true;
    unsigned char* ACT8; const float* b1; const LAS int* tile_e; LAS float* bslot;
    __device__ __forceinline__ void prefetch(const Unit& u, int lane) const {
        const int e = tile_e[u.pm]; const float* src = b1 + (size_t)e * 4096 + u.pn * 128 + (lane < 32 ? 4 * lane : 2048 + 4 * (lane - 32));
        __builtin_amdgcn_global_load_lds((const unsigned*)(const GAS float*)src, (LAS unsigned*)(bslot + __builtin_amdgcn_readfirstlane(u.sub) * 256), 16, 0, 0); }
    __device__ __forceinline__ void operator()(const f32x4 (&acc)[2][2][4][2], const Unit& u, int wr, int wc, int fr, int fq) const {
        const int row0 = u.pm * 256 + u.roff + wr * 64 + fr, col0 = u.pn * 128 + wc * 32 + 8 * fq;
        const LAS float* bs = bslot + u.sub * 256 + wc * 32 + 8 * fq;
        const f32x4 bg0 = *(const LAS f32x4*)bs, bg1 = *(const LAS f32x4*)(bs + 4), bl0 = *(const LAS f32x4*)(bs + 128), bl1 = *(const LAS f32x4*)(bs + 132);
        constexpr float IS = 1.0f / W8_SCALE;
#pragma unroll
        for (int ai = 0; ai < 2; ++ai) { if (ai == 1 && u.half) break;
#pragma unroll
            for (int m = 0; m < 4; ++m) { unsigned char* rowp = ACT8 + (size_t)(row0 + ai * 128 + m * 16) * 2048 + col0;
                f32x2 o[2][2];
#pragma unroll
                for (int n = 0; n < 2; ++n)
#pragma unroll
                    for (int h = 0; h < 2; ++h) { const f32x4 ga = acc[ai][0][m][n], la = acc[ai][1][m][n], bgn = n ? bg1 : bg0, bln = n ? bl1 : bl0;
                        const f32x2 gv = (f32x2){ga[2 * h], ga[2 * h + 1]} * (f32x2){IS, IS} + (f32x2){bgn[2 * h], bgn[2 * h + 1]};
                        const f32x2 lv = (f32x2){la[2 * h], la[2 * h + 1]} * (f32x2){IS, IS} + (f32x2){bln[2 * h], bln[2 * h + 1]};
                        const f32x2 gg = {__builtin_amdgcn_fmed3f(gv.x, -3.0e38f, 7.0f), __builtin_amdgcn_fmed3f(gv.y, -3.0e38f, 7.0f)};
                        const f32x2 ll = {__builtin_amdgcn_fmed3f(lv.x, -7.0f, 7.0f), __builtin_amdgcn_fmed3f(lv.y, -7.0f, 7.0f)};
                        const f32x2 ea = gg * (f32x2){-1.702f * 1.4426950408889634f, -1.702f * 1.4426950408889634f};
                        const f32x2 den = (f32x2){__builtin_amdgcn_exp2f(ea.x), __builtin_amdgcn_exp2f(ea.y)} + (f32x2){1.0f, 1.0f};
                        const f32x2 sg = {__builtin_amdgcn_rcpf(den.x), __builtin_amdgcn_rcpf(den.y)};
                        o[n][h] = (gg * sg) * (ll * (f32x2){ACT8_SCALE, ACT8_SCALE} + (f32x2){ACT8_SCALE, ACT8_SCALE}); }
                v2u w; w.x = pk4_fp8(o[0][0].x, o[0][0].y, o[0][1].x, o[0][1].y); w.y = pk4_fp8(o[1][0].x, o[1][0].y, o[1][1].x, o[1][1].y);
                *(v2u*)rowp = w; } }
    }
};
struct EpiYs {
    static constexpr bool PERM = true; static constexpr bool FUSED = false; static constexpr bool PREF = true;
    unsigned char* YS8; const float* b2; const LAS int* tile_e; LAS float* bslot;
    __device__ __forceinline__ void prefetch(const Unit& u, int lane) const {
        const int e = tile_e[u.pm]; const float* src = b2 + (size_t)e * 2048 + u.pn * 256 + 4 * lane;
        __builtin_amdgcn_global_load_lds((const unsigned*)(const GAS float*)src, (LAS unsigned*)(bslot + __builtin_amdgcn_readfirstlane(u.sub) * 256), 16, 0, 0); }
    __device__ __forceinline__ void operator()(const f32x4 (&acc)[2][2][4][2], const Unit& u, int wr, int wc, int fr, int fq) const {
        const int row0 = u.pm * 256 + u.roff + wr * 64 + fr, col0 = u.pn * 256 + wc * 32 + 8 * fq;
        const LAS float* bs = bslot + u.sub * 256 + wc * 32 + 8 * fq;
        f32x4 bv[2][2];
#pragma unroll
        for (int bj = 0; bj < 2; ++bj)
#pragma unroll
            for (int n = 0; n < 2; ++n) bv[bj][n] = *(const LAS f32x4*)(bs + bj * 128 + 4 * n) * YS8_SCALE;
#pragma unroll
        for (int ai = 0; ai < 2; ++ai) { if (ai == 1 && u.half) break;
#pragma unroll
            for (int m = 0; m < 4; ++m) { unsigned char* rowp = YS8 + (size_t)(row0 + ai * 128 + m * 16) * 2048 + col0;
#pragma unroll
                for (int bj = 0; bj < 2; ++bj) { constexpr float IS = YS8_SCALE / (W8_SCALE * ACT8_SCALE); const f32x4 v0 = acc[ai][bj][m][0] * IS + bv[bj][0], v1 = acc[ai][bj][m][1] * IS + bv[bj][1];
                    v2u w; w.x = pk4_fp8(v0[0], v0[1], v0[2], v0[3]); w.y = pk4_fp8(v1[0], v1[1], v1[2], v1[3]);
                    *(v2u*)(rowp + bj * 128) = w; } } }
    }
};


typedef float f32x16 __attribute__((ext_vector_type(16)));
#define DPP_ADD(v, ctrl) v += __builtin_amdgcn_update_dpp(0, v, ctrl, 0xF, 0xF, true)
__device__ __forceinline__ void indexer_task(const bf16* QI, const bf16* KW, unsigned* MW, int b, int tp, int tmaxb, LAS unsigned char* lds, int wave, int lane_in) {
    int lane = lane_in; asm volatile("" : "+v"(lane));
    const int c = lane & 31, kg = lane >> 5;
    const int t0 = 2 * tp; const size_t rowbase = (size_t)b * SEQ;
    const int arow_q = (c >> 2) & 1, ahead = 4 * (c >> 3) + (c & 3);
    const bf16* qa = QI + (rowbase + t0 + arow_q) * 1024 + ahead * 64 + 8 * kg;
    bf16x8 af[4];
#pragma unroll
    for (int kk = 0; kk < 4; ++kk) af[kk] = *(const bf16x8*)(qa + 16 * kk);
    float wf[16];
    { const bf16* wp = KW + (rowbase + t0 + kg) * 256 + 64; const v4u w0 = *(const v4u*)wp, w1 = *(const v4u*)(wp + 8);
      wf[0] = lo16(w0.x); wf[1] = hi16(w0.x); wf[2] = lo16(w0.y); wf[3] = hi16(w0.y); wf[4] = lo16(w0.z); wf[5] = hi16(w0.z); wf[6] = lo16(w0.w); wf[7] = hi16(w0.w);
      wf[8] = lo16(w1.x); wf[9] = hi16(w1.x); wf[10] = lo16(w1.y); wf[11] = hi16(w1.y); wf[12] = lo16(w1.z); wf[13] = hi16(w1.z); wf[14] = lo16(w1.w); wf[15] = hi16(w1.w); }
    asm volatile("s_waitcnt vmcnt(0)" ::: "memory");
    const int tq = t0 + kg, maxblk = (t0 + 1) >> 5;
    const bf16* dsrc = KW + (rowbase + 64 * wave + (lane >> 3)) * 256 + (((lane & 7) ^ ((lane >> 3) & 7)) * 8);
#define IDX_DMA(ch) do { _Pragma("unroll") for (int i_ = 0; i_ < 8; ++i_) \
        __builtin_amdgcn_global_load_lds((const unsigned*)(dsrc + ((size_t)(512 * (ch)) + 8 * i_) * 256), (LAS unsigned*)(lds + ((ch) & 1) * 65536 + (64 * wave + 8 * i_) * 128), 16, 0, 0); } while (0)
    const int krd = c * 128;
    unsigned key[64];
    IDX_DMA(0);
#pragma unroll
    for (int ch = 0; ch < 4; ++ch) {
        if (512 * ch <= tmaxb) {
            if (512 * (ch + 1) <= tmaxb) { IDX_DMA(ch + 1); asm volatile("s_waitcnt vmcnt(8)" ::: "memory"); }
            else asm volatile("s_waitcnt vmcnt(0)" ::: "memory");
            __builtin_amdgcn_s_barrier(); asm volatile("" ::: "memory");
            const LAS unsigned char* kb_ = lds + (ch & 1) * 65536 + krd;
#pragma unroll
            for (int bi = 0; bi < 16; ++bi) { const int blk = ch * 16 + bi;
                key[blk] = 0u;
                if (blk <= maxblk) {
                    f32x16 acc = {};
#pragma unroll
                    for (int kk = 0; kk < 4; ++kk) { const bf16x8 bf = *(const LAS bf16x8*)(kb_ + bi * 4096 + (((2 * kk + kg) ^ (c & 7)) * 16));
                        acc = __builtin_amdgcn_mfma_f32_32x32x16_bf16(af[kk], bf, acc, 0, 0, 0); }
                    float sc = 0.f;
#pragma unroll
                    for (int i = 0; i < 16; ++i) sc = __builtin_fmaf(wf[i], __builtin_amdgcn_fmed3f(acc[i], 0.f, 3.0e38f), sc);
                    const unsigned u = __float_as_uint(sc); const unsigned k2 = (u >> 31) ? ~u : (u | 0x80000000u);
                    key[blk] = (blk * 32 + c <= tq) ? k2 : 0u;
                }
            }
            asm volatile("s_waitcnt lgkmcnt(0)" ::: "memory"); __builtin_amdgcn_s_barrier(); asm volatile("" ::: "memory");
        } else {
#pragma unroll
            for (int bi = 0; bi < 16; ++bi) key[ch * 16 + bi] = 0u;
        }
    }
#undef IDX_DMA
    unsigned tau = 0u; bool act = (tq + 1) > NKEEP, exact = false;
    for (int bit = 31; bit >= 0; --bit) {
        if (!__any(act)) break;
        const unsigned cand = tau | (1u << bit);
        int cnt = 0;
#pragma unroll
        for (int g4 = 0; g4 < 4; ++g4) { if (16 * g4 <= maxblk) {
#pragma unroll
            for (int bi = 0; bi < 16; bi += 4) {
                unsigned long long m0, m1, m2, m3;
                asm volatile("v_cmp_ge_u32_e64 %1, %5, %9\n\tv_cmp_ge_u32_e64 %2, %6, %9\n\tv_cmp_ge_u32_e64 %3, %7, %9\n\tv_cmp_ge_u32_e64 %4, %8, %9\n\t"
                             "v_addc_co_u32_e64 %0, %1, %0, 0, %1\n\tv_addc_co_u32_e64 %0, %2, %0, 0, %2\n\tv_addc_co_u32_e64 %0, %3, %0, 0, %3\n\tv_addc_co_u32_e64 %0, %4, %0, 0, %4"
                             : "+v"(cnt), "=&s"(m0), "=&s"(m1), "=&s"(m2), "=&s"(m3)
                             : "v"(key[16 * g4 + bi]), "v"(key[16 * g4 + bi + 1]), "v"(key[16 * g4 + bi + 2]), "v"(key[16 * g4 + bi + 3]), "v"(cand)); } } }
        DPP_ADD(cnt, 0x128); DPP_ADD(cnt, 0x124); DPP_ADD(cnt, 0x122); DPP_ADD(cnt, 0x121);
        const int r0 = __builtin_amdgcn_readlane(cnt, 0), r1 = __builtin_amdgcn_readlane(cnt, 16), r2 = __builtin_amdgcn_readlane(cnt, 32), r3 = __builtin_amdgcn_readlane(cnt, 48);
        const int tot = kg ? (r2 + r3) : (r0 + r1);
        if (act && tot >= NKEEP) tau = cand;
        if (act && tot == NKEEP) { act = false; exact = true; }
    }
    int need = 0; const bool anyt = __any(act);
    if (anyt) {
        int cnt = 0; const unsigned cand = tau + 1u;
#pragma unroll
        for (int blk = 0; blk < 64; ++blk) cnt += (key[blk] >= cand) ? 1 : 0;
        DPP_ADD(cnt, 0x128); DPP_ADD(cnt, 0x124); DPP_ADD(cnt, 0x122); DPP_ADD(cnt, 0x121);
        const int r0 = __builtin_amdgcn_readlane(cnt, 0), r1 = __builtin_amdgcn_readlane(cnt, 16), r2 = __builtin_amdgcn_readlane(cnt, 32), r3 = __builtin_amdgcn_readlane(cnt, 48);
        const int tot = kg ? (r2 + r3) : (r0 + r1);
        need = act ? NKEEP - tot : 0;
    }
    const unsigned tauX = act ? tau : (exact ? tau - 1u : 0u);
    unsigned mA = 0u, mB = 0u; int tiesb = 0;
#pragma unroll
    for (int blk = 0; blk < 64; ++blk) {
        if (blk <= maxblk) {
            bool sel = key[blk] > tauX;
            if (anyt) {
                const bool eq = act && key[blk] == tauX;
                const unsigned long long em = __ballot(eq);
                const unsigned e32 = kg ? (unsigned)(em >> 32) : (unsigned)em;
                const int rank = tiesb + __popc(e32 & ((1u << c) - 1u));
                sel = sel || (eq && rank < need);
                tiesb += __popc(e32);
            }
            const unsigned long long sm = __ballot(sel);
            if (lane == blk) { mA = (unsigned)sm; mB = (unsigned)(sm >> 32); }
        }
    }
    MW[(rowbase + t0) * 64 + lane] = mA; MW[(rowbase + t0 + 1) * 64 + lane] = mB;
}

namespace att {
constexpr int NW = 8, QBLK = 32, KVBLK = 64;
constexpr float SCALE = 0.088388347648318440f, THR = 8.f;
constexpr int LDQ = 2048, LDK = 512, LDO = 2048;
constexpr int SHM_V = KVBLK * 128 * 2, SHM_K = KVBLK * 128 * 2, SHM_ATTN = 2 * SHM_V + 2 * SHM_K + NW * 64 * 4;
typedef short s16x4 __attribute__((ext_vector_type(4)));
#define KSWZ(row, colB) ((row) * 256 + ((colB) ^ (((row) & 7) << 4)))
#define SBAR() __builtin_amdgcn_sched_barrier(0)
__device__ __forceinline__ int crow(int r, int hi) { return (r & 3) + 8 * (r >> 2) + 4 * hi; }
__device__ __forceinline__ unsigned cvtpk(float lo, float hi) { unsigned r; asm volatile("v_cvt_pk_bf16_f32 %0, %1, %2" : "=v"(r) : "v"(lo), "v"(hi)); return r; }
__device__ __forceinline__ void partialSM(f32x16& p0, f32x16& p1, float& m_reg, float& mn, float& alpha) {
  constexpr float C = SCALE * 1.4426950408889634f;
  float pmax = p0[0]; for (int r = 1; r < 16; ++r) pmax = fmaxf(pmax, p0[r]); for (int r = 0; r < 16; ++r) pmax = fmaxf(pmax, p1[r]);
  { auto rr = __builtin_amdgcn_permlane32_swap(__float_as_uint(pmax), __float_as_uint(pmax), false, false);
    pmax = fmaxf(__uint_as_float(rr[0]), __uint_as_float(rr[1])); }
  if (__builtin_expect(__all(pmax - m_reg <= THR / SCALE), 1)) { mn = m_reg; alpha = 1.f; }
  else { mn = fmaxf(m_reg, pmax); alpha = __builtin_amdgcn_exp2f((m_reg - mn) * C); m_reg = mn; }
  float mnC = -mn * C;
  for (int r = 0; r < 16; ++r) p0[r] = fmaf(p0[r], C, mnC); for (int r = 0; r < 16; ++r) p1[r] = fmaf(p1[r], C, mnC);
  for (int r = 0; r < 16; ++r) p0[r] = __builtin_amdgcn_exp2f(p0[r]);
}
__device__ __forceinline__ void finishSM(f32x16& p0, f32x16& p1, float alpha, float& l_reg, bf16x8& pa0, bf16x8& pa1, bf16x8& pa2, bf16x8& pa3) {
  for (int r = 0; r < 16; ++r) p1[r] = __builtin_amdgcn_exp2f(p1[r]);
  float ps = 0; for (int r = 0; r < 16; ++r) ps += p0[r]; for (int r = 0; r < 16; ++r) ps += p1[r];
  { auto rr = __builtin_amdgcn_permlane32_swap(__float_as_uint(ps), __float_as_uint(ps), false, false);
    ps = __uint_as_float(rr[0]) + __uint_as_float(rr[1]); }
  l_reg = l_reg * alpha + ps;
#define PK4(P, BASE, OUT) do { unsigned a0 = cvtpk(P[BASE + 0], P[BASE + 1]), a1 = cvtpk(P[BASE + 2], P[BASE + 3]);   \
    unsigned b0 = cvtpk(P[BASE + 4], P[BASE + 5]), b1 = cvtpk(P[BASE + 6], P[BASE + 7]);                              \
    auto r0 = __builtin_amdgcn_permlane32_swap(a0, b0, false, false); auto r1 = __builtin_amdgcn_permlane32_swap(a1, b1, false, false); \
    v4u w = {r0[0], r1[0], r0[1], r1[1]}; OUT = *reinterpret_cast<bf16x8*>(&w); } while (0)
  PK4(p0, 0, pa0); PK4(p0, 8, pa1); PK4(p1, 0, pa2); PK4(p1, 8, pa3);
#undef PK4
}
__device__ __forceinline__ void qkt(f32x16& p0, f32x16& p1, const char* Ks, const bf16x8* qr, int r32, int hi) {
  p0 = f32x16{}; p1 = f32x16{};
  for (int d0 = 0; d0 < 8; ++d0) { int cb = (d0 * 16 + hi * 8) * 2;
    bf16x8 b0 = *reinterpret_cast<const bf16x8*>(Ks + KSWZ(r32, cb));
    bf16x8 b1 = *reinterpret_cast<const bf16x8*>(Ks + KSWZ(32 + r32, cb));
    p0 = __builtin_amdgcn_mfma_f32_32x32x16_bf16(b0, qr[d0], p0, 0, 0, 0);
    p1 = __builtin_amdgcn_mfma_f32_32x32x16_bf16(b1, qr[d0], p1, 0, 0, 0); }
}
__device__ __forceinline__ void mask_apply(f32x16& p0, f32x16& p1, unsigned m0, unsigned m1) {
#pragma unroll
  for (int r = 0; r < 16; ++r) { const int cb = (r & 3) + 8 * (r >> 2);
    const unsigned s0 = (unsigned)(((int)(m0 << (31 - cb))) >> 31), s1 = (unsigned)(((int)(m1 << (31 - cb))) >> 31);
    p0[r] = __uint_as_float((__float_as_uint(p0[r]) & s0) | (0xFF800000u & ~s0));
    p1[r] = __uint_as_float((__float_as_uint(p1[r]) & s1) | (0xFF800000u & ~s1)); }
}
__device__ __forceinline__ int v_st(int k, int c) { const int kk = (k & ~0xC) | ((k & 4) << 1) | ((k & 8) >> 1); return ((kk >> 3) * 4 + (c >> 5)) * 512 + ((kk & 7) * 32 + (c & 31)) * 2; }
__device__ __forceinline__ int v_rd_base(int lane) { return ((lane & 3) << 3) | (((lane >> 2) & 3) << 6) | (((lane >> 4) & 1) << 5) | (((lane >> 5) & 1) << 8); }
constexpr int v_rd_off(int d0, int ks, int half) { return d0 * 512 + ks * 4096 + half * 2048; }
template <int OFF> __device__ __forceinline__ s16x4 tr_read(int vb) {
  s16x4 r; asm volatile("ds_read_b64_tr_b16 %0, %1 offset:%2" : "=&v"(r) : "v"(vb), "i"(OFF) : "memory"); return r;
}
template <int D0> __device__ __forceinline__ void pv_one(f32x16& od, int vb, bf16x8 pa0, bf16x8 pa1, bf16x8 pa2, bf16x8 pa3) {
  const s16x4 l0 = tr_read<v_rd_off(D0, 0, 0)>(vb), h0 = tr_read<v_rd_off(D0, 0, 1)>(vb), l1 = tr_read<v_rd_off(D0, 1, 0)>(vb), h1 = tr_read<v_rd_off(D0, 1, 1)>(vb);
  const s16x4 l2 = tr_read<v_rd_off(D0, 2, 0)>(vb), h2 = tr_read<v_rd_off(D0, 2, 1)>(vb), l3 = tr_read<v_rd_off(D0, 3, 0)>(vb), h3 = tr_read<v_rd_off(D0, 3, 1)>(vb);
  asm volatile("s_waitcnt lgkmcnt(0)" ::: "memory"); SBAR();
#define PK(L, H) (bf16x8){L[0], L[1], L[2], L[3], H[0], H[1], H[2], H[3]}
  od = __builtin_amdgcn_mfma_f32_32x32x16_bf16(pa0, PK(l0, h0), od, 0, 0, 0);
  od = __builtin_amdgcn_mfma_f32_32x32x16_bf16(pa1, PK(l1, h1), od, 0, 0, 0);
  od = __builtin_amdgcn_mfma_f32_32x32x16_bf16(pa2, PK(l2, h2), od, 0, 0, 0);
  od = __builtin_amdgcn_mfma_f32_32x32x16_bf16(pa3, PK(l3, h3), od, 0, 0, 0);
#undef PK
}
__device__ __forceinline__ void pv_d0(f32x16* o, int vb, bf16x8 pa0, bf16x8 pa1, bf16x8 pa2, bf16x8 pa3) {
  pv_one<0>(o[0], vb, pa0, pa1, pa2, pa3); pv_one<1>(o[1], vb, pa0, pa1, pa2, pa3); pv_one<2>(o[2], vb, pa0, pa1, pa2, pa3); pv_one<3>(o[3], vb, pa0, pa1, pa2, pa3);
}
constexpr int ATT_K0 = 0, ATT_V0 = 2 * SHM_K, ATT_WS = ATT_V0 + 3 * SHM_V, ATT_M0 = ATT_WS + NW * 64 * 4, ATT_END = ATT_M0 + 65536;
__device__ __forceinline__ void attn_masked_body(const bf16* __restrict__ Qb, const bf16* __restrict__ Kh, const bf16* __restrict__ Vh, bf16* __restrict__ Ob,
                                                 const unsigned* __restrict__ Mq, int seq, LAS unsigned char* ldsl) {
  char* lds = (char*)ldsl;
  int tid = threadIdx.x; asm volatile("" : "+v"(tid));
  const int wid = __builtin_amdgcn_readfirstlane(tid >> 6), lane = tid & 63, r32 = lane & 31, hi = lane >> 5;
  char* K_lds = lds + ATT_K0; char* V_lds = lds + ATT_V0;
  float* ws = (float*)(lds + ATT_WS) + wid * 64; float* li_l = ws; float* al_l = ws + 32;
  float m_reg = -1e30f, l_reg = 0; f32x16 o[4] = {}; bf16x8 qr[8];
  const int NT = seq / KVBLK, sh4 = 4 * hi;
  unsigned offK[2], offV[2];
#pragma unroll
  for (int q = 0; q < 2; ++q) {
      const int krow = 8 * wid + 4 * q + (lane >> 4);
      offK[q] = (unsigned)((krow * LDK + 8 * ((lane & 15) ^ (krow & 7))) * 2);
      const int kk = 8 * wid + ((lane & 31) >> 2), vk = (kk & ~0xC) | ((kk & 4) << 1) | ((kk & 8) >> 1);
      offV[q] = (unsigned)((vk * LDK + 32 * (2 * q + (lane >> 5)) + 8 * (lane & 3)) * 2);
  }
#define DMA_TILE(t, kbuf, vbuf) do { const char* kt_ = (const char*)Kh + (size_t)(t) * (KVBLK * LDK * 2); const char* vt_ = (const char*)Vh + (size_t)(t) * (KVBLK * LDK * 2); \
    _Pragma("unroll") for (int q_ = 0; q_ < 2; ++q_) { \
      __builtin_amdgcn_global_load_lds((const unsigned*)(kt_ + offK[q_]), (LAS unsigned*)(ldsl + ATT_K0 + (kbuf) * SHM_K + (2 * wid + q_) * 1024), 16, 0, 0); \
      __builtin_amdgcn_global_load_lds((const unsigned*)(vt_ + offV[q_]), (LAS unsigned*)(ldsl + ATT_V0 + (vbuf) * SHM_V + (2 * wid + q_) * 1024), 16, 0, 0); } } while (0)
#define TILE_SYNC() do { asm volatile("s_waitcnt vmcnt(0)" ::: "memory"); __builtin_amdgcn_s_barrier(); asm volatile("" ::: "memory"); } while (0)
  DMA_TILE(0, 0, 0);
  const bf16* Qw = Qb + (long)(wid * QBLK + r32) * LDQ + hi * 8;
#pragma unroll
  for (int d0 = 0; d0 < 8; ++d0) qr[d0] = *reinterpret_cast<const bf16x8*>(Qw + d0 * 16);
  char* M_lds = lds + ATT_M0;
  { v2u mw[32];
#pragma unroll
    for (int rr = 0; rr < 32; ++rr) { const int r = wid * QBLK + rr; mw[rr] = (lane < NT) ? ((const v2u*)(Mq + (size_t)r * 64))[lane] : (v2u){0u, 0u}; }
#pragma unroll
    for (int rr = 0; rr < 32; ++rr) { const int r = wid * QBLK + rr; if (lane < NT) *(v2u*)(M_lds + r * 256 + ((lane ^ rr) << 3)) = mw[rr]; } }
  const char* mrow = M_lds + (wid * QBLK + r32) * 256;
#define MLOAD(j) (*(const v2u*)(mrow + ((((j)) ^ r32) << 3)))
  const int vbase = (int)(uintptr_t)V_lds + v_rd_base(lane);
#define RESC(a) do { if (__any((a) < 1.f)) { if (hi == 0) al_l[r32] = (a); asm volatile("s_waitcnt lgkmcnt(0)" ::: "memory"); \
    for (int d = 0; d < 4; ++d) for (int r = 0; r < 16; ++r) o[d][r] *= al_l[crow(r, hi)]; } } while (0)
  f32x16 pA0, pA1, pB0, pB1; float mnA, mnB, alA, alB; bf16x8 pa0, pa1, pa2, pa3;
  TILE_SYNC();
  DMA_TILE(1, 1, 1);
  qkt(pA0, pA1, K_lds, qr, r32, hi); { const v2u mk = MLOAD(0); mask_apply(pA0, pA1, mk.x >> sh4, mk.y >> sh4); } partialSM(pA0, pA1, m_reg, mnA, alA);
  TILE_SYNC();
  int vprev = 0;
  for (int j = 1; j + 1 < NT; j += 2) {
    const int vcur = vprev == 2 ? 0 : vprev + 1, vnxt = vcur == 2 ? 0 : vcur + 1;
    DMA_TILE(j + 1, 0, vnxt);
    SBAR(); qkt(pB0, pB1, K_lds + SHM_K, qr, r32, hi);
    finishSM(pA0, pA1, alA, l_reg, pa0, pa1, pa2, pa3); SBAR();
    pv_d0(o, vbase + vprev * (int)SHM_V, pa0, pa1, pa2, pa3); { const v2u mk = MLOAD(j); mask_apply(pB0, pB1, mk.x >> sh4, mk.y >> sh4); } partialSM(pB0, pB1, m_reg, mnB, alB);
    RESC(alB); TILE_SYNC();
    DMA_TILE(j + 2, 1, vprev);
    SBAR(); qkt(pA0, pA1, K_lds, qr, r32, hi);
    finishSM(pB0, pB1, alB, l_reg, pa0, pa1, pa2, pa3); SBAR();
    pv_d0(o, vbase + vcur * (int)SHM_V, pa0, pa1, pa2, pa3); { const v2u mk = MLOAD(j + 1); mask_apply(pA0, pA1, mk.x >> sh4, mk.y >> sh4); } partialSM(pA0, pA1, m_reg, mnA, alA);
    RESC(alA); TILE_SYNC();
    vprev = vnxt;
  }
  { const int vcur = vprev == 2 ? 0 : vprev + 1;
    SBAR(); qkt(pB0, pB1, K_lds + SHM_K, qr, r32, hi);
    finishSM(pA0, pA1, alA, l_reg, pa0, pa1, pa2, pa3); SBAR();
    pv_d0(o, vbase + vprev * (int)SHM_V, pa0, pa1, pa2, pa3); { const v2u mk = MLOAD(NT - 1); mask_apply(pB0, pB1, mk.x >> sh4, mk.y >> sh4); } partialSM(pB0, pB1, m_reg, mnB, alB);
    RESC(alB);
    finishSM(pB0, pB1, alB, l_reg, pa0, pa1, pa2, pa3); SBAR();
    pv_d0(o, vbase + vcur * (int)SHM_V, pa0, pa1, pa2, pa3); }
  if (hi == 0) li_l[r32] = l_reg; asm volatile("s_waitcnt lgkmcnt(0)" ::: "memory");
  float rli[16];
#pragma unroll
  for (int r = 0; r < 16; ++r) rli[r] = __builtin_amdgcn_rcpf(li_l[crow(r, hi)]);
  bf16* Ow = Ob + (long)(wid * QBLK) * LDO;
#pragma unroll
  for (int r = 0; r < 16; ++r) { const int orow = crow(r, hi);
#pragma unroll
    for (int d0 = 0; d0 < 4; ++d0) { const float v = o[d0][r] * rli[r];
#if UPA_FP8
      ((unsigned char*)Ob)[(long)(wid * QBLK + orow) * LDO + d0 * 32 + r32] = (unsigned char)(__builtin_amdgcn_cvt_pk_fp8_f32(v * YA8_SCALE, 0.f, 0, false) & 0xff);
#else
      const float vn = __shfl_xor(v, 1);
      if ((r32 & 1) == 0) *(unsigned*)(Ow + (long)orow * LDO + d0 * 32 + r32) = cvtpk(v, vn);
#endif
    } }
  (void)Ow;
#undef DMA_TILE
#undef TILE_SYNC
#undef RESC
#undef MLOAD
}
#undef KSWZ
#undef SBAR
}

struct Args { const float* in[20]; float* out; unsigned char* ws; float inv_a[16]; float inv_i[8]; int ph_lo, ph_hi; };
enum { I_X = 0, I_C, I_WADA, I_BADA, I_GPREMIX, I_GPOSTMIX, I_WIN, I_WPOOL, I_POOLSCALE, I_WUPP, I_WUPA, I_WOUT, I_GPREFFN, I_GPOSTFFN, I_WROUTER, I_BROUTER, I_W1, I_B1, I_W2, I_B2 };

__device__ __forceinline__ void tr_item(const float* W, int ldw, int nvalid, bf16* WT, int ldt, LAS float* scr, int lane) {
    const int kr = lane >> 3, n4 = (lane & 7) * 4;
    f32x4 v[8];
#pragma unroll
    for (int i = 0; i < 8; ++i) v[i] = (n4 < nvalid) ? *(const f32x4*)(W + (size_t)(8 * i + kr) * ldw + n4) : (f32x4){0.f, 0.f, 0.f, 0.f};
#pragma unroll
    for (int i = 0; i < 8; ++i) { LAS float* d = scr + (8 * i + kr) * 33 + n4; d[0] = v[i].x; d[1] = v[i].y; d[2] = v[i].z; d[3] = v[i].w; }
    LDS_WAIT(); asm volatile("" ::: "memory");
    const int c = lane & 7;
#pragma unroll
    for (int j = 0; j < 4; ++j) { const int n = (lane >> 3) + 8 * j; const LAS float* s = scr + (8 * c) * 33 + n;
        v4u o; o.x = pk2(s[0 * 33], s[1 * 33]); o.y = pk2(s[2 * 33], s[3 * 33]); o.z = pk2(s[4 * 33], s[5 * 33]); o.w = pk2(s[6 * 33], s[7 * 33]);
        *(v4u*)(WT + (size_t)n * ldt + 8 * c) = o; }
    LDS_WAIT(); asm volatile("" ::: "memory");
}
__device__ __forceinline__ void tr_item8(const float* W, int ldw, unsigned char* WT, int ldt, float scale, LAS float* scr, int lane) {
    { const int kr = lane >> 3, s = lane & 7;
#pragma unroll
      for (int i = 0; i < 16; ++i) { const int c = 2 * (i >> 2) + (kr & 1), ip = 4 * (i & 3) + (kr >> 1), k = 16 * c + ip, g = s ^ (2 * (i >> 2));
          __builtin_amdgcn_global_load_lds((const unsigned*)(W + (size_t)k * ldw + 4 * g), (LAS unsigned*)(scr + i * 256), 16, 0, 2); } }
    VM_WAIT(); asm volatile("" ::: "memory");
    const int c = lane & 7;
#pragma unroll
    for (int j = 0; j < 4; ++j) { const int n = (lane >> 3) + 8 * j; const LAS float* sp = scr + 1024 * (c >> 1) + 32 * (c & 1) + 4 * ((n >> 2) ^ (2 * (c >> 1))) + (n & 3);
        float f[16];
#pragma unroll
        for (int ip = 0; ip < 16; ++ip) f[ip] = sp[256 * (ip >> 2) + 64 * (ip & 3)] * scale;
        v4u o; o.x = pk4_fp8(f[0], f[1], f[2], f[3]); o.y = pk4_fp8(f[4], f[5], f[6], f[7]); o.z = pk4_fp8(f[8], f[9], f[10], f[11]); o.w = pk4_fp8(f[12], f[13], f[14], f[15]);
        __builtin_nontemporal_store(o, (v4u*)(WT + (size_t)n * ldt + 16 * c)); asm volatile("" ::: "memory"); }
    LDS_WAIT(); asm volatile("" ::: "memory");
}

__device__ __forceinline__ void sincos_d(float angf, float& c_out, float& s_out) {
    const double a = (double)angf;
    const double kq = __builtin_rint(a * 0.63661977236758134308);
    double r = __builtin_fma(-kq, 1.57079632679489655800, a);
    r = __builtin_fma(-kq, 6.12323399573676603587e-17, r);
    const int q = ((int)kq) & 3;
    const double r2 = r * r;
    double sp = 1.0 / 6227020800.0; sp = sp * r2 - 1.0 / 39916800.0; sp = sp * r2 + 1.0 / 362880.0; sp = sp * r2 - 1.0 / 5040.0; sp = sp * r2 + 1.0 / 120.0; sp = sp * r2 - 1.0 / 6.0; sp = sp * r2 + 1.0;
    const double sr = sp * r;
    double cp = -1.0 / 87178291200.0; cp = cp * r2 + 1.0 / 479001600.0; cp = cp * r2 - 1.0 / 3628800.0; cp = cp * r2 + 1.0 / 40320.0; cp = cp * r2 - 1.0 / 720.0; cp = cp * r2 + 1.0 / 24.0; cp = cp * r2 - 0.5; cp = cp * r2 + 1.0;
    const double cr = cp;
    double c, s;
    if (q == 0) { c = cr; s = sr; } else if (q == 1) { c = -sr; s = cr; } else if (q == 2) { c = -cr; s = -sr; } else { c = sr; s = -cr; }
    c_out = (float)c; s_out = (float)s;
}


#define WSP(off) (wsb + (off))
#define MOD ((float*)WSP(WS_MOD))
#define WRT ((float*)WSP(WS_WRT))
#define ROPA ((float*)WSP(WS_ROPA))
#define ROPI ((float*)WSP(WS_ROPI))
#define TOPI ((int*)WSP(WS_TOPI))
#define GATE ((float*)WSP(WS_GATE))
#define SLOT ((int*)WSP(WS_SLOT))
#define WTPOOL ((bf16*)WSP(WS_WTPOOL))
#define WTUPP ((bf16*)WSP(WS_WTUPP))
#define WTUPA ((bf16*)WSP(WS_WTUPA))
#define WTOUT ((bf16*)WSP(WS_WTOUT))
#define WTIN ((bf16*)WSP(WS_WTIN))
#define W1T ((bf16*)WSP(WS_W1T))
#define W2T ((bf16*)WSP(WS_W2T))
#define Hb ((bf16*)WSP(WS_H))
#define Qb ((bf16*)WSP(WS_Q))
#define Kb ((bf16*)WSP(WS_K))
#define Vb ((bf16*)WSP(WS_V))
#define Ub ((bf16*)WSP(WS_U))
#define GLb ((bf16*)WSP(WS_GL))
#define QIb ((bf16*)WSP(WS_QI))
#define KWb ((bf16*)WSP(WS_KW))
#define MIXb ((bf16*)WSP(WS_MIX))
#define YPOOL ((bf16*)WSP(WS_YPOOL))
#define YATTN ((bf16*)WSP(WS_YATTN))
#define TMP ((float*)WSP(WS_TMP))
#define MERGED ((bf16*)WSP(WS_MERGED))
#define Yf ((float*)WSP(WS_Y))
#define X1 ((float*)WSP(WS_X1))
#define XS ((bf16*)WSP(WS_XS))
#define ACT ((bf16*)WSP(WS_ACT))
#define YS ((bf16*)WSP(WS_YS))
#define MASKW ((unsigned*)WSP(WS_MASK))
#define H8A ((unsigned char*)WSP(WS_XS + 1 * MiB))
#define WTIN8 ((unsigned char*)WSP(WS_XS + 64 * MiB))
#define ELIST ((int*)WSP(WS_XS + 40 * MiB))
#define ROWTOK ((int*)WSP(WS_XS))
#define PHASE_BASE() GAS unsigned char* wsg_ = (GAS unsigned char*)KA->ws; asm volatile("" : "+s"(wsg_)); unsigned char* wsb = (unsigned char*)wsg_; unsigned* ctl = (unsigned*)(wsb + WS_CTL); (void)ctl
#define INP(i) ((const float*)(const GAS float*)KA->in[i])
#define OUTP ((float*)(GAS float*)KA->out)
#define CAS __attribute__((address_space(4)))
extern __shared__ __attribute__((aligned(16))) unsigned char lds_raw[];
#define PH_PROLOG() \
    const CAS Args* KA = (const CAS Args*)__builtin_amdgcn_kernarg_segment_ptr(); LAS unsigned char* lds = (LAS unsigned char*)lds_raw; \
    volatile LAS unsigned* MISC = (volatile LAS unsigned*)(lds + MISC_OFF); (void)MISC; \
    const int wave = __builtin_amdgcn_readfirstlane((int)threadIdx.x >> 6); \
    const int lane = (int)__builtin_amdgcn_mbcnt_hi(~0u, __builtin_amdgcn_mbcnt_lo(~0u, 0u)), tid = wave * 64 + lane; \
    const int G = gridDim.x, bx = blockIdx.x; const int gw = bx * NWAVES + wave, NGW = G * NWAVES; (void)tid; (void)gw; (void)NGW; (void)lane

constexpr int FIRST_T_OFF = MISC_OFF + 1280, CNT_E_OFF = MISC_OFF + 1408, TILE_ROWS_OFF = MISC_OFF + 1536;
static_assert(TILE_ROWS_OFF + MAXTILES * 4 <= LDS_BYTES, "tile tables overflow the LDS block");
constexpr int FIRST_T_OFF_ = 0;
__device__ __forceinline__ void moe_tiles() {
    PH_PROLOG();
        PHASE_BASE();
        LAS int* tile_e = (LAS int*)(lds + TILE_E_OFF);
        if (wave == 0) {
            int myc = 0; if (lane < NE) myc = (int)__hip_atomic_load(ctl + CW_CUR + 64 * lane, __ATOMIC_RELAXED, __HIP_MEMORY_SCOPE_AGENT);
            const int ntl = (myc + 255) >> 8; int incl = ntl;
#pragma unroll
            for (int o = 1; o < 32; o <<= 1) { const int t = __shfl_up(incl, o); if ((lane & 31) >= o) incl += t; }
            if (lane < NE) { for (int i = incl - ntl; i < incl; ++i) { tile_e[i] = lane; const int lv = myc - (i - (incl - ntl)) * 256; ((LAS int*)(lds + TILE_ROWS_OFF))[i] = lv < 256 ? lv : 256; }
                ((LAS int*)(lds + FIRST_T_OFF))[lane] = incl - ntl; ((LAS int*)(lds + CNT_E_OFF))[lane] = myc; }
            if (lane == NE - 1) MISC[4] = (unsigned)incl;
        }
        __syncthreads();
}

__device__ __forceinline__ void phase0() {
    PH_PROLOG();
        PHASE_BASE();
        LAS float* scr = (LAS float*)(lds + wave * 16896);
        constexpr int I_IN = 296 * 32, I_PL = 128, I_UPP = UPP_FP8 ? 512 : 1024, I_UPA = UPA_FP8 ? 1024 : 2048, I_OUT = OUT_FP8 ? 1024 : 2048, I_1 = 32 * 2048, I_2 = 32 * 1024;
        constexpr int I_IN8 = GL_FP8 ? 16 * 224 : 0;
        constexpr int NIT = I_IN + I_IN8 + I_PL + I_UPP + I_UPA + I_OUT + I_1 + I_2;
        for (int it = gw; it < NIT; it += NGW) {
            int r = it;
            if (r < I_IN) { const int nb = r >> 5, kb = r & 31, d0 = 32 * nb; int src = 0, nv = 32;
                if (GL_FP8 && ((d0 >> 8) < 12 || ((d0 >> 8) >= 16 && (d0 >> 8) < 32))) continue;
                if (d0 < 2048) src = 1024 + d0; else if (d0 < 2560) src = 3072 + (d0 - 2048); else if (d0 < 3072) src = 3584 + (d0 - 2560); else if (d0 < 4096) src = d0 - 3072;
                else if (d0 < 8192) src = 5200 + (d0 - 4096); else if (d0 < 9216) src = 4096 + (d0 - 8192); else if (d0 < 9280) src = 5120 + (d0 - 9216); else if (d0 < 9312) { src = 5184; nv = 16; } else { src = 0; nv = 0; }
                tr_item(INP(I_WIN) + (size_t)(64 * kb) * 9296 + src, 9296, nv, WTIN + (size_t)d0 * 2048 + 64 * kb, 2048, scr, lane); continue; }
            r -= I_IN;
#if GL_FP8
            if (r < I_IN8) { const int kb = r / 224, nb = r % 224, p0 = 32 * nb;
                const int src = p0 < 2048 ? 1024 + p0 : p0 < 2560 ? 3072 + (p0 - 2048) : p0 < 3072 ? 3584 + (p0 - 2560) : 5200 + (p0 - 3072);
                tr_item8(INP(I_WIN) + (size_t)(128 * kb) * 9296 + src, 9296, WTIN8 + (size_t)p0 * 2048 + 128 * kb, 2048, W8_SCALE, scr, lane); continue; }
            r -= I_IN8;
#endif
            if (r < I_PL) { const int gI = r >> 5, q = r & 31, kb = q >> 3, nb = q & 7;
                tr_item(INP(I_WPOOL) + (size_t)gI * 65536 + (size_t)(64 * kb) * 256 + 32 * nb, 256, 32, WTPOOL + (size_t)gI * 65536 + (size_t)(32 * nb) * 256 + 64 * kb, 256, scr, lane); continue; }
            r -= I_PL;
            if (r < I_UPP) {
#if UPP_FP8
                const int kb = r >> 6, nb = r & 63;
                tr_item8(INP(I_WUPP) + (size_t)(128 * kb) * 2048 + 32 * nb, 2048, (unsigned char*)WTUPP + (size_t)(32 * nb) * 2048 + 128 * kb, 2048, W8_SCALE, scr, lane);
#else
                const int nb = r >> 4, kb = r & 15;
                tr_item(INP(I_WUPP) + (size_t)(64 * kb) * 2048 + 32 * nb, 2048, 32, WTUPP + (size_t)(32 * nb) * 1024 + 64 * kb, 1024, scr, lane);
#endif
                continue; }
            r -= I_UPP;
            if (r < I_UPA) {
#if UPA_FP8
                const int kb = r >> 6, nb = r & 63;
                tr_item8(INP(I_WUPA) + (size_t)(128 * kb) * 2048 + 32 * nb, 2048, (unsigned char*)WTUPA + (size_t)(32 * nb) * 2048 + 128 * kb, 2048, W8_SCALE, scr, lane);
#else
                const int nb = r >> 5, kb = r & 31;
                tr_item(INP(I_WUPA) + (size_t)(64 * kb) * 2048 + 32 * nb, 2048, 32, WTUPA + (size_t)(32 * nb) * 2048 + 64 * kb, 2048, scr, lane);
#endif
                continue; }
            r -= I_UPA;
            if (r < I_OUT) {
#if OUT_FP8
                const int kb = r >> 6, nb = r & 63;
                tr_item8(INP(I_WOUT) + (size_t)(128 * kb) * 2048 + 32 * nb, 2048, (unsigned char*)WTOUT + (size_t)(32 * nb) * 2048 + 128 * kb, 2048, W8_SCALE, scr, lane);
#else
                const int nb = r >> 5, kb = r & 31;
                tr_item(INP(I_WOUT) + (size_t)(64 * kb) * 2048 + 32 * nb, 2048, 32, WTOUT + (size_t)(32 * nb) * 2048 + 64 * kb, 2048, scr, lane);
#endif
                continue; }
            r -= I_OUT;
            if (r < I_1) { const int e = r >> 11, q = r & 2047, kb = q >> 7, nb = q & 127, c0 = 32 * nb;
                const int dst = c0 < 2048 ? 256 * (c0 >> 7) + (c0 & 127) : 256 * ((c0 - 2048) >> 7) + 128 + ((c0 - 2048) & 127);
                tr_item8(INP(I_W1) + (size_t)e * 2048 * 4096 + (size_t)(128 * kb) * 4096 + c0, 4096, (unsigned char*)W1T + ((size_t)e * 4096 + dst) * 2048 + 128 * kb, 2048, W8_SCALE, scr, lane); continue; }
            r -= I_1;
            { const int e = r >> 10, q = r & 1023, kb = q >> 6, nb = q & 63;
                tr_item8(INP(I_W2) + (size_t)e * 2048 * 2048 + (size_t)(128 * kb) * 2048 + 32 * nb, 2048, (unsigned char*)W2T + ((size_t)e * 2048 + 32 * nb) * 2048 + 128 * kb, 2048, W8_SCALE, scr, lane); }
        }
        for (int id = bx * 512 + tid; id < NE * D; id += G * 512) WRT[id] = INP(I_WROUTER)[(size_t)(id & 2047) * 32 + (id >> 11)];
        for (int id = bx * 512 + tid; id < SEQ * 24; id += G * 512) {
            if (id < SEQ * 16) { const int pos = id >> 4, i = id & 15; float c_, s_; sincos_d((float)pos * KA->inv_a[i], c_, s_); ROPA[pos * 32 + i] = c_; ROPA[pos * 32 + 16 + i] = s_; }
            else { const int id2 = id - SEQ * 16, pos = id2 >> 3, i = id2 & 7; float c_, s_; sincos_d((float)pos * KA->inv_i[i], c_, s_); ROPI[pos * 16 + i] = c_; ROPI[pos * 16 + 8 + i] = s_; }
        }
        __syncthreads();
        LAS float* cact = (LAS float*)lds;
        LAS float* red = (LAS float*)(lds + 65536);
        for (int i = tid; i < NB * D; i += 512) { const float cv = INP(I_C)[i]; cact[i] = cv / (1.0f + __expf(-cv)); }
        __syncthreads();
        for (int cb = bx; cb < 256; cb += G) {
            float a8[8];
#pragma unroll
            for (int b = 0; b < 8; ++b) a8[b] = 0.f;
            if (lane < 48) {
                const float* wp = INP(I_WADA) + cb * 48 + lane;
#pragma unroll 1
                for (int i0 = 0; i0 < 256; i0 += 16) { float wv[16];
#pragma unroll
                    for (int i = 0; i < 16; ++i) wv[i] = wp[(size_t)(wave + 8 * (i0 + i)) * 12288];
#pragma unroll
                    for (int i = 0; i < 16; ++i) { const int k = wave + 8 * (i0 + i);
#pragma unroll
                        for (int b = 0; b < 8; ++b) a8[b] += cact[b * 2048 + k] * wv[i]; } }
#pragma unroll
                for (int b = 0; b < 8; ++b) red[(wave * 8 + b) * 48 + lane] = a8[b];
            }
            __syncthreads();
            if (tid < 384) { const int b = tid / 48, cI = tid % 48; float s = 0.f;
#pragma unroll
                for (int w = 0; w < 8; ++w) s += red[(w * 8 + b) * 48 + cI];
                MOD[b * 12288 + cb * 48 + cI] = s + INP(I_BADA)[cb * 48 + cI]; }
            __syncthreads();
        }
}

__device__ __forceinline__ void phase1() {
    PH_PROLOG();
        PHASE_BASE();
        const float* gp = INP(I_GPREMIX);
        for (int m0 = gw; m0 < T; m0 += 2 * NGW) {
            f32x4 v[2][8]; float rstd[2];
#pragma unroll
            for (int u = 0; u < 2; ++u) { const f32x4* xr = (const f32x4*)(INP(I_X) + (size_t)(m0 + u * NGW) * D) + lane;
#pragma unroll
                for (int j = 0; j < 8; ++j) v[u][j] = xr[64 * j]; }
#pragma unroll
            for (int u = 0; u < 2; ++u) { float ss = 0.f;
#pragma unroll
                for (int j = 0; j < 8; ++j) ss += (v[u][j].x * v[u][j].x + v[u][j].y * v[u][j].y) + (v[u][j].z * v[u][j].z + v[u][j].w * v[u][j].w);
                rstd[u] = rsqrtf(wave_sum(ss) * (1.0f / D) + EPS); }
#pragma unroll
            for (int u = 0; u < 2; ++u) { const int m = m0 + u * NGW, b = m >> 11; const float* mod = MOD + b * 12288;
                v2u* o8 = (v2u*)(Hb + (size_t)m * D) + lane;
#pragma unroll
                for (int j = 0; j < 8; ++j) { const int col = 4 * (lane + 64 * j);
                    const f32x4 gv = *(const f32x4*)(gp + col), sc = *(const f32x4*)(mod + 2048 + col), sh = *(const f32x4*)(mod + col);
                    const f32x4 hv = (v[u][j] * rstd[u] * gv) * (sc + 1.0f) + sh;
                    v2u w; w.x = cvt_pk_bf16(hv.x, hv.y); w.y = cvt_pk_bf16(hv.z, hv.w); o8[64 * j] = w;
#if GL_FP8
                    ((unsigned*)(H8A + (size_t)m * D))[lane + 64 * j] = pk4_fp8(hv.x, hv.y, hv.z, hv.w);
#endif
                } }
        }
}

__device__ __forceinline__ void phase2() {
    PH_PROLOG();
        PHASE_BASE();
#if GL_FP8
        { pg8::Gemm g{2 * D, 2 * D, 2 * D};
          ProjOrder<0> S{T / 256, G, bx, (const char*)Hb, (const char*)WTIN, (size_t)256 * D * 2, (size_t)256 * D * 2};
          EpiProj E{Qb, Kb, Vb, Ub, GLb, QIb, KWb, ROPA, ROPI, 1.0f};
          pg8::gemm_phase<EpiProj, ProjOrder<0>>(lds, g, S, E); }
        __syncthreads();
        { pg8::Gemm g{D, D, D};
          ProjOrder<1> S{T / 256, G, bx, (const char*)H8A, (const char*)WTIN8, (size_t)256 * D, (size_t)256 * D};
          EpiProj E{Qb, Kb, Vb, Ub, GLb, QIb, KWb, ROPA, ROPI, 1.0f / W8_SCALE};
          pg8::gemm_phase<EpiProj, ProjOrder<1>, true>(lds, g, S, E); }
#else
        pg8::Gemm g{2 * D, 2 * D, 2 * D};
        DenseOrder S{T / 256, NPROJ / 256, G, bx, (const char*)Hb, (const char*)WTIN, (size_t)256 * D * 2, 0, (size_t)256 * D * 2};
        EpiProj E{Qb, Kb, Vb, Ub, GLb, QIb, KWb, ROPA, ROPI, 1.0f};
        pg8::gemm_phase<EpiProj, DenseOrder>(lds, g, S, E);
#endif
}

__device__ __forceinline__ void phase3() { }

__device__ __forceinline__ void phase4() {
    PH_PROLOG();
        PHASE_BASE();
        { Unit pu;
          if (pg8::order_next(0, G, bx, T / 256, 4, pu)) {
              { const int c8 = pu.pn * 32 + (tid & 31), seg = tid >> 5, w = 2 << pu.pn, trow0 = pu.pm * 256 + 16 * seg, pos0 = trow0 & 2047;
                const bf16* ucol = Ub + (size_t)c8 * 8;
                float S[8];
#pragma unroll
                for (int i = 0; i < 8; ++i) S[i] = 0.f;
                { const int c0 = pos0 < w ? pos0 : w;
                  for (int j = 1; j <= c0; ++j) { const v4u uv = *(const v4u*)(ucol + (size_t)(trow0 - j) * 1024);
                      S[0] += lo16(uv.x); S[1] += hi16(uv.x); S[2] += lo16(uv.y); S[3] += hi16(uv.y); S[4] += lo16(uv.z); S[5] += hi16(uv.z); S[6] += lo16(uv.w); S[7] += hi16(uv.w); } }
#pragma unroll 4
                for (int i = 0; i < 16; ++i) { const int t = trow0 + i, pos = pos0 + i;
                    const v4u uv = *(const v4u*)(ucol + (size_t)t * 1024);
                    const float f[8] = {lo16(uv.x), hi16(uv.x), lo16(uv.y), hi16(uv.y), lo16(uv.z), hi16(uv.z), lo16(uv.w), hi16(uv.w)};
#pragma unroll
                    for (int q = 0; q < 8; ++q) S[q] += f[q];
                    if (pos >= w) { const v4u lv = *(const v4u*)(ucol + (size_t)(t - w) * 1024);
                        S[0] -= lo16(lv.x); S[1] -= hi16(lv.x); S[2] -= lo16(lv.y); S[3] -= hi16(lv.y); S[4] -= lo16(lv.z); S[5] -= hi16(lv.z); S[6] -= lo16(lv.w); S[7] -= hi16(lv.w); }
                    const int cnt = (pos + 1) < w ? (pos + 1) : w; const float inv = __builtin_amdgcn_rcpf((float)cnt); v4u o;
                    o.x = pk2(S[0] * inv - f[0], S[1] * inv - f[1]); o.y = pk2(S[2] * inv - f[2], S[3] * inv - f[3]);
                    o.z = pk2(S[4] * inv - f[4], S[5] * inv - f[5]); o.w = pk2(S[6] * inv - f[6], S[7] * inv - f[7]);
                    *(v4u*)(MIXb + (size_t)t * 1024 + c8 * 8) = o; }
              }
          }
          VM_WAIT(); __syncthreads(); }
        { pg8::Gemm g{512, 2048, 512};
          DenseOrder S{T / 256, 4, G, bx, (const char*)MIXb, (const char*)WTPOOL, (size_t)256 * 1024 * 2, (size_t)256 * 2, (size_t)256 * 256 * 2};
          EpiPool E{YPOOL, INP(I_POOLSCALE)};
          pg8::gemm_phase<EpiPool, DenseOrder>(lds, g, S, E); }
        __syncthreads();
#pragma unroll 1
        for (int rnd = 0; rnd * NGW < NB * (SEQ / 2); ++rnd) {
            const int task = gw + rnd * NGW, b = task >> 10, mir = (b >> 1) & 1;
            const int tpr = task & 1023, tp = mir ? 1023 - tpr : tpr;
            const int tpr_lo = (bx * NWAVES) & 1023, tp_hi = mir ? 1023 - tpr_lo : tpr_lo + NWAVES - 1;
            indexer_task(QIb, KWb, MASKW, b, tp, 2 * tp_hi + 1, lds, wave, lane);
        }
}

__device__ __forceinline__ void phase5() {
    PH_PROLOG();
        PHASE_BASE();
#pragma unroll 1
        for (int L = bx; L < NB * 16 * 4; L += G) {
            const int b = L & 7, rest = L >> 3, h = rest >> 2, pair = rest & 3;
#pragma unroll 1
            for (int pass = 0; pass < 2; ++pass) {
                const int qb = pass ? pair : 7 - pair;
                const size_t r0 = (size_t)b * SEQ + (size_t)qb * 256;
                att::attn_masked_body(Qb + r0 * 2048 + h * 128, Kb + (size_t)b * SEQ * 512 + (h >> 2) * 128, Vb + (size_t)b * SEQ * 512 + (h >> 2) * 128,
                                      UPA_FP8 ? (bf16*)((unsigned char*)YATTN + r0 * 2048 + h * 128) : YATTN + r0 * 2048 + h * 128, MASKW + r0 * 64, (qb + 1) * 256, lds);
                __syncthreads();
            }
        }
}

__device__ __forceinline__ void phase6() {
    PH_PROLOG();
        PHASE_BASE();
        static_assert(UPP_FP8 && UPA_FP8 && OUT_FP8, "the fused up-projection runs on e4m3 operands and writes e4m3 merged");
        { pg8::Gemm g{1024, 1024, 2048};
          UpOrder S{T / 256, D / 256, G, bx, (const char*)YPOOL, (const char*)YATTN, (const char*)WTUPP, (const char*)WTUPA};
          EpiUpF E{MERGED, GLb};
          pg8::gemm_phase<EpiUpF, UpOrder, true, true>(lds, g, S, E); }
}

__device__ __forceinline__ void phase7() {
    PH_PROLOG();
        PHASE_BASE();
        pg8::Gemm g{OUT_FP8 ? D : 2 * D, OUT_FP8 ? D : 2 * D, OUT_FP8 ? D : 2 * D};
        DenseOrder S{T / 256, D / 256, G, bx, (const char*)MERGED, (const char*)WTOUT, (size_t)256 * (OUT_FP8 ? D : 2 * D), 0, (size_t)256 * (OUT_FP8 ? D : 2 * D)};
        EpiY16 E{(bf16*)Yf};
        pg8::gemm_phase<EpiY16, DenseOrder, OUT_FP8 != 0>(lds, g, S, E);
}

__device__ __forceinline__ void phase8() {
    PH_PROLOG();
        PHASE_BASE();
        const float* gpm = INP(I_GPOSTMIX); const float* gpf = INP(I_GPREFFN);
        { LAS f32x4* wl = (LAS f32x4*)lds; const f32x4* wg = (const f32x4*)WRT;
          for (int i = tid; i < 16 * D / 4; i += 512) wl[i] = wg[i];
          __syncthreads(); }
#pragma unroll 1
        for (int grp = gw; grp < T / 4; grp += NGW) {
            int lane = (int)__builtin_amdgcn_mbcnt_hi(~0u, __builtin_amdgcn_mbcnt_lo(~0u, 0u)); asm volatile("" : "+v"(lane));
            f32x4 hv[4][8];
#pragma unroll
            for (int r = 0; r < 4; ++r) {
                const int m = grp * 4 + r, b = m >> 11; const float* mod = MOD + b * 12288;
                const v2u* yr = (const v2u*)((const bf16*)Yf + (size_t)m * D) + lane; const f32x4* xr = (const f32x4*)(INP(I_X) + (size_t)m * D) + lane;
                v2u yw[8]; f32x4 xv[8];
#pragma unroll
                for (int j = 0; j < 8; ++j) yw[j] = yr[64 * j];
#pragma unroll
                for (int j = 0; j < 8; ++j) xv[j] = xr[64 * j];
                asm volatile("" ::: "memory");
                float ss = 0.f;
#pragma unroll
                for (int j = 0; j < 8; ++j) { const f32x4 t = {lo16(yw[j].x), hi16(yw[j].x), lo16(yw[j].y), hi16(yw[j].y)}; hv[r][j] = t; ss += (t.x * t.x + t.y * t.y) + (t.z * t.z + t.w * t.w); }
                const float rstd = rsqrtf(wave_sum(ss) * (1.0f / D) + EPS);
                float ss2 = 0.f; v2u* x1r = (v2u*)((bf16*)X1 + (size_t)m * D) + lane;
#pragma unroll
                for (int h = 0; h < 2; ++h) { f32x4 gv[4], gt[4];
#pragma unroll
                    for (int q = 0; q < 4; ++q) { const int col = 4 * (lane + 64 * (4 * h + q)); gv[q] = *(const f32x4*)(gpm + col); gt[q] = *(const f32x4*)(mod + 4096 + col); }
                    asm volatile("" ::: "memory");
#pragma unroll
                    for (int q = 0; q < 4; ++q) { const int j = 4 * h + q;
                        const f32x4 t = xv[j] + gt[q] * (hv[r][j] * rstd * gv[q]); hv[r][j] = t; { v2u w; w.x = cvt_pk_bf16(t.x, t.y); w.y = cvt_pk_bf16(t.z, t.w); x1r[64 * j] = w; }
                        ss2 += (t.x * t.x + t.y * t.y) + (t.z * t.z + t.w * t.w); }
                    asm volatile("" ::: "memory"); }
                const float rstd2 = rsqrtf(wave_sum(ss2) * (1.0f / D) + EPS);
                unsigned* o8 = (unsigned*)((unsigned char*)Hb + (size_t)m * D) + lane;
#pragma unroll
                for (int h = 0; h < 2; ++h) { f32x4 gv[4], sc[4], sh[4];
#pragma unroll
                    for (int q = 0; q < 4; ++q) { const int col = 4 * (lane + 64 * (4 * h + q)); gv[q] = *(const f32x4*)(gpf + col); sc[q] = *(const f32x4*)(mod + 8192 + col); sh[q] = *(const f32x4*)(mod + 6144 + col); }
                    asm volatile("" ::: "memory");
#pragma unroll
                    for (int q = 0; q < 4; ++q) { const int j = 4 * h + q;
                        const f32x4 t = (hv[r][j] * rstd2 * gv[q]) * (sc[q] + 1.0f) + sh[q]; hv[r][j] = t;
                        o8[64 * j] = pk4_fp8(t.x, t.y, t.z, t.w); }
                    asm volatile("" ::: "memory"); }
                asm volatile("" : "+v"(lane) :: "memory");
            }
            float lgA[4] = {0.f, 0.f, 0.f, 0.f}, lgB[4] = {0.f, 0.f, 0.f, 0.f};
            const int l15 = lane & 15;
#pragma unroll 1
            for (int e = 0; e < 16; ++e) {
                const LAS f32x4* wp = (const LAS f32x4*)lds + e * (D / 4) + lane;
                f32x2 p2[4] = {{0.f, 0.f}, {0.f, 0.f}, {0.f, 0.f}, {0.f, 0.f}};
#pragma unroll
                for (int j = 0; j < 8; ++j) { const f32x4 w = wp[64 * j]; const f32x2 w01 = {w.x, w.y}, w23 = {w.z, w.w};
#pragma unroll
                    for (int r = 0; r < 4; ++r) { p2[r] += (f32x2){hv[r][j].x, hv[r][j].y} * w01; p2[r] += (f32x2){hv[r][j].z, hv[r][j].w} * w23; } }
                const float p[4] = {p2[0].x + p2[0].y, p2[1].x + p2[1].y, p2[2].x + p2[2].y, p2[3].x + p2[3].y};
#pragma unroll
                for (int r = 0; r < 4; ++r) { const float sR = row_sum16(p[r]); lgA[r] = (l15 == e) ? sR : lgA[r]; }
            }
#pragma unroll 1
            for (int e = 0; e < 16; ++e) {
                const f32x4* wp = (const f32x4*)(WRT + (size_t)(16 + e) * D) + lane;
                f32x2 p2[4] = {{0.f, 0.f}, {0.f, 0.f}, {0.f, 0.f}, {0.f, 0.f}};
#pragma unroll
                for (int j = 0; j < 8; ++j) { const f32x4 w = wp[64 * j]; const f32x2 w01 = {w.x, w.y}, w23 = {w.z, w.w};
#pragma unroll
                    for (int r = 0; r < 4; ++r) { p2[r] += (f32x2){hv[r][j].x, hv[r][j].y} * w01; p2[r] += (f32x2){hv[r][j].z, hv[r][j].w} * w23; } }
                const float p[4] = {p2[0].x + p2[0].y, p2[1].x + p2[1].y, p2[2].x + p2[2].y, p2[3].x + p2[3].y};
#pragma unroll
                for (int r = 0; r < 4; ++r) { const float sR = row_sum16(p[r]); lgB[r] = (l15 == e) ? sR : lgB[r]; }
            }
#pragma unroll
            for (int r = 0; r < 4; ++r) { lgA[r] += __shfl_xor(lgA[r], 16); lgA[r] += __shfl_xor(lgA[r], 32); lgB[r] += __shfl_xor(lgB[r], 16); lgB[r] += __shfl_xor(lgB[r], 32); }
            const float brt = INP(I_BROUTER)[lane & 31];
            int tiA[4][4]; float gA[4][4];
#pragma unroll
            for (int r = 0; r < 4; ++r) {
                float lv = (lane < NE) ? ((lane < 16) ? lgA[r] : lgB[r]) + brt : -__builtin_inff();
                float tv[4];
#pragma unroll
                for (int k = 0; k < 4; ++k) {
                    float m1 = row_max16(lv); m1 = __builtin_fmaxf(m1, __shfl_xor(m1, 16));
                    const float mx = __builtin_bit_cast(float, __builtin_amdgcn_readlane(__builtin_bit_cast(int, m1), 0));
                    int c1 = row_min16i((lv == mx) ? lane : 99); { const int t = __shfl_xor(c1, 16); c1 = t < c1 ? t : c1; }
                    const int ie = __builtin_amdgcn_readlane(c1, 0);
                    tv[k] = mx; tiA[r][k] = ie; if (lane == ie) lv = -__builtin_inff(); }
                const float e1 = __expf(tv[1] - tv[0]), e2 = __expf(tv[2] - tv[0]), e3 = __expf(tv[3] - tv[0]); const float is = 1.0f / (1.0f + e1 + e2 + e3);
                gA[r][0] = is; gA[r][1] = e1 * is; gA[r][2] = e2 * is; gA[r][3] = e3 * is;
            }
            if (lane < 4) {
                const int m = grp * 4 + lane; int ti[4]; float gg[4];
#pragma unroll
                for (int k = 0; k < 4; ++k) { ti[k] = lane == 0 ? tiA[0][k] : lane == 1 ? tiA[1][k] : lane == 2 ? tiA[2][k] : tiA[3][k]; gg[k] = lane == 0 ? gA[0][k] : lane == 1 ? gA[1][k] : lane == 2 ? gA[2][k] : gA[3][k]; }
                *(int4*)(TOPI + (size_t)m * 4) = make_int4(ti[0], ti[1], ti[2], ti[3]); *(f32x4*)(GATE + (size_t)m * 4) = (f32x4){gg[0], gg[1], gg[2], gg[3]};
                int ps[4];
#pragma unroll
                for (int k = 0; k < 4; ++k) ps[k] = (int)xb_add(ctl + CW_CUR + 64 * ti[k], 1u);
#pragma unroll
                for (int k = 0; k < 4; ++k) ELIST[ti[k] * 16384 + ps[k]] = m;
                *(int4*)(SLOT + (size_t)m * 4) = make_int4(ps[0], ps[1], ps[2], ps[3]); }
        }
}

__device__ __forceinline__ void phase9() { }

__device__ __forceinline__ void phase10() {
    PH_PROLOG();
    moe_tiles();
        PHASE_BASE();
        const int ntiles = (int)MISC[4]; const LAS int* tile_e = (const LAS int*)(lds + TILE_E_OFF);
        pg8::Gemm g{D, D, D};
        LAS int* tokL = (LAS int*)(lds + TOK_OFF);
        MoeOrder S{ntiles, 16, G, bx, (const char*)Hb, (const char*)W1T, 0, (size_t)4096 * D, (size_t)256 * D, tile_e, tokL, (const LAS int*)(lds + TILE_ROWS_OFF), 1};
        { const LAS int* first_t = (const LAS int*)(lds + FIRST_T_OFF); const LAS int* cnt_e = (const LAS int*)(lds + CNT_E_OFF);
          int tv[9]; const int r8 = tid & 255;
#pragma unroll
          for (int q = 0; q < 9; ++q) { const int i = (tid >> 8) + 2 * q; Unit u; const bool ok = S.next(i, u); const int pm = ok ? u.pm : 0;
              const int rr = r8 + (ok ? u.roff : 0);
              const int e = tile_e[pm], r = (pm - first_t[e]) * 256 + rr; const bool live = ok && (rr < 256) && (r < cnt_e[e]);
              const int v = ELIST[live ? e * 16384 + r : 0]; tv[q] = live ? v : 0; }
#pragma unroll
          for (int q = 0; q < 9; ++q) { const int i = (tid >> 8) + 2 * q; tokL[i * 256 + r8] = tv[q]; } }
        __syncthreads();
        EpiAct E{(unsigned char*)ACT, INP(I_B1), tile_e, (LAS float*)(lds + TOK_OFF + 18 * 1024)};
        pg8::gemm_phase<EpiAct, MoeOrder, true, true>(lds, g, S, E);
}

__device__ __forceinline__ void phase11() {
    PH_PROLOG();
    moe_tiles();
        PHASE_BASE();
        const int ntiles = (int)MISC[4]; const LAS int* tile_e = (const LAS int*)(lds + TILE_E_OFF);
        pg8::Gemm g{DFF, DFF, DFF};
        MoeOrder S{ntiles, 8, G, bx, (const char*)ACT, (const char*)W2T, (size_t)256 * DFF, (size_t)2048 * DFF, (size_t)256 * DFF, tile_e, nullptr, (const LAS int*)(lds + TILE_ROWS_OFF), 1};
        EpiYs E{(unsigned char*)YS, INP(I_B2), tile_e, (LAS float*)(lds + TOK_OFF + 18 * 1024)};
        pg8::gemm_phase<EpiYs, MoeOrder, true>(lds, g, S, E);
}

__device__ __forceinline__ void phase12() {
    PH_PROLOG();
        PHASE_BASE();
        const float* gpo = INP(I_GPOSTFFN);
        int frow;
        { int myc = 0; if (lane < NE) myc = (int)__hip_atomic_load(ctl + CW_CUR + 64 * lane, __ATOMIC_RELAXED, __HIP_MEMORY_SCOPE_AGENT);
          const int padded = (myc + 255) & ~255; int incl = padded;
#pragma unroll
          for (int o = 1; o < 32; o <<= 1) { const int t = __shfl_up(incl, o); if ((lane & 31) >= o) incl += t; }
          frow = incl - padded; }
        int4 sl = *(const int4*)(SLOT + (size_t)gw * 4), te = *(const int4*)(TOPI + (size_t)gw * 4); f32x4 gt4 = *(const f32x4*)(GATE + (size_t)gw * 4);
#pragma unroll 1
        for (int m = gw; m < T; m += NGW) {
            int lane = (int)__builtin_amdgcn_mbcnt_hi(~0u, __builtin_amdgcn_mbcnt_lo(~0u, 0u)); asm volatile("" : "+v"(lane));
            const int b = m >> 11; const float* mod = MOD + b * 12288;
            const int sk[4] = {__shfl(frow, te.x) + sl.x, __shfl(frow, te.y) + sl.y, __shfl(frow, te.z) + sl.z, __shfl(frow, te.w) + sl.w}; constexpr float IYS = 1.0f / YS8_SCALE; const float gk[4] = {gt4.x * IYS, gt4.y * IYS, gt4.z * IYS, gt4.w * IYS};
            unsigned yw[4][8]; v2u xw[8];
#pragma unroll
            for (int k = 0; k < 4; ++k) { const unsigned* yp = (const unsigned*)((const unsigned char*)YS + (size_t)sk[k] * D) + lane;
#pragma unroll
                for (int j = 0; j < 8; ++j) yw[k][j] = yp[64 * j]; }
            const v2u* x1r = (const v2u*)((const bf16*)X1 + (size_t)m * D) + lane;
#pragma unroll
            for (int j = 0; j < 8; ++j) xw[j] = x1r[64 * j];
            { const int mn = (m + NGW < T) ? m + NGW : m; sl = *(const int4*)(SLOT + (size_t)mn * 4); te = *(const int4*)(TOPI + (size_t)mn * 4); gt4 = *(const f32x4*)(GATE + (size_t)mn * 4); }
            asm volatile("" ::: "memory");
            f32x4 a[8];
#pragma unroll
            for (int j = 0; j < 8; ++j) a[j] = (f32x4){0.f, 0.f, 0.f, 0.f};
#pragma unroll
            for (int k = 0; k < 4; ++k)
#pragma unroll
                for (int j = 0; j < 8; ++j) { const int w = (int)yw[k][j]; const f32x2 lo = __builtin_amdgcn_cvt_pk_f32_fp8(w, false), hi = __builtin_amdgcn_cvt_pk_f32_fp8(w, true);
                    a[j] += (f32x4){lo.x, lo.y, hi.x, hi.y} * gk[k]; }
            float ss = 0.f;
#pragma unroll
            for (int j = 0; j < 8; ++j) ss += (a[j].x * a[j].x + a[j].y * a[j].y) + (a[j].z * a[j].z + a[j].w * a[j].w);
            const float rstd = rsqrtf(wave_sum(ss) * (1.0f / D) + EPS);
            f32x4* orow = (f32x4*)(OUTP + (size_t)m * D) + lane;
#pragma unroll
            for (int j = 0; j < 8; ++j) { const int col = 4 * (lane + 64 * j);
                const f32x4 gv = *(const f32x4*)(gpo + col), gt = *(const f32x4*)(mod + 10240 + col);
                __builtin_nontemporal_store((f32x4){lo16(xw[j].x), hi16(xw[j].x), lo16(xw[j].y), hi16(xw[j].y)} + gt * (a[j] * rstd * gv), orow + 64 * j); }
        }
}

__global__ void __launch_bounds__(NWAVES * 64, 2) fwd_kernel(Args args) {
    LAS unsigned char* lds = (LAS unsigned char*)lds_raw;
    volatile LAS unsigned* MISC = (volatile LAS unsigned*)(lds + MISC_OFF);
    const int wave = __builtin_amdgcn_readfirstlane((int)threadIdx.x >> 6);
    const int lane = (int)__builtin_amdgcn_mbcnt_hi(~0u, __builtin_amdgcn_mbcnt_lo(~0u, 0u)), tid = wave * 64 + lane;
    unsigned* ctl0 = (unsigned*)(args.ws + WS_CTL);
    for (int u = tid; u < (LDS_BYTES - MISC_OFF) / 4; u += NWAVES * 64) ((LAS unsigned*)(lds + MISC_OFF))[u] = 0u;
    __syncthreads();
    XcdBarrier bar; bar.bar = ctl0 + CW_BAR; bar.x = 0; bar.st = nullptr;
    if (MK_N_LAUNCHES == 1) bar = xcd_barrier_post(ctl0 + CW_BAR, MISC);
    const int lo = args.ph_lo, hi = args.ph_hi;
#ifndef PHMASK
#define PHMASK 0xFFFF
#endif
#define IN(k) ((((PHMASK) >> (k)) & 1) && lo <= (k) && (k) < hi)
#define SEAM(k) do { if (IN(k) && IN((k) + 1)) xcd_barrier(bar); } while (0)
#ifndef PROBE_MASK
#define PROBE_MASK 0
#endif
#define REP(k) _Pragma("unroll") for (int rep_ = 0; rep_ < ((((PROBE_MASK) >> (k)) & 1) ? 2 : 1); ++rep_)

    if (IN(0)) REP(0) { if (rep_) __syncthreads(); phase0(); }
    SEAM(0);

    if (IN(1)) REP(1) { if (rep_) __syncthreads(); phase1(); }
    SEAM(1);

    if (IN(2)) REP(2) { if (rep_) __syncthreads(); phase2(); }
    SEAM(2);


    if (IN(4)) REP(4) { if (rep_) __syncthreads(); phase4(); }
    SEAM(4);
    if (IN(5)) REP(5) { if (rep_) __syncthreads(); phase5(); }
    SEAM(5);

    if (IN(6)) REP(6) { if (rep_) __syncthreads(); phase6(); }
    SEAM(6);

    if (IN(7)) REP(7) { if (rep_) __syncthreads(); phase7(); }
    SEAM(7);

    if (IN(8)) { phase8(); }
    SEAM(8);


    if (IN(10)) REP(10) { if (rep_) __syncthreads(); phase10(); }
    SEAM(10);
    if (IN(11)) REP(11) { if (rep_) __syncthreads(); phase11(); }
    SEAM(11);

    if (IN(12)) REP(12) { if (rep_) __syncthreads(); phase12(); }
#undef IN
#undef SEAM
}

constexpr int NPHASES = 13;
extern "C" void kernel_launch(void* const* d_in, const int* in_sizes, int n_in, void* d_out, int out_size, void* d_ws, size_t ws_size, hipStream_t stream) {
    static int grid = 0;
    if (grid == 0) {
        if (n_in != 20 || out_size != T * D || ws_size < WS_END) { fprintf(stderr, "kernel_launch: unexpected shapes (n_in %d out %d ws %zu need %zu)\n", n_in, out_size, ws_size, (size_t)WS_END); grid = -1; return; }
        int dev = 0, cus = 0, per_cu = 0;
        if (hipGetDevice(&dev) != hipSuccess || hipDeviceGetAttribute(&cus, hipDeviceAttributeMultiprocessorCount, dev) != hipSuccess) { grid = -1; return; }
        if (hipFuncSetAttribute((const void*)fwd_kernel, hipFuncAttributeMaxDynamicSharedMemorySize, LDS_BYTES) != hipSuccess) { fprintf(stderr, "kernel_launch: hipFuncSetAttribute failed\n"); grid = -1; return; }
        if (hipOccupancyMaxActiveBlocksPerMultiprocessor(&per_cu, (const void*)fwd_kernel, NWAVES * 64, LDS_BYTES) != hipSuccess || per_cu < 1)
            fprintf(stderr, "kernel_launch: occupancy query reports %d workgroups per CU\n", per_cu);
        (void)hipGetLastError();
        grid = cus;
        if (grid != 256) fprintf(stderr, "kernel_launch: %d CUs (built for 256)\n", grid);
    }
    if (grid < 0) return;
    (void)in_sizes;
    if (hipMemsetAsync((char*)d_ws + WS_CTL, 0, CTL_ZERO_BYTES, stream) != hipSuccess) { fprintf(stderr, "kernel_launch: memset failed\n"); return; }
    Args a{};
    for (int i = 0; i < 20; ++i) a.in[i] = (const float*)d_in[i];
    a.out = (float*)d_out; a.ws = (unsigned char*)d_ws;
    for (int i = 0; i < 16; ++i) a.inv_a[i] = (float)pow(500000.0, -(double)(2 * i) / 32.0);
    for (int i = 0; i < 8; ++i) a.inv_i[i] = (float)pow(500000.0, -(double)(2 * i) / 16.0);
#if MK_N_LAUNCHES == 1
    a.ph_lo = 0; a.ph_hi = NPHASES;
    hipLaunchKernelGGL(fwd_kernel, dim3(grid), dim3(NWAVES * 64), LDS_BYTES, stream, a);
#else
    for (int p = 0; p < NPHASES; ++p) { a.ph_lo = p; a.ph_hi = p + 1; hipLaunchKernelGGL(fwd_kernel, dim3(grid), dim3(NWAVES * 64), LDS_BYTES, stream, a); }
#endif
    const hipError_t le = hipPeekAtLastError();
    if (le != hipSuccess) fprintf(stderr, "kernel_launch: launch failed: %s\n", hipGetErrorName(le));
}
```

```cpp
#include <hip/hip_runtime.h>
#include <cstdio>
#include <cstdint>
#include <cmath>

#ifndef MK_N_LAUNCHES
#define MK_N_LAUNCHES 1
#endif

#define GAS __attribute__((address_space(1)))
#define LAS __attribute__((address_space(3)))
typedef unsigned short bf16;
typedef unsigned v4u __attribute__((ext_vector_type(4)));
typedef unsigned v2u __attribute__((ext_vector_type(2)));
typedef float f32x4 __attribute__((ext_vector_type(4)));
typedef float f32x2 __attribute__((ext_vector_type(2)));
typedef short bf16x8 __attribute__((ext_vector_type(8)));
#define LDS_WAIT() asm volatile("s_waitcnt lgkmcnt(0)" ::: "memory")
#define VM_WAIT() asm volatile("s_waitcnt vmcnt(0)" ::: "memory")

constexpr int NB = 8, SEQ = 2048, D = 2048, T = NB * SEQ;
constexpr int NPROJ = 9472;
constexpr int NE = 32, TOPK = 4, DFF = 2048;
constexpr int MAXTILES = (T * TOPK) / 256 + NE;
constexpr int MAXROWS = MAXTILES * 256;
constexpr int NKEEP = 256;
constexpr float EPS = 1e-6f;
constexpr int NWAVES = 8;
#ifndef ATT_END
#define ATT_END T
#endif

constexpr size_t MiB = 1u << 20;
constexpr size_t WS_CTL = 0, CTL_ZERO_BYTES = 1 * MiB;
constexpr size_t WS_MOD = 1 * MiB;
constexpr size_t WS_WRT = 1 * MiB + 512 * 1024;
constexpr size_t WS_ROPA = 2 * MiB;
constexpr size_t WS_ROPI = 2 * MiB + 512 * 1024;
constexpr size_t WS_TOPI = 3 * MiB;
constexpr size_t WS_GATE = 3 * MiB + 256 * 1024;
constexpr size_t WS_SLOT = 3 * MiB + 512 * 1024;
constexpr size_t WS_WTPOOL = 4 * MiB;
constexpr size_t WS_WTUPP = 5 * MiB;
constexpr size_t WS_WTUPA = 9 * MiB;
constexpr size_t WS_WTOUT = 17 * MiB;
constexpr size_t WS_WTIN = 25 * MiB;
constexpr size_t WS_W1T = 64 * MiB;
constexpr size_t WS_W2T = 576 * MiB;
constexpr size_t WS_H = 832 * MiB;
constexpr size_t WS_Q = 896 * MiB;
constexpr size_t WS_K = 960 * MiB;
constexpr size_t WS_V = 976 * MiB;
constexpr size_t WS_U = 992 * MiB;
constexpr size_t WS_GL = 1024 * MiB;
constexpr size_t WS_QI = 1152 * MiB;
constexpr size_t WS_KW = 1184 * MiB;
constexpr size_t WS_MIX = 1192 * MiB;
constexpr size_t WS_YPOOL = 1224 * MiB;
constexpr size_t WS_YATTN = 1256 * MiB;
constexpr size_t WS_TMP = 1320 * MiB;
constexpr size_t WS_MERGED = 1448 * MiB;
constexpr size_t WS_Y = 1512 * MiB;
constexpr size_t WS_X1 = 1640 * MiB;
constexpr size_t WS_XS = 1768 * MiB;
constexpr size_t WS_ACT = 2056 * MiB;
constexpr size_t WS_YS = 2344 * MiB;
constexpr size_t WS_MASK = 2632 * MiB;
constexpr size_t WS_END = 2636 * MiB;
constexpr int CW_BAR = 4096;
constexpr int CW_CNT = 16384;
constexpr int CW_CUR = 20480;

constexpr int RING_BYTES = 131072;
constexpr int TOK_OFF = RING_BYTES;
constexpr int MISC_OFF = 155648;
constexpr int TILE_E_OFF = MISC_OFF + 64;
constexpr int LDS_BYTES = MISC_OFF + 4096;

__device__ __forceinline__ float bf2f(unsigned b) { return __uint_as_float(b << 16); }
__device__ __forceinline__ unsigned f2bf(float f) { unsigned u = __float_as_uint(f); return (u + 0x7fffu + ((u >> 16) & 1u)) >> 16; }
__device__ __forceinline__ unsigned pk2(float lo, float hi) { return f2bf(lo) | (f2bf(hi) << 16); }
__device__ __forceinline__ float lo16(unsigned w) { return __uint_as_float(w << 16); }
__device__ __forceinline__ float hi16(unsigned w) { return __uint_as_float(w & 0xffff0000u); }
__device__ __forceinline__ float wave_sum(float v) {
#pragma unroll
    for (int o = 1; o < 64; o <<= 1) v += __shfl_xor(v, o);
    return v;
}
__device__ __forceinline__ float wave_max(float v) {
#pragma unroll
    for (int o = 1; o < 64; o <<= 1) v = fmaxf(v, __shfl_xor(v, o));
    return v;
}
__device__ __forceinline__ int wave_min_i(int v) {
#pragma unroll
    for (int o = 1; o < 64; o <<= 1) { int t = __shfl_xor(v, o); v = t < v ? t : v; }
    return v;
}
__device__ __forceinline__ unsigned pk4_fp8(float a, float b, float c, float d) {
    int w = __builtin_amdgcn_cvt_pk_fp8_f32(a, b, 0, false); w = __builtin_amdgcn_cvt_pk_fp8_f32(c, d, w, true); return (unsigned)w; }
#ifndef GL_FP8
#define GL_FP8 1
#endif
#ifndef UPP_FP8
#define UPP_FP8 1
#endif
#ifndef UPA_FP8
#define UPA_FP8 1
#endif
#ifndef OUT_FP8
#define OUT_FP8 1
#endif
constexpr float W8_SCALE = 64.0f, ACT8_SCALE = 4.0f, YA8_SCALE = 4.0f, YS8_SCALE = 4.0f;
template <int CTRL> __device__ __forceinline__ float dppf(float v) { return __builtin_bit_cast(float, __builtin_amdgcn_update_dpp(0, __builtin_bit_cast(int, v), CTRL, 0xF, 0xF, true)); }
template <int CTRL> __device__ __forceinline__ int dppi(int v) { return __builtin_amdgcn_update_dpp(0, v, CTRL, 0xF, 0xF, true); }
__device__ __forceinline__ float row_sum16(float v) { v += dppf<0x128>(v); v += dppf<0x124>(v); v += dppf<0x122>(v); v += dppf<0x121>(v); return v; }
__device__ __forceinline__ float row_max16(float v) { v = __builtin_fmaxf(v, dppf<0x128>(v)); v = __builtin_fmaxf(v, dppf<0x124>(v)); v = __builtin_fmaxf(v, dppf<0x122>(v)); v = __builtin_fmaxf(v, dppf<0x121>(v)); return v; }
__device__ __forceinline__ int row_min16i(int v) { int t = dppi<0x128>(v); v = t < v ? t : v; t = dppi<0x124>(v); v = t < v ? t : v; t = dppi<0x122>(v); v = t < v ? t : v; t = dppi<0x121>(v); v = t < v ? t : v; return v; }
__device__ __forceinline__ float sigmoidf_(float x) { return __builtin_amdgcn_rcpf(1.0f + __builtin_amdgcn_exp2f(-1.4426950408889634f * x)); }

#define XB_TMO      128
#define XB_XCNT(j)  (256  + 64 * (j))
#define XB_XSUB(j)  (1280 + 64 * (j))
#define XB_XGEN(j)  (2304 + 64 * (j))
#define XB_TOP      3328
#define XB_TOPGEN   3392
#define XCD_BAR_WORDS 3456
#define XB_SPIN_CAP (1u << 22)

__device__ __forceinline__ unsigned xb_ld(unsigned* p)              { return __hip_atomic_load(p, __ATOMIC_RELAXED, __HIP_MEMORY_SCOPE_AGENT); }
__device__ __forceinline__ unsigned xb_add(unsigned* p, unsigned v) { return __hip_atomic_fetch_add(p, v, __ATOMIC_RELAXED, __HIP_MEMORY_SCOPE_AGENT); }
__device__ __forceinline__ unsigned xb_xcc_id() { return (unsigned)__builtin_amdgcn_s_getreg((3 << 11) | 20) & 0xFu; }
#define XB_SPIN(cond, bar) do { unsigned _sp = 0; while (cond) { __builtin_amdgcn_s_sleep(1); \
    if ((++_sp & 255u) == 0u) { if (xb_ld(&(bar)[XB_TMO])) break; if (_sp > XB_SPIN_CAP) { atomicAdd(&(bar)[XB_TMO], 1u); break; } } } } while (0)

struct XcdBarrier { unsigned* bar; unsigned x; volatile LAS unsigned* st; };

__device__ __forceinline__ XcdBarrier xcd_barrier_post(unsigned* bar, volatile LAS unsigned* st) {
    XcdBarrier b; b.bar = bar; b.x = xb_xcc_id(); b.st = st;
    if (threadIdx.x == 0) (void)xb_add(&bar[XB_XCNT(b.x)], 1u);
    return b;
}
__device__ __forceinline__ void xcd_barrier_complete(unsigned* bar, unsigned x, unsigned& nloc, unsigned& nx) {
    const unsigned G = gridDim.x * gridDim.y * gridDim.z;
    unsigned sum, cnt, mine, sp = 0u;
    for (;;) {
        sum = 0u; cnt = 0u; mine = 0u;
#pragma unroll
        for (unsigned j = 0; j < 16; ++j) { const unsigned c = xb_ld(&bar[XB_XCNT(j)]); sum += c; cnt += (c > 0u) ? 1u : 0u; mine = (j == x) ? c : mine; }
        if (sum == G) break;
        __builtin_amdgcn_s_sleep(1);
        if ((++sp & 255u) == 0u) { if (xb_ld(&bar[XB_TMO])) break; if (sp > XB_SPIN_CAP) { atomicAdd(&bar[XB_TMO], 1u); break; } }
    }
    nloc = mine > 0u ? mine : 1u; nx = cnt > 0u ? cnt : 1u;
}
__device__ __forceinline__ void xcd_barrier(const XcdBarrier& b) {
    asm volatile("s_waitcnt vmcnt(0)" ::: "memory");
    __syncthreads();
    if (threadIdx.x == 0) {
        unsigned* bar = b.bar;
        __builtin_amdgcn_s_waitcnt(0);
        unsigned nloc = b.st[0], nx = b.st[1];
        if (nloc == 0u) { xcd_barrier_complete(bar, b.x, nloc, nx); b.st[0] = nloc; b.st[1] = nx; }
        const unsigned old = xb_add(&bar[XB_XSUB(b.x)], 1u);
        const unsigned gen = old / nloc;
        if (old + 1u == (gen + 1u) * nloc) {
            __builtin_amdgcn_fence(__ATOMIC_RELEASE, "agent");
            asm volatile("s_waitcnt vmcnt(0)" ::: "memory");
            const unsigned og = xb_add(&bar[XB_TOP], 1u);
            const unsigned tg = og / nx;
            if (og + 1u == (tg + 1u) * nx) xb_add(&bar[XB_TOPGEN], 1u);
            else XB_SPIN(xb_ld(&bar[XB_TOPGEN]) == tg, bar);
            __builtin_amdgcn_fence(__ATOMIC_ACQUIRE, "agent");
            xb_add(&bar[XB_XGEN(b.x)], 1u);
            asm volatile("s_waitcnt vmcnt(0)" ::: "memory");
        } else {
            XB_SPIN(xb_ld(&bar[XB_XGEN(b.x)]) == gen, bar);
            __builtin_amdgcn_fence(__ATOMIC_ACQUIRE, "agent");
            asm volatile("s_waitcnt vmcnt(0)" ::: "memory");
        }
    }
    __syncthreads();
}

namespace pg8 {
constexpr int BM = 256, BK = 64, HALF = 128, HTB = HALF * BK * 2, STAGE_BYTES = 8 * HTB, NXCD = 8, WGM = 8;
__host__ __device__ __forceinline__ int lds_byte(int r, int c) { const int st = (r >> 4) * 2 + (c >> 5), rr = r & 15, cc = c & 31, ob = rr * 64 + cc * 2; return st * 1024 + (ob ^ (((ob >> 9) & 1) << 5)); }
__host__ __device__ __forceinline__ void stage_rc(int b, int& R, int& C) { const int st = b / 1024, sb = b % 1024, swz = sb ^ (((sb >> 9) & 1) << 5); R = (st >> 1) * 16 + swz / 64; C = (st & 1) * 32 + (swz % 64) / 2; }
__host__ __device__ __forceinline__ int perm32(int rho) { const int n = rho >> 4, i = rho & 15; return 8 * (i >> 2) + 4 * n + (i & 3); }
struct Unit { int pm, pn, half, roff, sub; };
struct Gemm { int Kb, lda, ldb; };

__device__ __forceinline__ void order_map(int L, int nM, int nN, Unit& u) {
    const int nwg = nM * nN;
    int wgid = L; { const int q = nwg / NXCD, r = nwg % NXCD, xcd = wgid % NXCD, off = wgid / NXCD; wgid = (xcd < r ? xcd * (q + 1) : r * (q + 1) + (xcd - r) * q) + off; }
    const int nig = WGM * nN, gid = wgid / nig, fm = gid * WGM, gsz = (nM - fm) < WGM ? (nM - fm) : WGM;
    u.pm = fm + ((wgid % nig) % gsz); u.pn = (wgid % nig) / gsz; u.half = 0; u.roff = 0; u.sub = 0;
}
__device__ __forceinline__ bool order_next(int i, int G, int c, int nM, int nN, Unit& u) {
    const int nwg = nM * nN; const long L = (long)i * G + c; if (L >= nwg) return false;
    order_map((int)L, nM, nN, u); return true;
}
__device__ __forceinline__ unsigned cvt_pk_bf16(float lo, float hi) { unsigned r; asm volatile("v_cvt_pk_bf16_f32 %0, %1, %2" : "=v"(r) : "v"(lo), "v"(hi)); return r; }

typedef int v4i_t __attribute__((ext_vector_type(4)));
typedef int v8i_t __attribute__((ext_vector_type(8)));
template <class Epi, class Sched, bool FP8 = false, bool GATHER = false>
__device__ __forceinline__ void gemm_phase(LAS unsigned char* lds, const Gemm g, const Sched& S, const Epi& E) {
    const int tid = threadIdx.x, wid = __builtin_amdgcn_readfirstlane(tid >> 6), lane = tid & 63, wr = wid >> 2, wc = wid & 3, fr = lane & 15, fq = lane >> 4;
    const int nt0 = g.Kb / 128;
    unsigned vA0[2], vA1[2], nA0[2], nA1[2], voffB[2]; int RA[2], CA[2];
#pragma unroll
    for (int i = 0; i < 2; ++i) { int R, C; stage_rc(tid * 16 + i * 8192, R, C); const int Rb = Epi::PERM ? ((R & ~31) + perm32(R & 31)) : R;
        RA[i] = R; CA[i] = C * 2; voffB[i] = (unsigned)(Rb * g.ldb + C * 2);
        if constexpr (GATHER) { vA0[i] = (unsigned)(S.tok(0, R) * g.lda + C * 2); vA1[i] = (unsigned)(S.tok(0, HALF + R) * g.lda + C * 2); }
        else { vA0[i] = (unsigned)(R * g.lda + C * 2); vA1[i] = (unsigned)((HALF + R) * g.lda + C * 2); }
        nA0[i] = vA0[i]; nA1[i] = vA1[i]; }
    const size_t kstep = (size_t)(BK * 2);
    const size_t hstepB = (size_t)HALF * g.ldb;
    const unsigned ldsw = (unsigned)wid * 1024u;
    const int aoff = lds_byte(wr * 64 + fr, fq * 8), boff = lds_byte(wc * 32 + fr, fq * 8);
#define PG8_SA(b, h) (((b) * 2 + (h)) * HTB)
#define PG8_SB(b, h) ((4 + (b) * 2 + (h)) * HTB)
#define PG8_STAGE(bufoff, gbase, voff) do { _Pragma("unroll") for (int _i = 0; _i < 2; ++_i) \
        __builtin_amdgcn_global_load_lds((const unsigned*)((const char*)(gbase) + (voff)[_i]), (LAS unsigned*)(lds + (bufoff) + ldsw + _i * 8192), 16, 0, 0); } while (0)
#define PG8_LD8(p) __builtin_shufflevector(*(const LAS v4i_t*)(p), *(const LAS v4i_t*)((p) + 1024), 0, 1, 2, 3, 4, 5, 6, 7)
#define PG8_LDA(dst, b, h) do { _Pragma("unroll") for (int m = 0; m < 4; ++m) { if constexpr (FP8) dst##8[m] = PG8_LD8(lds + PG8_SA(b, h) + aoff + m * 2048); else { _Pragma("unroll") for (int k = 0; k < 2; ++k) dst[m][k] = *(const LAS bf16x8*)(lds + PG8_SA(b, h) + aoff + m * 2048 + k * 1024); } } } while (0)
#define PG8_LDB(dst, b, h) do { _Pragma("unroll") for (int n = 0; n < 2; ++n) { if constexpr (FP8) dst##8[n] = PG8_LD8(lds + PG8_SB(b, h) + boff + n * 2048); else { _Pragma("unroll") for (int k = 0; k < 2; ++k) dst[n][k] = *(const LAS bf16x8*)(lds + PG8_SB(b, h) + boff + n * 2048 + k * 1024); } } } while (0)
#define PG8_MMA(ai, bj, At, Bt) do { __builtin_amdgcn_s_setprio(1); _Pragma("unroll") for (int m = 0; m < 4; ++m) _Pragma("unroll") for (int n = 0; n < 2; ++n) { \
        if constexpr (FP8) asm volatile("v_mfma_f32_16x16x128_f8f6f4 %0, %1, %2, %0" : "+v"(acc[ai][bj][m][n]) : "v"(Bt##8[n]), "v"(At##8[m])); \
        else { _Pragma("unroll") for (int k = 0; k < 2; ++k) acc[ai][bj][m][n] = __builtin_amdgcn_mfma_f32_16x16x32_bf16(Bt[n][k], At[m][k], acc[ai][bj][m][n], 0, 0, 0); } } \
        __builtin_amdgcn_s_setprio(0); } while (0)
#define PG8_WAIT_V(n) asm volatile("s_waitcnt vmcnt(" #n ")" ::: "memory")
#define PG8_WAIT_L(n) asm volatile("s_waitcnt lgkmcnt(" #n ")" ::: "memory")
#define PG8_BAR __builtin_amdgcn_s_barrier()
#define PG8_SCHED __builtin_amdgcn_sched_barrier(0)
    Unit cur, nxt; int ui = 0;
    if (!S.next(0, cur)) return;
    f32x4 acc[2][2][4][2];
#pragma unroll
    for (int a = 0; a < 2; ++a)
#pragma unroll
        for (int b = 0; b < 2; ++b)
#pragma unroll
            for (int m = 0; m < 4; ++m)
#pragma unroll
                for (int n = 0; n < 2; ++n) acc[a][b][m][n] = (f32x4){0.f, 0.f, 0.f, 0.f};
    const int one_scale = 0x7f7f7f7f;
    bf16x8 At[4][2], B0[2][2], B1[2][2]; v8i_t At8[4], B08[2], B18[2];
    if constexpr (Epi::PREF) { cur.sub = 0; if (wid == 0) E.prefetch(cur, lane); }
    const char* cA = S.a_ptr(cur); const char* cB = S.b_ptr(cur);
    PG8_STAGE(PG8_SB(0, 0), cB, voffB); PG8_STAGE(PG8_SB(0, 1), cB + hstepB, voffB); PG8_STAGE(PG8_SA(0, 0), cA, vA0); PG8_STAGE(PG8_SA(0, 1), cA, vA1);
    if (wr == 1) PG8_BAR;
    PG8_WAIT_V(2); PG8_BAR;
    PG8_STAGE(PG8_SB(1, 0), cB + kstep, voffB); PG8_STAGE(PG8_SA(1, 0), cA + kstep, vA0); PG8_STAGE(PG8_SB(1, 1), cB + hstepB + kstep, voffB);
    PG8_WAIT_V(6); PG8_BAR;
    for (;;) {
        const bool has_next = S.next(ui + 1, nxt); const bool hf = __builtin_amdgcn_readfirstlane(cur.half) != 0;
        const char* nA = has_next ? S.a_ptr(nxt) : cA; const char* nB = has_next ? S.b_ptr(nxt) : cB;
        int nt = nt0; if constexpr (Epi::FUSED) nt = S.nt(ui);
        if constexpr (GATHER) { if (has_next) {
#pragma unroll
            for (int i = 0; i < 2; ++i) { nA0[i] = (unsigned)(S.tok(ui + 1, RA[i]) * g.lda + CA[i]); nA1[i] = (unsigned)(S.tok(ui + 1, HALF + RA[i]) * g.lda + CA[i]); } } }
#pragma unroll 1
        for (int t = 0; t < nt; t += 2) {
            const bool last = (t == nt - 2);
            const char* a1 = cA + (size_t)(t + 1) * kstep;
            const char* a2 = last ? nA : cA + (size_t)(t + 2) * kstep; const char* b2 = last ? nB : cB + (size_t)(t + 2) * kstep;
            const char* a3 = a2 + kstep; const char* b3 = b2 + kstep;
            unsigned sA0[2], sA1[2];
#pragma unroll
            for (int i = 0; i < 2; ++i) { sA0[i] = (GATHER && last) ? nA0[i] : vA0[i]; sA1[i] = (GATHER && last) ? nA1[i] : vA1[i]; }
            PG8_LDB(B0, 0, 0); PG8_LDB(B1, 0, 1); PG8_SCHED; PG8_LDA(At, 0, 0); PG8_STAGE(PG8_SA(1, 1), a1, vA1);
            PG8_WAIT_V(8); PG8_WAIT_L(0); PG8_BAR; PG8_MMA(0, 0, At, B0); PG8_MMA(0, 1, At, B1); PG8_BAR; PG8_SCHED;
            if (!hf) { PG8_LDA(At, 0, 1); } PG8_STAGE(PG8_SB(0, 0), b2, voffB); PG8_STAGE(PG8_SB(0, 1), b2 + hstepB, voffB); PG8_STAGE(PG8_SA(0, 0), a2, sA0);
            PG8_WAIT_V(8); PG8_WAIT_L(0); PG8_BAR; if (!hf) { PG8_MMA(1, 0, At, B0); PG8_MMA(1, 1, At, B1); } PG8_BAR; PG8_SCHED;
            PG8_LDB(B0, 1, 0); PG8_LDB(B1, 1, 1); PG8_SCHED; PG8_LDA(At, 1, 0); PG8_STAGE(PG8_SA(0, 1), a2, sA1);
            PG8_WAIT_V(8); PG8_WAIT_L(0); PG8_BAR; PG8_MMA(0, 0, At, B0); PG8_MMA(0, 1, At, B1); PG8_BAR; PG8_SCHED;
            if (!hf) { PG8_LDA(At, 1, 1); } PG8_STAGE(PG8_SB(1, 0), b3, voffB); PG8_STAGE(PG8_SB(1, 1), b3 + hstepB, voffB); PG8_STAGE(PG8_SA(1, 0), a3, sA0);
            PG8_WAIT_V(8); PG8_WAIT_L(0); PG8_BAR; if (!hf) { PG8_MMA(1, 0, At, B0); PG8_MMA(1, 1, At, B1); } PG8_BAR; PG8_SCHED;
        }
        if constexpr (Epi::PREF) { if (has_next) { nxt.sub = (ui + 1) & 1; if (wid == 0) E.prefetch(nxt, lane); } }
        if (wr == 0) PG8_BAR;
        if constexpr (FP8) asm volatile("s_nop 15\n\ts_nop 15" ::: "memory");
        bool keep = false;
        if constexpr (Epi::FUSED) { if ((ui & 1) == 0) { E.mid(acc, cur, wr, wc, fr, fq); keep = true; } else E(acc, cur, wr, wc, fr, fq); }
        else E(acc, cur, wr, wc, fr, fq);
        if (!has_next) break;
        if (!keep)
#pragma unroll
        for (int a = 0; a < 2; ++a)
#pragma unroll
            for (int b = 0; b < 2; ++b)
#pragma unroll
                for (int m = 0; m < 4; ++m)
#pragma unroll
                    for (int n = 0; n < 2; ++n) acc[a][b][m][n] = (f32x4){0.f, 0.f, 0.f, 0.f};
        cur = nxt; cA = nA; cB = nB; ++ui;
#pragma unroll
        for (int i = 0; i < 2; ++i) { vA0[i] = nA0[i]; vA1[i] = nA1[i]; }
        if (wr == 1) PG8_BAR;
    }
    PG8_WAIT_V(0);
    PG8_BAR;
#undef PG8_SA
#undef PG8_SB
#undef PG8_STAGE
#undef PG8_LDA
#undef PG8_LDB
#undef PG8_MMA
#undef PG8_LD8
#undef PG8_WAIT_V
#undef PG8_WAIT_L
#undef PG8_BAR
#undef PG8_SCHED
}
}
using pg8::Unit; using pg8::cvt_pk_bf16;

struct DenseOrder {
    int nM, nN, G, c; const char* A; const char* Bt; size_t astep, astepn, bstep;
    __device__ __forceinline__ bool next(int i, Unit& u) const { return pg8::order_next(i, G, c, nM, nN, u); }
    __device__ __forceinline__ const char* a_ptr(const Unit& u) const { return A + (size_t)u.pm * astep + (size_t)u.pn * astepn; }
    __device__ __forceinline__ const char* b_ptr(const Unit& u) const { return Bt + (size_t)u.pn * bstep; }
};
template <int PART> struct ProjOrder {
    int nM, G, c; const char* A; const char* Bt; size_t astep, bstep;
    __device__ __forceinline__ bool next(int i, Unit& u) const {
        if (PART == 0) { if (!pg8::order_next(i, G, c, nM, 9, u)) return false; }
        else {
            const int nwg = nM * 28, extra = (nM * 9) % G, full = nwg / G - 1; int L;
            if (i < full) L = i * G + c; else { if (c < extra) return false; L = full * G + (i - full) * (G - extra) + (c - extra); if (L >= nwg) return false; }
            pg8::order_map(L, nM, 28, u); }
        const int j = u.pn; u.pn = PART ? (j < 12 ? j : j + 4) : (j < 4 ? 12 + j : j < 8 ? 28 + j : 36); return true; }
    __device__ __forceinline__ const char* a_ptr(const Unit& u) const { return A + (size_t)u.pm * astep; }
    __device__ __forceinline__ const char* b_ptr(const Unit& u) const { return Bt + (size_t)(PART ? (u.pn < 12 ? u.pn : u.pn - 4) : u.pn) * bstep; }
};
struct MoeOrder {
    int nM, nN, G, c; const char* A; const char* Bt; size_t astep, bstep_e, bstep; const LAS int* tile_e; const LAS int* tokL; const LAS int* tile_rows; int split;
    __device__ __forceinline__ bool next(int i, Unit& u) const {
        const int nwg = nM * nN, nfull = split ? (nwg / G) * G : nwg, L = i * G + c;
        if (L < nfull) { pg8::order_map(L, nM, nN, u); u.half = tile_rows[u.pm] <= 128 ? 1 : 0; return true; }
        const int rem = nwg - nfull, idx = L - nfull;
        if (2 * rem <= G) { if (idx >= 2 * rem) return false; pg8::order_map(nfull + (idx >> 1), nM, nN, u); u.half = 1; u.roff = (idx & 1) * 128; return true; }
        if (L >= nwg) return false;
        pg8::order_map(L, nM, nN, u); u.half = tile_rows[u.pm] <= 128 ? 1 : 0; return true; }
    __device__ __forceinline__ const char* a_ptr(const Unit& u) const { return A + (size_t)u.pm * astep + (size_t)u.roff * (astep >> 8); }
    __device__ __forceinline__ const char* b_ptr(const Unit& u) const { return Bt + (size_t)tile_e[u.pm] * bstep_e + (size_t)u.pn * bstep; }
    __device__ __forceinline__ int tok(int ui, int r) const { return tokL[ui * 256 + r]; }
};

struct EpiProj {
    static constexpr bool PERM = true; static constexpr bool FUSED = false; static constexpr bool PREF = false;
    bf16 *Q, *K, *V, *U, *GL, *QI, *KW; const float* ropa; const float* ropi; float oscale;
    __device__ __forceinline__ void operator()(const f32x4 (&acc)[2][2][4][2], const Unit& u, int wr, int wc, int fr, int fq) const {
        const int pn = u.pn; bf16* base; int ldc, c0, mode = 0;
        if (pn < 8) { base = Q; ldc = 2048; c0 = pn * 256; mode = 1; }
        else if (pn < 10) { base = K; ldc = 512; c0 = (pn - 8) * 256; mode = 1; }
        else if (pn < 12) { base = V; ldc = 512; c0 = (pn - 10) * 256; }
        else if (pn < 16) { base = U; ldc = 1024; c0 = (pn - 12) * 256; }
        else if (pn < 32) { base = GL; ldc = 4096; c0 = (pn - 16) * 256; }
        else if (pn < 36) { base = QI; ldc = 1024; c0 = (pn - 32) * 256; mode = 2; }
        else { base = KW; ldc = 256; c0 = 0; mode = 3; }
        const int row0 = u.pm * 256 + wr * 64 + fr, col0 = c0 + wc * 32 + 8 * fq;
        const bool ropeA = (mode == 1) && (wc == 0);
        const bool ropeI = ((mode == 2) && ((wc & 1) == 0)) || ((mode == 3) && (wc == 0));
        const bool wsc = (mode == 3) && (wc == 2) && (fq < 2);
        const bool anyrope = ropeA || ropeI; const float* tab = ropeA ? ropa + 8 * (fq & 1) : ropi; const int tstride = ropeA ? 32 : 16, soff = ropeA ? 16 : 8;
        f32x4 tc[4];
        if (anyrope) { const float* cs = tab + (row0 & (SEQ - 1)) * tstride; tc[0] = *(const f32x4*)cs; tc[1] = *(const f32x4*)(cs + 4); tc[2] = *(const f32x4*)(cs + soff); tc[3] = *(const f32x4*)(cs + soff + 4); }
#pragma unroll
        for (int it = 0; it < 8; ++it) { const int ai = it >> 2, m = it & 3; const int row = row0 + ai * 128 + m * 16; bf16* rowp = base + (size_t)row * ldc + col0;
            v4u w[2];
#pragma unroll
            for (int bj = 0; bj < 2; ++bj) { f32x4 v0 = acc[ai][bj][m][0] * oscale, v1 = acc[ai][bj][m][1] * oscale;
                if (ropeA) {
                    const float sg = (fq < 2) ? -1.f : 1.f;
                    const f32x4 c0v = tc[0], c1v = tc[1], s0v = tc[2] * sg, s1v = tc[3] * sg;
                    f32x4 p0, p1;
#pragma unroll
                    for (int j = 0; j < 4; ++j) { p0[j] = __shfl_xor(v0[j], 32); p1[j] = __shfl_xor(v1[j], 32); }
                    v0 = v0 * c0v + p0 * s0v; v1 = v1 * c1v + p1 * s1v;
                } else if (ropeI && (mode == 2 || bj == 0)) {
                    const float sg = (fq == 0) ? -1.f : 1.f;
                    const f32x4 c0v = tc[0], c1v = tc[1], s0v = tc[2] * sg, s1v = tc[3] * sg;
                    f32x4 p0, p1;
#pragma unroll
                    for (int j = 0; j < 4; ++j) { p0[j] = __shfl_xor(v0[j], 16); p1[j] = __shfl_xor(v1[j], 16); }
                    if (fq < 2) { v0 = v0 * c0v + p0 * s0v; v1 = v1 * c1v + p1 * s1v; }
                } else if (wsc && bj == 0) { v0 = v0 * 0.03125f; v1 = v1 * 0.03125f; }
                w[bj].x = cvt_pk_bf16(v0[0], v0[1]); w[bj].y = cvt_pk_bf16(v0[2], v0[3]); w[bj].z = cvt_pk_bf16(v1[0], v1[1]); w[bj].w = cvt_pk_bf16(v1[2], v1[3]); }
            asm volatile("" ::: "memory");
            if (anyrope && it < 7) { const int rown = row0 + ((it + 1) >> 2) * 128 + ((it + 1) & 3) * 16; const float* cs = tab + (rown & (SEQ - 1)) * tstride;
                tc[0] = *(const f32x4*)cs; tc[1] = *(const f32x4*)(cs + 4); tc[2] = *(const f32x4*)(cs + soff); tc[3] = *(const f32x4*)(cs + soff + 4); }
            asm volatile("" ::: "memory");
            *(v4u*)rowp = w[0]; *(v4u*)(rowp + 128) = w[1];
            asm volatile("" ::: "memory"); }
    }
};
struct EpiPool {
    static constexpr bool PERM = true; static constexpr bool FUSED = false; static constexpr bool PREF = false;
    bf16* O; const float* scale;
    __device__ __forceinline__ void operator()(const f32x4 (&acc)[2][2][4][2], const Unit& u, int wr, int wc, int fr, int fq) const {
        const int row0 = u.pm * 256 + wr * 64 + fr, col0 = u.pn * 256 + wc * 32 + 8 * fq;
#pragma unroll
        for (int bj = 0; bj < 2; ++bj) {
            const f32x4 s0 = *(const f32x4*)(scale + col0 + bj * 128), s1 = *(const f32x4*)(scale + col0 + bj * 128 + 4);
#pragma unroll
            for (int ai = 0; ai < 2; ++ai)
#pragma unroll
                for (int m = 0; m < 4; ++m) { const size_t off = (size_t)(row0 + ai * 128 + m * 16) * 1024 + col0 + bj * 128;
                    const f32x4 v0 = acc[ai][bj][m][0] * s0, v1 = acc[ai][bj][m][1] * s1;
#if UPP_FP8
                    v2u w; w.x = pk4_fp8(v0[0], v0[1], v0[2], v0[3]); w.y = pk4_fp8(v1[0], v1[1], v1[2], v1[3]);
                    *(v2u*)((unsigned char*)O + off) = w;
#else
                    v4u w; w.x = cvt_pk_bf16(v0[0], v0[1]); w.y = cvt_pk_bf16(v0[2], v0[3]); w.z = cvt_pk_bf16(v1[0], v1[1]); w.w = cvt_pk_bf16(v1[2], v1[3]);
                    *(v4u*)(O + off) = w;
#endif
                }
            asm volatile("" ::: "memory"); }
    }
};
template <int MODE> struct EpiUp {
    static constexpr bool PERM = true; static constexpr bool FUSED = false; static constexpr bool PREF = false;
    float* TMP; bf16* MERGED; const bf16* GL;
    __device__ __forceinline__ void operator()(const f32x4 (&acc)[2][2][4][2], const Unit& u, int wr, int wc, int fr, int fq) const {
        const int row0 = u.pm * 256 + wr * 64 + fr, col0 = u.pn * 256 + wc * 32 + 8 * fq;
        constexpr float IS = MODE ? (UPA_FP8 ? 1.0f / (W8_SCALE * YA8_SCALE) : 1.0f) : (UPP_FP8 ? 1.0f / W8_SCALE : 1.0f), RIS = 1.0f / IS;
        v4u gwn[2], twn[2];
#pragma unroll
        for (int bj = 0; bj < 2; ++bj) { const size_t row = (size_t)row0; const int col = col0 + bj * 128;
            gwn[bj] = *(const v4u*)(GL + row * 4096 + (MODE ? 2048 : 0) + col); if (MODE) twn[bj] = *(const v4u*)((const bf16*)TMP + row * 2048 + col); }
#pragma unroll
        for (int it = 0; it < 8; ++it) { const int ai = it >> 2, m = it & 3; const size_t row = (size_t)(row0 + ai * 128 + m * 16);
            v4u gwc[2] = {gwn[0], gwn[1]}, twc[2]; if (MODE) { twc[0] = twn[0]; twc[1] = twn[1]; }
            if (it < 7) { const size_t rown = (size_t)(row0 + ((it + 1) >> 2) * 128 + ((it + 1) & 3) * 16);
#pragma unroll
                for (int bj = 0; bj < 2; ++bj) { const int col = col0 + bj * 128;
                    gwn[bj] = *(const v4u*)(GL + rown * 4096 + (MODE ? 2048 : 0) + col); if (MODE) twn[bj] = *(const v4u*)((const bf16*)TMP + rown * 2048 + col); } }
            asm volatile("" ::: "memory");
#pragma unroll
            for (int bj = 0; bj < 2; ++bj) { const int col = col0 + bj * 128;
                const unsigned gwv[4] = {gwc[bj].x, gwc[bj].y, gwc[bj].z, gwc[bj].w}; f32x2 gs[4];
#pragma unroll
                for (int q = 0; q < 4; ++q) { const f32x2 ea = (f32x2){lo16(gwv[q]), hi16(gwv[q])} * (f32x2){-1.4426950408889634f, -1.4426950408889634f};
                    const f32x2 den = (f32x2){__builtin_amdgcn_exp2f(ea.x), __builtin_amdgcn_exp2f(ea.y)} * (f32x2){RIS, RIS} + (f32x2){RIS, RIS};
                    gs[q] = (f32x2){__builtin_amdgcn_rcpf(den.x), __builtin_amdgcn_rcpf(den.y)}; }
                const f32x4 a0 = acc[ai][bj][m][0], a1 = acc[ai][bj][m][1];
                f32x2 p[4] = {(f32x2){a0[0], a0[1]} * gs[0], (f32x2){a0[2], a0[3]} * gs[1], (f32x2){a1[0], a1[1]} * gs[2], (f32x2){a1[2], a1[3]} * gs[3]};
                if (MODE == 0) { v4u w; w.x = cvt_pk_bf16(p[0].x, p[0].y); w.y = cvt_pk_bf16(p[1].x, p[1].y); w.z = cvt_pk_bf16(p[2].x, p[2].y); w.w = cvt_pk_bf16(p[3].x, p[3].y); *(v4u*)((bf16*)TMP + row * 2048 + col) = w; }
                else { const v4u tw = twc[bj]; p[0] += (f32x2){lo16(tw.x), hi16(tw.x)}; p[1] += (f32x2){lo16(tw.y), hi16(tw.y)}; p[2] += (f32x2){lo16(tw.z), hi16(tw.z)}; p[3] += (f32x2){lo16(tw.w), hi16(tw.w)};
#if OUT_FP8
                    v2u w; w.x = pk4_fp8(p[0].x, p[0].y, p[1].x, p[1].y); w.y = pk4_fp8(p[2].x, p[2].y, p[3].x, p[3].y);
                    *(v2u*)((unsigned char*)MERGED + row * 2048 + col) = w; }
#else
                    v4u w; w.x = cvt_pk_bf16(p[0].x, p[0].y); w.y = cvt_pk_bf16(p[1].x, p[1].y); w.z = cvt_pk_bf16(p[2].x, p[2].y); w.w = cvt_pk_bf16(p[3].x, p[3].y);
                    *(v4u*)(MERGED + row * 2048 + col) = w; }
#endif
            }
            asm volatile("" ::: "memory"); }
    }
};
struct UpOrder {
    int nM, nN, G, c; const char* A0; const char* A1; const char* B0; const char* B1;
    __device__ __forceinline__ bool next(int i, Unit& u) const { if (!pg8::order_next(i >> 1, G, c, nM, nN, u)) return false; u.sub = i & 1; return true; }
    __device__ __forceinline__ const char* a_ptr(const Unit& u) const { return u.sub ? A1 + (size_t)u.pm * (256 * 2048) : A0 + (size_t)u.pm * (256 * 1024); }
    __device__ __forceinline__ const char* b_ptr(const Unit& u) const { return (u.sub ? B1 : B0) + (size_t)u.pn * (256 * 2048); }
    __device__ __forceinline__ int tok(int ui, int r) const { return (ui & 1) ? 2 * r : r; }
    __device__ __forceinline__ int nt(int ui) const { return (ui & 1) ? 16 : 8; }
};
struct EpiUpF {
    static constexpr bool PERM = true; static constexpr bool FUSED = true; static constexpr bool PREF = false;
    bf16* MERGED; const bf16* GL;
    __device__ __forceinline__ void mid(f32x4 (&acc)[2][2][4][2], const Unit& u, int wr, int wc, int fr, int fq) const {
        const int row0 = u.pm * 256 + wr * 64 + fr, col0 = u.pn * 256 + wc * 32 + 8 * fq;
        constexpr float RS = (1.0f / W8_SCALE) / (1.0f / (W8_SCALE * YA8_SCALE));
        v4u an[2], bn[2];
#pragma unroll
        for (int bj = 0; bj < 2; ++bj) { const bf16* gp = GL + (size_t)row0 * 4096 + col0 + bj * 128; an[bj] = *(const v4u*)gp; bn[bj] = *(const v4u*)(gp + 2048); }
#pragma unroll
        for (int it = 0; it < 8; ++it) { const int ai = it >> 2, m = it & 3;
            v4u ac[2] = {an[0], an[1]}, bc[2] = {bn[0], bn[1]};
            if (it < 7) { const size_t rown = (size_t)(row0 + ((it + 1) >> 2) * 128 + ((it + 1) & 3) * 16);
#pragma unroll
                for (int bj = 0; bj < 2; ++bj) { const bf16* gp = GL + rown * 4096 + col0 + bj * 128; an[bj] = *(const v4u*)gp; bn[bj] = *(const v4u*)(gp + 2048); } }
            asm volatile("" ::: "memory");
#pragma unroll
            for (int bj = 0; bj < 2; ++bj) { const unsigned av[4] = {ac[bj].x, ac[bj].y, ac[bj].z, ac[bj].w}, bv[4] = {bc[bj].x, bc[bj].y, bc[bj].z, bc[bj].w};
#pragma unroll
                for (int q = 0; q < 4; ++q) { const f32x2 ea = (f32x2){lo16(av[q]), hi16(av[q])} * (f32x2){-1.4426950408889634f, -1.4426950408889634f}, eb = (f32x2){lo16(bv[q]), hi16(bv[q])} * (f32x2){-1.4426950408889634f, -1.4426950408889634f};
                    const f32x2 da = (f32x2){__builtin_amdgcn_exp2f(ea.x), __builtin_amdgcn_exp2f(ea.y)} + (f32x2){1.0f, 1.0f};
                    const f32x2 db = (f32x2){__builtin_amdgcn_exp2f(eb.x), __builtin_amdgcn_exp2f(eb.y)} * (f32x2){RS, RS} + (f32x2){RS, RS};
                    const f32x2 r = db * (f32x2){__builtin_amdgcn_rcpf(da.x), __builtin_amdgcn_rcpf(da.y)};
                    f32x4& t = acc[ai][bj][m][q >> 1];
                    if (q & 1) { t[2] *= r.x; t[3] *= r.y; } else { t[0] *= r.x; t[1] *= r.y; } } }
            asm volatile("" ::: "memory"); }
    }
    __device__ __forceinline__ void operator()(const f32x4 (&acc)[2][2][4][2], const Unit& u, int wr, int wc, int fr, int fq) const {
        const int row0 = u.pm * 256 + wr * 64 + fr, col0 = u.pn * 256 + wc * 32 + 8 * fq;
        constexpr float RIS = W8_SCALE * YA8_SCALE;
        v4u bn[2];
#pragma unroll
        for (int bj = 0; bj < 2; ++bj) bn[bj] = *(const v4u*)(GL + (size_t)row0 * 4096 + 2048 + col0 + bj * 128);
#pragma unroll
        for (int it = 0; it < 8; ++it) { const int ai = it >> 2, m = it & 3; const size_t row = (size_t)(row0 + ai * 128 + m * 16);
            v4u bc[2] = {bn[0], bn[1]};
            if (it < 7) { const size_t rown = (size_t)(row0 + ((it + 1) >> 2) * 128 + ((it + 1) & 3) * 16);
#pragma unroll
                for (int bj = 0; bj < 2; ++bj) bn[bj] = *(const v4u*)(GL + rown * 4096 + 2048 + col0 + bj * 128); }
            asm volatile("" ::: "memory");
#pragma unroll
            for (int bj = 0; bj < 2; ++bj) { const int col = col0 + bj * 128; const unsigned bv[4] = {bc[bj].x, bc[bj].y, bc[bj].z, bc[bj].w}; f32x2 gs[4];
#pragma unroll
                for (int q = 0; q < 4; ++q) { const f32x2 eb = (f32x2){lo16(bv[q]), hi16(bv[q])} * (f32x2){-1.4426950408889634f, -1.4426950408889634f};
                    const f32x2 den = (f32x2){__builtin_amdgcn_exp2f(eb.x), __builtin_amdgcn_exp2f(eb.y)} * (f32x2){RIS, RIS} + (f32x2){RIS, RIS};
                    gs[q] = (f32x2){__builtin_amdgcn_rcpf(den.x), __builtin_amdgcn_rcpf(den.y)}; }
                const f32x4 a0 = acc[ai][bj][m][0], a1 = acc[ai][bj][m][1];
                const f32x2 p[4] = {(f32x2){a0[0], a0[1]} * gs[0], (f32x2){a0[2], a0[3]} * gs[1], (f32x2){a1[0], a1[1]} * gs[2], (f32x2){a1[2], a1[3]} * gs[3]};
                v2u w; w.x = pk4_fp8(p[0].x, p[0].y, p[1].x, p[1].y); w.y = pk4_fp8(p[2].x, p[2].y, p[3].x, p[3].y);
                *(v2u*)((unsigned char*)MERGED + row * 2048 + col) = w; }
            asm volatile("" ::: "memory"); }
    }
};
struct EpiY16 {
    static constexpr bool PERM = true; static constexpr bool FUSED = false; static constexpr bool PREF = false;
    bf16* C;
    __device__ __forceinline__ void operator()(const f32x4 (&acc)[2][2][4][2], const Unit& u, int wr, int wc, int fr, int fq) const {
        const int row0 = u.pm * 256 + wr * 64 + fr, col0 = u.pn * 256 + wc * 32 + 8 * fq;
#pragma unroll
        for (int ai = 0; ai < 2; ++ai)
#pragma unroll
            for (int m = 0; m < 4; ++m) { bf16* rowp = C + (size_t)(row0 + ai * 128 + m * 16) * 2048 + col0;
#pragma unroll
                for (int bj = 0; bj < 2; ++bj) { constexpr float IS = OUT_FP8 ? 1.0f / W8_SCALE : 1.0f; const f32x4 v0 = acc[ai][bj][m][0] * IS, v1 = acc[ai][bj][m][1] * IS;
                    v4u w; w.x = cvt_pk_bf16(v0[0], v0[1]); w.y = cvt_pk_bf16(v0[2], v0[3]); w.z = cvt_pk_bf16(v1[0], v1[1]); w.w = cvt_pk_bf16(v1[2], v1[3]);
                    *(v4u*)(rowp + bj * 128) = w; } }
    }
};
struct EpiAct {
    static constexpr bool PERM = true; static constexpr bool FUSED = false; static constexpr bool PREF = true;
    unsigned char* ACT8; const float* b1; const LAS int* tile_e; LAS float* bslot;
    __device__ __forceinline__ void prefetch(const Unit& u, int lane) const {
        const int e = tile_e[u.pm]; const float* src = b1 + (size_t)e * 4096 + u.pn * 128 + (lane < 32 ? 4 * lane : 2048 + 4 * (lane - 32));
        __builtin_amdgcn_global_load_lds((const unsigned*)(const GAS float*)src, (LAS unsigned*)(bslot + __builtin_amdgcn_readfirstlane(u.sub) * 256), 16, 0, 0); }
    __device__ __forceinline__ void operator()(const f32x4 (&acc)[2][2][4][2], const Unit& u, int wr, int wc, int fr, int fq) const {
        const int row0 = u.pm * 256 + u.roff + wr * 64 + fr, col0 = u.pn * 128 + wc * 32 + 8 * fq;
        const LAS float* bs = bslot + u.sub * 256 + wc * 32 + 8 * fq;
        const f32x4 bg0 = *(const LAS f32x4*)bs, bg1 = *(const LAS f32x4*)(bs + 4), bl0 = *(const LAS f32x4*)(bs + 128), bl1 = *(const LAS f32x4*)(bs + 132);
        constexpr float IS = 1.0f / W8_SCALE;
#pragma unroll
        for (int ai = 0; ai < 2; ++ai) { if (ai == 1 && u.half) break;
#pragma unroll
            for (int m = 0; m < 4; ++m) { unsigned char* rowp = ACT8 + (size_t)(row0 + ai * 128 + m * 16) * 2048 + col0;
                f32x2 o[2][2];
#pragma unroll
                for (int n = 0; n < 2; ++n)
#pragma unroll
                    for (int h = 0; h < 2; ++h) { const f32x4 ga = acc[ai][0][m][n], la = acc[ai][1][m][n], bgn = n ? bg1 : bg0, bln = n ? bl1 : bl0;
                        const f32x2 gv = (f32x2){ga[2 * h], ga[2 * h + 1]} * (f32x2){IS, IS} + (f32x2){bgn[2 * h], bgn[2 * h + 1]};
                        const f32x2 lv = (f32x2){la[2 * h], la[2 * h + 1]} * (f32x2){IS, IS} + (f32x2){bln[2 * h], bln[2 * h + 1]};
                        const f32x2 gg = {__builtin_amdgcn_fmed3f(gv.x, -3.0e38f, 7.0f), __builtin_amdgcn_fmed3f(gv.y, -3.0e38f, 7.0f)};
                        const f32x2 ll = {__builtin_amdgcn_fmed3f(lv.x, -7.0f, 7.0f), __builtin_amdgcn_fmed3f(lv.y, -7.0f, 7.0f)};
                        const f32x2 ea = gg * (f32x2){-1.702f * 1.4426950408889634f, -1.702f * 1.4426950408889634f};
                        const f32x2 den = (f32x2){__builtin_amdgcn_exp2f(ea.x), __builtin_amdgcn_exp2f(ea.y)} + (f32x2){1.0f, 1.0f};
                        const f32x2 sg = {__builtin_amdgcn_rcpf(den.x), __builtin_amdgcn_rcpf(den.y)};
                        o[n][h] = (gg * sg) * (ll * (f32x2){ACT8_SCALE, ACT8_SCALE} + (f32x2){ACT8_SCALE, ACT8_SCALE}); }
                v2u w; w.x = pk4_fp8(o[0][0].x, o[0][0].y, o[0][1].x, o[0][1].y); w.y = pk4_fp8(o[1][0].x, o[1][0].y, o[1][1].x, o[1][1].y);
                *(v2u*)rowp = w; } }
    }
};
struct EpiYs {
    static constexpr bool PERM = true; static constexpr bool FUSED = false; static constexpr bool PREF = true;
    unsigned char* YS8; const float* b2; const LAS int* tile_e; LAS float* bslot;
    __device__ __forceinline__ void prefetch(const Unit& u, int lane) const {
        const int e = tile_e[u.pm]; const float* src = b2 + (size_t)e * 2048 + u.pn * 256 + 4 * lane;
        __builtin_amdgcn_global_load_lds((const unsigned*)(const GAS float*)src, (LAS unsigned*)(bslot + __builtin_amdgcn_readfirstlane(u.sub) * 256), 16, 0, 0); }
    __device__ __forceinline__ void operator()(const f32x4 (&acc)[2][2][4][2], const Unit& u, int wr, int wc, int fr, int fq) const {
        const int row0 = u.pm * 256 + u.roff + wr * 64 + fr, col0 = u.pn * 256 + wc * 32 + 8 * fq;
        const LAS float* bs = bslot + u.sub * 256 + wc * 32 + 8 * fq;
        f32x4 bv[2][2];
#pragma unroll
        for (int bj = 0; bj < 2; ++bj)
#pragma unroll
            for (int n = 0; n < 2; ++n) bv[bj][n] = *(const LAS f32x4*)(bs + bj * 128 + 4 * n) * YS8_SCALE;
#pragma unroll
        for (int ai = 0; ai < 2; ++ai) { if (ai == 1 && u.half) break;
#pragma unroll
            for (int m = 0; m < 4; ++m) { unsigned char* rowp = YS8 + (size_t)(row0 + ai * 128 + m * 16) * 2048 + col0;
#pragma unroll
                for (int bj = 0; bj < 2; ++bj) { constexpr float IS = YS8_SCALE / (W8_SCALE * ACT8_SCALE); const f32x4 v0 = acc[ai][bj][m][0] * IS + bv[bj][0], v1 = acc[ai][bj][m][1] * IS + bv[bj][1];
                    v2u w; w.x = pk4_fp8(v0[0], v0[1], v0[2], v0[3]); w.y = pk4_fp8(v1[0], v1[1], v1[2], v1[3]);
                    *(v2u*)(rowp + bj * 128) = w; } } }
    }
};


typedef float f32x16 __attribute__((ext_vector_type(16)));
#define DPP_ADD(v, ctrl) v += __builtin_amdgcn_update_dpp(0, v, ctrl, 0xF, 0xF, true)
__device__ __forceinline__ void indexer_task(const bf16* QI, const bf16* KW, unsigned* MW, int b, int tp, int tmaxb, LAS unsigned char* lds, int wave, int lane_in) {
    int lane = lane_in; asm volatile("" : "+v"(lane));
    const int c = lane & 31, kg = lane >> 5;
    const int t0 = 2 * tp; const size_t rowbase = (size_t)b * SEQ;
    const int arow_q = (c >> 2) & 1, ahead = 4 * (c >> 3) + (c & 3);
    const bf16* qa = QI + (rowbase + t0 + arow_q) * 1024 + ahead * 64 + 8 * kg;
    bf16x8 af[4];
#pragma unroll
    for (int kk = 0; kk < 4; ++kk) af[kk] = *(const bf16x8*)(qa + 16 * kk);
    float wf[16];
    { const bf16* wp = KW + (rowbase + t0 + kg) * 256 + 64; const v4u w0 = *(const v4u*)wp, w1 = *(const v4u*)(wp + 8);
      wf[0] = lo16(w0.x); wf[1] = hi16(w0.x); wf[2] = lo16(w0.y); wf[3] = hi16(w0.y); wf[4] = lo16(w0.z); wf[5] = hi16(w0.z); wf[6] = lo16(w0.w); wf[7] = hi16(w0.w);
      wf[8] = lo16(w1.x); wf[9] = hi16(w1.x); wf[10] = lo16(w1.y); wf[11] = hi16(w1.y); wf[12] = lo16(w1.z); wf[13] = hi16(w1.z); wf[14] = lo16(w1.w); wf[15] = hi16(w1.w); }
    asm volatile("s_waitcnt vmcnt(0)" ::: "memory");
    const int tq = t0 + kg, maxblk = (t0 + 1) >> 5;
    const bf16* dsrc = KW + (rowbase + 64 * wave + (lane >> 3)) * 256 + (((lane & 7) ^ ((lane >> 3) & 7)) * 8);
#define IDX_DMA(ch) do { _Pragma("unroll") for (int i_ = 0; i_ < 8; ++i_) \
        __builtin_amdgcn_global_load_lds((const unsigned*)(dsrc + ((size_t)(512 * (ch)) + 8 * i_) * 256), (LAS unsigned*)(lds + ((ch) & 1) * 65536 + (64 * wave + 8 * i_) * 128), 16, 0, 0); } while (0)
    const int krd = c * 128;
    unsigned key[64];
    IDX_DMA(0);
#pragma unroll
    for (int ch = 0; ch < 4; ++ch) {
        if (512 * ch <= tmaxb) {
            if (512 * (ch + 1) <= tmaxb) { IDX_DMA(ch + 1); asm volatile("s_waitcnt vmcnt(8)" ::: "memory"); }
            else asm volatile("s_waitcnt vmcnt(0)" ::: "memory");
            __builtin_amdgcn_s_barrier(); asm volatile("" ::: "memory");
            const LAS unsigned char* kb_ = lds + (ch & 1) * 65536 + krd;
#pragma unroll
            for (int bi = 0; bi < 16; ++bi) { const int blk = ch * 16 + bi;
                key[blk] = 0u;
                if (blk <= maxblk) {
                    f32x16 acc = {};
#pragma unroll
                    for (int kk = 0; kk < 4; ++kk) { const bf16x8 bf = *(const LAS bf16x8*)(kb_ + bi * 4096 + (((2 * kk + kg) ^ (c & 7)) * 16));
                        acc = __builtin_amdgcn_mfma_f32_32x32x16_bf16(af[kk], bf, acc, 0, 0, 0); }
                    float sc = 0.f;
#pragma unroll
                    for (int i = 0; i < 16; ++i) sc = __builtin_fmaf(wf[i], __builtin_amdgcn_fmed3f(acc[i], 0.f, 3.0e38f), sc);
                    const unsigned u = __float_as_uint(sc); const unsigned k2 = (u >> 31) ? ~u : (u | 0x80000000u);
                    key[blk] = (blk * 32 + c <= tq) ? k2 : 0u;
                }
            }
            asm volatile("s_waitcnt lgkmcnt(0)" ::: "memory"); __builtin_amdgcn_s_barrier(); asm volatile("" ::: "memory");
        } else {
#pragma unroll
            for (int bi = 0; bi < 16; ++bi) key[ch * 16 + bi] = 0u;
        }
    }
#undef IDX_DMA
    unsigned tau = 0u; bool act = (tq + 1) > NKEEP, exact = false;
    for (int bit = 31; bit >= 0; --bit) {
        if (!__any(act)) break;
        const unsigned cand = tau | (1u << bit);
        int cnt = 0;
#pragma unroll
        for (int g4 = 0; g4 < 4; ++g4) { if (16 * g4 <= maxblk) {
#pragma unroll
            for (int bi = 0; bi < 16; bi += 4) {
                unsigned long long m0, m1, m2, m3;
                asm volatile("v_cmp_ge_u32_e64 %1, %5, %9\n\tv_cmp_ge_u32_e64 %2, %6, %9\n\tv_cmp_ge_u32_e64 %3, %7, %9\n\tv_cmp_ge_u32_e64 %4, %8, %9\n\t"
                             "v_addc_co_u32_e64 %0, %1, %0, 0, %1\n\tv_addc_co_u32_e64 %0, %2, %0, 0, %2\n\tv_addc_co_u32_e64 %0, %3, %0, 0, %3\n\tv_addc_co_u32_e64 %0, %4, %0, 0, %4"
                             : "+v"(cnt), "=&s"(m0), "=&s"(m1), "=&s"(m2), "=&s"(m3)
                             : "v"(key[16 * g4 + bi]), "v"(key[16 * g4 + bi + 1]), "v"(key[16 * g4 + bi + 2]), "v"(key[16 * g4 + bi + 3]), "v"(cand)); } } }
        DPP_ADD(cnt, 0x128); DPP_ADD(cnt, 0x124); DPP_ADD(cnt, 0x122); DPP_ADD(cnt, 0x121);
        const int r0 = __builtin_amdgcn_readlane(cnt, 0), r1 = __builtin_amdgcn_readlane(cnt, 16), r2 = __builtin_amdgcn_readlane(cnt, 32), r3 = __builtin_amdgcn_readlane(cnt, 48);
        const int tot = kg ? (r2 + r3) : (r0 + r1);
        if (act && tot >= NKEEP) tau = cand;
        if (act && tot == NKEEP) { act = false; exact = true; }
    }
    int need = 0; const bool anyt = __any(act);
    if (anyt) {
        int cnt = 0; const unsigned cand = tau + 1u;
#pragma unroll
        for (int blk = 0; blk < 64; ++blk) cnt += (key[blk] >= cand) ? 1 : 0;
        DPP_ADD(cnt, 0x128); DPP_ADD(cnt, 0x124); DPP_ADD(cnt, 0x122); DPP_ADD(cnt, 0x121);
        const int r0 = __builtin_amdgcn_readlane(cnt, 0), r1 = __builtin_amdgcn_readlane(cnt, 16), r2 = __builtin_amdgcn_readlane(cnt, 32), r3 = __builtin_amdgcn_readlane(cnt, 48);
        const int tot = kg ? (r2 + r3) : (r0 + r1);
        need = act ? NKEEP - tot : 0;
    }
    const unsigned tauX = act ? tau : (exact ? tau - 1u : 0u);
    unsigned mA = 0u, mB = 0u; int tiesb = 0;
#pragma unroll
    for (int blk = 0; blk < 64; ++blk) {
        if (blk <= maxblk) {
            bool sel = key[blk] > tauX;
            if (anyt) {
                const bool eq = act && key[blk] == tauX;
                const unsigned long long em = __ballot(eq);
                const unsigned e32 = kg ? (unsigned)(em >> 32) : (unsigned)em;
                const int rank = tiesb + __popc(e32 & ((1u << c) - 1u));
                sel = sel || (eq && rank < need);
                tiesb += __popc(e32);
            }
            const unsigned long long sm = __ballot(sel);
            if (lane == blk) { mA = (unsigned)sm; mB = (unsigned)(sm >> 32); }
        }
    }
    MW[(rowbase + t0) * 64 + lane] = mA; MW[(rowbase + t0 + 1) * 64 + lane] = mB;
}

namespace att {
constexpr int NW = 8, QBLK = 32, KVBLK = 64;
constexpr float SCALE = 0.088388347648318440f, THR = 8.f;
constexpr int LDQ = 2048, LDK = 512, LDO = 2048;
constexpr int SHM_V = KVBLK * 128 * 2, SHM_K = KVBLK * 128 * 2, SHM_ATTN = 2 * SHM_V + 2 * SHM_K + NW * 64 * 4;
typedef short s16x4 __attribute__((ext_vector_type(4)));
#define KSWZ(row, colB) ((row) * 256 + ((colB) ^ (((row) & 7) << 4)))
#define SBAR() __builtin_amdgcn_sched_barrier(0)
__device__ __forceinline__ int crow(int r, int hi) { return (r & 3) + 8 * (r >> 2) + 4 * hi; }
__device__ __forceinline__ unsigned cvtpk(float lo, float hi) { unsigned r; asm volatile("v_cvt_pk_bf16_f32 %0, %1, %2" : "=v"(r) : "v"(lo), "v"(hi)); return r; }
__device__ __forceinline__ void partialSM(f32x16& p0, f32x16& p1, float& m_reg, float& mn, float& alpha) {
  constexpr float C = SCALE * 1.4426950408889634f;
  float pmax = p0[0]; for (int r = 1; r < 16; ++r) pmax = fmaxf(pmax, p0[r]); for (int r = 0; r < 16; ++r) pmax = fmaxf(pmax, p1[r]);
  { auto rr = __builtin_amdgcn_permlane32_swap(__float_as_uint(pmax), __float_as_uint(pmax), false, false);
    pmax = fmaxf(__uint_as_float(rr[0]), __uint_as_float(rr[1])); }
  if (__builtin_expect(__all(pmax - m_reg <= THR / SCALE), 1)) { mn = m_reg; alpha = 1.f; }
  else { mn = fmaxf(m_reg, pmax); alpha = __builtin_amdgcn_exp2f((m_reg - mn) * C); m_reg = mn; }
  float mnC = -mn * C;
  for (int r = 0; r < 16; ++r) p0[r] = fmaf(p0[r], C, mnC); for (int r = 0; r < 16; ++r) p1[r] = fmaf(p1[r], C, mnC);
  for (int r = 0; r < 16; ++r) p0[r] = __builtin_amdgcn_exp2f(p0[r]);
}
__device__ __forceinline__ void finishSM(f32x16& p0, f32x16& p1, float alpha, float& l_reg, bf16x8& pa0, bf16x8& pa1, bf16x8& pa2, bf16x8& pa3) {
  for (int r = 0; r < 16; ++r) p1[r] = __builtin_amdgcn_exp2f(p1[r]);
  float ps = 0; for (int r = 0; r < 16; ++r) ps += p0[r]; for (int r = 0; r < 16; ++r) ps += p1[r];
  { auto rr = __builtin_amdgcn_permlane32_swap(__float_as_uint(ps), __float_as_uint(ps), false, false);
    ps = __uint_as_float(rr[0]) + __uint_as_float(rr[1]); }
  l_reg = l_reg * alpha + ps;
#define PK4(P, BASE, OUT) do { unsigned a0 = cvtpk(P[BASE + 0], P[BASE + 1]), a1 = cvtpk(P[BASE + 2], P[BASE + 3]);   \
    unsigned b0 = cvtpk(P[BASE + 4], P[BASE + 5]), b1 = cvtpk(P[BASE + 6], P[BASE + 7]);                              \
    auto r0 = __builtin_amdgcn_permlane32_swap(a0, b0, false, false); auto r1 = __builtin_amdgcn_permlane32_swap(a1, b1, false, false); \
    v4u w = {r0[0], r1[0], r0[1], r1[1]}; OUT = *reinterpret_cast<bf16x8*>(&w); } while (0)
  PK4(p0, 0, pa0); PK4(p0, 8, pa1); PK4(p1, 0, pa2); PK4(p1, 8, pa3);
#undef PK4
}
__device__ __forceinline__ void qkt(f32x16& p0, f32x16& p1, const char* Ks, const bf16x8* qr, int r32, int hi) {
  p0 = f32x16{}; p1 = f32x16{};
  for (int d0 = 0; d0 < 8; ++d0) { int cb = (d0 * 16 + hi * 8) * 2;
    bf16x8 b0 = *reinterpret_cast<const bf16x8*>(Ks + KSWZ(r32, cb));
    bf16x8 b1 = *reinterpret_cast<const bf16x8*>(Ks + KSWZ(32 + r32, cb));
    p0 = __builtin_amdgcn_mfma_f32_32x32x16_bf16(b0, qr[d0], p0, 0, 0, 0);
    p1 = __builtin_amdgcn_mfma_f32_32x32x16_bf16(b1, qr[d0], p1, 0, 0, 0); }
}
__device__ __forceinline__ void mask_apply(f32x16& p0, f32x16& p1, unsigned m0, unsigned m1) {
#pragma unroll
  for (int r = 0; r < 16; ++r) { const int cb = (r & 3) + 8 * (r >> 2);
    const unsigned s0 = (unsigned)(((int)(m0 << (31 - cb))) >> 31), s1 = (unsigned)(((int)(m1 << (31 - cb))) >> 31);
    p0[r] = __uint_as_float((__float_as_uint(p0[r]) & s0) | (0xFF800000u & ~s0));
    p1[r] = __uint_as_float((__float_as_uint(p1[r]) & s1) | (0xFF800000u & ~s1)); }
}
__device__ __forceinline__ int v_st(int k, int c) { const int kk = (k & ~0xC) | ((k & 4) << 1) | ((k & 8) >> 1); return ((kk >> 3) * 4 + (c >> 5)) * 512 + ((kk & 7) * 32 + (c & 31)) * 2; }
__device__ __forceinline__ int v_rd_base(int lane) { return ((lane & 3) << 3) | (((lane >> 2) & 3) << 6) | (((lane >> 4) & 1) << 5) | (((lane >> 5) & 1) << 8); }
constexpr int v_rd_off(int d0, int ks, int half) { return d0 * 512 + ks * 4096 + half * 2048; }
template <int OFF> __device__ __forceinline__ s16x4 tr_read(int vb) {
  s16x4 r; asm volatile("ds_read_b64_tr_b16 %0, %1 offset:%2" : "=&v"(r) : "v"(vb), "i"(OFF) : "memory"); return r;
}
template <int D0> __device__ __forceinline__ void pv_one(f32x16& od, int vb, bf16x8 pa0, bf16x8 pa1, bf16x8 pa2, bf16x8 pa3) {
  const s16x4 l0 = tr_read<v_rd_off(D0, 0, 0)>(vb), h0 = tr_read<v_rd_off(D0, 0, 1)>(vb), l1 = tr_read<v_rd_off(D0, 1, 0)>(vb), h1 = tr_read<v_rd_off(D0, 1, 1)>(vb);
  const s16x4 l2 = tr_read<v_rd_off(D0, 2, 0)>(vb), h2 = tr_read<v_rd_off(D0, 2, 1)>(vb), l3 = tr_read<v_rd_off(D0, 3, 0)>(vb), h3 = tr_read<v_rd_off(D0, 3, 1)>(vb);
  asm volatile("s_waitcnt lgkmcnt(0)" ::: "memory"); SBAR();
#define PK(L, H) (bf16x8){L[0], L[1], L[2], L[3], H[0], H[1], H[2], H[3]}
  od = __builtin_amdgcn_mfma_f32_32x32x16_bf16(pa0, PK(l0, h0), od, 0, 0, 0);
  od = __builtin_amdgcn_mfma_f32_32x32x16_bf16(pa1, PK(l1, h1), od, 0, 0, 0);
  od = __builtin_amdgcn_mfma_f32_32x32x16_bf16(pa2, PK(l2, h2), od, 0, 0, 0);
  od = __builtin_amdgcn_mfma_f32_32x32x16_bf16(pa3, PK(l3, h3), od, 0, 0, 0);
#undef PK
}
__device__ __forceinline__ void pv_d0(f32x16* o, int vb, bf16x8 pa0, bf16x8 pa1, bf16x8 pa2, bf16x8 pa3) {
  pv_one<0>(o[0], vb, pa0, pa1, pa2, pa3); pv_one<1>(o[1], vb, pa0, pa1, pa2, pa3); pv_one<2>(o[2], vb, pa0, pa1, pa2, pa3); pv_one<3>(o[3], vb, pa0, pa1, pa2, pa3);
}
constexpr int ATT_K0 = 0, ATT_V0 = 2 * SHM_K, ATT_WS = ATT_V0 + 3 * SHM_V, ATT_M0 = ATT_WS + NW * 64 * 4, ATT_END = ATT_M0 + 65536;
__device__ __forceinline__ void attn_masked_body(const bf16* __restrict__ Qb, const bf16* __restrict__ Kh, const bf16* __restrict__ Vh, bf16* __restrict__ Ob,
                                                 const unsigned* __restrict__ Mq, int seq, LAS unsigned char* ldsl) {
  char* lds = (char*)ldsl;
  int tid = threadIdx.x; asm volatile("" : "+v"(tid));
  const int wid = __builtin_amdgcn_readfirstlane(tid >> 6), lane = tid & 63, r32 = lane & 31, hi = lane >> 5;
  char* K_lds = lds + ATT_K0; char* V_lds = lds + ATT_V0;
  float* ws = (float*)(lds + ATT_WS) + wid * 64; float* li_l = ws; float* al_l = ws + 32;
  float m_reg = -1e30f, l_reg = 0; f32x16 o[4] = {}; bf16x8 qr[8];
  const int NT = seq / KVBLK, sh4 = 4 * hi;
  unsigned offK[2], offV[2];
#pragma unroll
  for (int q = 0; q < 2; ++q) {
      const int krow = 8 * wid + 4 * q + (lane >> 4);
      offK[q] = (unsigned)((krow * LDK + 8 * ((lane & 15) ^ (krow & 7))) * 2);
      const int kk = 8 * wid + ((lane & 31) >> 2), vk = (kk & ~0xC) | ((kk & 4) << 1) | ((kk & 8) >> 1);
      offV[q] = (unsigned)((vk * LDK + 32 * (2 * q + (lane >> 5)) + 8 * (lane & 3)) * 2);
  }
#define DMA_TILE(t, kbuf, vbuf) do { const char* kt_ = (const char*)Kh + (size_t)(t) * (KVBLK * LDK * 2); const char* vt_ = (const char*)Vh + (size_t)(t) * (KVBLK * LDK * 2); \
    _Pragma("unroll") for (int q_ = 0; q_ < 2; ++q_) { \
      __builtin_amdgcn_global_load_lds((const unsigned*)(kt_ + offK[q_]), (LAS unsigned*)(ldsl + ATT_K0 + (kbuf) * SHM_K + (2 * wid + q_) * 1024), 16, 0, 0); \
      __builtin_amdgcn_global_load_lds((const unsigned*)(vt_ + offV[q_]), (LAS unsigned*)(ldsl + ATT_V0 + (vbuf) * SHM_V + (2 * wid + q_) * 1024), 16, 0, 0); } } while (0)
#define TILE_SYNC() do { asm volatile("s_waitcnt vmcnt(0)" ::: "memory"); __builtin_amdgcn_s_barrier(); asm volatile("" ::: "memory"); } while (0)
  DMA_TILE(0, 0, 0);
  const bf16* Qw = Qb + (long)(wid * QBLK + r32) * LDQ + hi * 8;
#pragma unroll
  for (int d0 = 0; d0 < 8; ++d0) qr[d0] = *reinterpret_cast<const bf16x8*>(Qw + d0 * 16);
  char* M_lds = lds + ATT_M0;
  { v2u mw[32];
#pragma unroll
    for (int rr = 0; rr < 32; ++rr) { const int r = wid * QBLK + rr; mw[rr] = (lane < NT) ? ((const v2u*)(Mq + (size_t)r * 64))[lane] : (v2u){0u, 0u}; }
#pragma unroll
    for (int rr = 0; rr < 32; ++rr) { const int r = wid * QBLK + rr; if (lane < NT) *(v2u*)(M_lds + r * 256 + ((lane ^ rr) << 3)) = mw[rr]; } }
  const char* mrow = M_lds + (wid * QBLK + r32) * 256;
#define MLOAD(j) (*(const v2u*)(mrow + ((((j)) ^ r32) << 3)))
  const int vbase = (int)(uintptr_t)V_lds + v_rd_base(lane);
#define RESC(a) do { if (__any((a) < 1.f)) { if (hi == 0) al_l[r32] = (a); asm volatile("s_waitcnt lgkmcnt(0)" ::: "memory"); \
    for (int d = 0; d < 4; ++d) for (int r = 0; r < 16; ++r) o[d][r] *= al_l[crow(r, hi)]; } } while (0)
  f32x16 pA0, pA1, pB0, pB1; float mnA, mnB, alA, alB; bf16x8 pa0, pa1, pa2, pa3;
  TILE_SYNC();
  DMA_TILE(1, 1, 1);
  qkt(pA0, pA1, K_lds, qr, r32, hi); { const v2u mk = MLOAD(0); mask_apply(pA0, pA1, mk.x >> sh4, mk.y >> sh4); } partialSM(pA0, pA1, m_reg, mnA, alA);
  TILE_SYNC();
  int vprev = 0;
  for (int j = 1; j + 1 < NT; j += 2) {
    const int vcur = vprev == 2 ? 0 : vprev + 1, vnxt = vcur == 2 ? 0 : vcur + 1;
    DMA_TILE(j + 1, 0, vnxt);
    SBAR(); qkt(pB0, pB1, K_lds + SHM_K, qr, r32, hi);
    finishSM(pA0, pA1, alA, l_reg, pa0, pa1, pa2, pa3); SBAR();
    pv_d0(o, vbase + vprev * (int)SHM_V, pa0, pa1, pa2, pa3); { const v2u mk = MLOAD(j); mask_apply(pB0, pB1, mk.x >> sh4, mk.y >> sh4); } partialSM(pB0, pB1, m_reg, mnB, alB);
    RESC(alB); TILE_SYNC();
    DMA_TILE(j + 2, 1, vprev);
    SBAR(); qkt(pA0, pA1, K_lds, qr, r32, hi);
    finishSM(pB0, pB1, alB, l_reg, pa0, pa1, pa2, pa3); SBAR();
    pv_d0(o, vbase + vcur * (int)SHM_V, pa0, pa1, pa2, pa3); { const v2u mk = MLOAD(j + 1); mask_apply(pA0, pA1, mk.x >> sh4, mk.y >> sh4); } partialSM(pA0, pA1, m_reg, mnA, alA);
    RESC(alA); TILE_SYNC();
    vprev = vnxt;
  }
  { const int vcur = vprev == 2 ? 0 : vprev + 1;
    SBAR(); qkt(pB0, pB1, K_lds + SHM_K, qr, r32, hi);
    finishSM(pA0, pA1, alA, l_reg, pa0, pa1, pa2, pa3); SBAR();
    pv_d0(o, vbase + vprev * (int)SHM_V, pa0, pa1, pa2, pa3); { const v2u mk = MLOAD(NT - 1); mask_apply(pB0, pB1, mk.x >> sh4, mk.y >> sh4); } partialSM(pB0, pB1, m_reg, mnB, alB);
    RESC(alB);
    finishSM(pB0, pB1, alB, l_reg, pa0, pa1, pa2, pa3); SBAR();
    pv_d0(o, vbase + vcur * (int)SHM_V, pa0, pa1, pa2, pa3); }
  if (hi == 0) li_l[r32] = l_reg; asm volatile("s_waitcnt lgkmcnt(0)" ::: "memory");
  float rli[16];
#pragma unroll
  for (int r = 0; r < 16; ++r) rli[r] = __builtin_amdgcn_rcpf(li_l[crow(r, hi)]);
  bf16* Ow = Ob + (long)(wid * QBLK) * LDO;
#pragma unroll
  for (int r = 0; r < 16; ++r) { const int orow = crow(r, hi);
#pragma unroll
    for (int d0 = 0; d0 < 4; ++d0) { const float v = o[d0][r] * rli[r];
#if UPA_FP8
      ((unsigned char*)Ob)[(long)(wid * QBLK + orow) * LDO + d0 * 32 + r32] = (unsigned char)(__builtin_amdgcn_cvt_pk_fp8_f32(v * YA8_SCALE, 0.f, 0, false) & 0xff);
#else
      const float vn = __shfl_xor(v, 1);
      if ((r32 & 1) == 0) *(unsigned*)(Ow + (long)orow * LDO + d0 * 32 + r32) = cvtpk(v, vn);
#endif
    } }
  (void)Ow;
#undef DMA_TILE
#undef TILE_SYNC
#undef RESC
#undef MLOAD
}
#undef KSWZ
#undef SBAR
}

struct Args { const float* in[20]; float* out; unsigned char* ws; float inv_a[16]; float inv_i[8]; int ph_lo, ph_hi; };
enum { I_X = 0, I_C, I_WADA, I_BADA, I_GPREMIX, I_GPOSTMIX, I_WIN, I_WPOOL, I_POOLSCALE, I_WUPP, I_WUPA, I_WOUT, I_GPREFFN, I_GPOSTFFN, I_WROUTER, I_BROUTER, I_W1, I_B1, I_W2, I_B2 };

__device__ __forceinline__ void tr_item(const float* W, int ldw, int nvalid, bf16* WT, int ldt, LAS float* scr, int lane) {
    const int kr = lane >> 3, n4 = (lane & 7) * 4;
    f32x4 v[8];
#pragma unroll
    for (int i = 0; i < 8; ++i) v[i] = (n4 < nvalid) ? *(const f32x4*)(W + (size_t)(8 * i + kr) * ldw + n4) : (f32x4){0.f, 0.f, 0.f, 0.f};
#pragma unroll
    for (int i = 0; i < 8; ++i) { LAS float* d = scr + (8 * i + kr) * 33 + n4; d[0] = v[i].x; d[1] = v[i].y; d[2] = v[i].z; d[3] = v[i].w; }
    LDS_WAIT(); asm volatile("" ::: "memory");
    const int c = lane & 7;
#pragma unroll
    for (int j = 0; j < 4; ++j) { const int n = (lane >> 3) + 8 * j; const LAS float* s = scr + (8 * c) * 33 + n;
        v4u o; o.x = pk2(s[0 * 33], s[1 * 33]); o.y = pk2(s[2 * 33], s[3 * 33]); o.z = pk2(s[4 * 33], s[5 * 33]); o.w = pk2(s[6 * 33], s[7 * 33]);
        *(v4u*)(WT + (size_t)n * ldt + 8 * c) = o; }
    LDS_WAIT(); asm volatile("" ::: "memory");
}
__device__ __forceinline__ void tr_item8(const float* W, int ldw, unsigned char* WT, int ldt, float scale, LAS float* scr, int lane) {
    { const int kr = lane >> 3, s = lane & 7;
#pragma unroll
      for (int i = 0; i < 16; ++i) { const int c = 2 * (i >> 2) + (kr & 1), ip = 4 * (i & 3) + (kr >> 1), k = 16 * c + ip, g = s ^ (2 * (i >> 2));
          __builtin_amdgcn_global_load_lds((const unsigned*)(W + (size_t)k * ldw + 4 * g), (LAS unsigned*)(scr + i * 256), 16, 0, 2); } }
    VM_WAIT(); asm volatile("" ::: "memory");
    const int c = lane & 7;
#pragma unroll
    for (int j = 0; j < 4; ++j) { const int n = (lane >> 3) + 8 * j; const LAS float* sp = scr + 1024 * (c >> 1) + 32 * (c & 1) + 4 * ((n >> 2) ^ (2 * (c >> 1))) + (n & 3);
        float f[16];
#pragma unroll
        for (int ip = 0; ip < 16; ++ip) f[ip] = sp[256 * (ip >> 2) + 64 * (ip & 3)] * scale;
        v4u o; o.x = pk4_fp8(f[0], f[1], f[2], f[3]); o.y = pk4_fp8(f[4], f[5], f[6], f[7]); o.z = pk4_fp8(f[8], f[9], f[10], f[11]); o.w = pk4_fp8(f[12], f[13], f[14], f[15]);
        __builtin_nontemporal_store(o, (v4u*)(WT + (size_t)n * ldt + 16 * c)); asm volatile("" ::: "memory"); }
    LDS_WAIT(); asm volatile("" ::: "memory");
}

__device__ __forceinline__ void sincos_d(float angf, float& c_out, float& s_out) {
    const double a = (double)angf;
    const double kq = __builtin_rint(a * 0.63661977236758134308);
    double r = __builtin_fma(-kq, 1.57079632679489655800, a);
    r = __builtin_fma(-kq, 6.12323399573676603587e-17, r);
    const int q = ((int)kq) & 3;
    const double r2 = r * r;
    double sp = 1.0 / 6227020800.0; sp = sp * r2 - 1.0 / 39916800.0; sp = sp * r2 + 1.0 / 362880.0; sp = sp * r2 - 1.0 / 5040.0; sp = sp * r2 + 1.0 / 120.0; sp = sp * r2 - 1.0 / 6.0; sp = sp * r2 + 1.0;
    const double sr = sp * r;
    double cp = -1.0 / 87178291200.0; cp = cp * r2 + 1.0 / 479001600.0; cp = cp * r2 - 1.0 / 3628800.0; cp = cp * r2 + 1.0 / 40320.0; cp = cp * r2 - 1.0 / 720.0; cp = cp * r2 + 1.0 / 24.0; cp = cp * r2 - 0.5; cp = cp * r2 + 1.0;
    const double cr = cp;
    double c, s;
    if (q == 0) { c = cr; s = sr; } else if (q == 1) { c = -sr; s = cr; } else if (q == 2) { c = -cr; s = -sr; } else { c = sr; s = -cr; }
    c_out = (float)c; s_out = (float)s;
}


#define WSP(off) (wsb + (off))
#define MOD ((float*)WSP(WS_MOD))
#define WRT ((float*)WSP(WS_WRT))
#define ROPA ((float*)WSP(WS_ROPA))
#define ROPI ((float*)WSP(WS_ROPI))
#define TOPI ((int*)WSP(WS_TOPI))
#define GATE ((float*)WSP(WS_GATE))
#define SLOT ((int*)WSP(WS_SLOT))
#define WTPOOL ((bf16*)WSP(WS_WTPOOL))
#define WTUPP ((bf16*)WSP(WS_WTUPP))
#define WTUPA ((bf16*)WSP(WS_WTUPA))
#define WTOUT ((bf16*)WSP(WS_WTOUT))
#define WTIN ((bf16*)WSP(WS_WTIN))
#define W1T ((bf16*)WSP(WS_W1T))
#define W2T ((bf16*)WSP(WS_W2T))
#define Hb ((bf16*)WSP(WS_H))
#define Qb ((bf16*)WSP(WS_Q))
#define Kb ((bf16*)WSP(WS_K))
#define Vb ((bf16*)WSP(WS_V))
#define Ub ((bf16*)WSP(WS_U))
#define GLb ((bf16*)WSP(WS_GL))
#define QIb ((bf16*)WSP(WS_QI))
#define KWb ((bf16*)WSP(WS_KW))
#define MIXb ((bf16*)WSP(WS_MIX))
#define YPOOL ((bf16*)WSP(WS_YPOOL))
#define YATTN ((bf16*)WSP(WS_YATTN))
#define TMP ((float*)WSP(WS_TMP))
#define MERGED ((bf16*)WSP(WS_MERGED))
#define Yf ((float*)WSP(WS_Y))
#define X1 ((float*)WSP(WS_X1))
#define XS ((bf16*)WSP(WS_XS))
#define ACT ((bf16*)WSP(WS_ACT))
#define YS ((bf16*)WSP(WS_YS))
#define MASKW ((unsigned*)WSP(WS_MASK))
#define H8A ((unsigned char*)WSP(WS_XS + 1 * MiB))
#define WTIN8 ((unsigned char*)WSP(WS_XS + 64 * MiB))
#define ELIST ((int*)WSP(WS_XS + 40 * MiB))
#define ROWTOK ((int*)WSP(WS_XS))
#define PHASE_BASE() GAS unsigned char* wsg_ = (GAS unsigned char*)KA->ws; asm volatile("" : "+s"(wsg_)); unsigned char* wsb = (unsigned char*)wsg_; unsigned* ctl = (unsigned*)(wsb + WS_CTL); (void)ctl
#define INP(i) ((const float*)(const GAS float*)KA->in[i])
#define OUTP ((float*)(GAS float*)KA->out)
#define CAS __attribute__((address_space(4)))
extern __shared__ __attribute__((aligned(16))) unsigned char lds_raw[];
#define PH_PROLOG() \
    const CAS Args* KA = (const CAS Args*)__builtin_amdgcn_kernarg_segment_ptr(); LAS unsigned char* lds = (LAS unsigned char*)lds_raw; \
    volatile LAS unsigned* MISC = (volatile LAS unsigned*)(lds + MISC_OFF); (void)MISC; \
    const int wave = __builtin_amdgcn_readfirstlane((int)threadIdx.x >> 6); \
    const int lane = (int)__builtin_amdgcn_mbcnt_hi(~0u, __builtin_amdgcn_mbcnt_lo(~0u, 0u)), tid = wave * 64 + lane; \
    const int G = gridDim.x, bx = blockIdx.x; const int gw = bx * NWAVES + wave, NGW = G * NWAVES; (void)tid; (void)gw; (void)NGW; (void)lane

constexpr int FIRST_T_OFF = MISC_OFF + 1280, CNT_E_OFF = MISC_OFF + 1408, TILE_ROWS_OFF = MISC_OFF + 1536;
static_assert(TILE_ROWS_OFF + MAXTILES * 4 <= LDS_BYTES, "tile tables overflow the LDS block");
constexpr int FIRST_T_OFF_ = 0;
__device__ __forceinline__ void moe_tiles() {
    PH_PROLOG();
        PHASE_BASE();
        LAS int* tile_e = (LAS int*)(lds + TILE_E_OFF);
        if (wave == 0) {
            int myc = 0; if (lane < NE) myc = (int)__hip_atomic_load(ctl + CW_CUR + 64 * lane, __ATOMIC_RELAXED, __HIP_MEMORY_SCOPE_AGENT);
            const int ntl = (myc + 255) >> 8; int incl = ntl;
#pragma unroll
            for (int o = 1; o < 32; o <<= 1) { const int t = __shfl_up(incl, o); if ((lane & 31) >= o) incl += t; }
            if (lane < NE) { for (int i = incl - ntl; i < incl; ++i) { tile_e[i] = lane; const int lv = myc - (i - (incl - ntl)) * 256; ((LAS int*)(lds + TILE_ROWS_OFF))[i] = lv < 256 ? lv : 256; }
                ((LAS int*)(lds + FIRST_T_OFF))[lane] = incl - ntl; ((LAS int*)(lds + CNT_E_OFF))[lane] = myc; }
            if (lane == NE - 1) MISC[4] = (unsigned)incl;
        }
        __syncthreads();
}

__device__ __forceinline__ void phase0() {
    PH_PROLOG();
        PHASE_BASE();
        LAS float* scr = (LAS float*)(lds + wave * 16896);
        constexpr int I_IN = 296 * 32, I_PL = 128, I_UPP = UPP_FP8 ? 512 : 1024, I_UPA = UPA_FP8 ? 1024 : 2048, I_OUT = OUT_FP8 ? 1024 : 2048, I_1 = 32 * 2048, I_2 = 32 * 1024;
        constexpr int I_IN8 = GL_FP8 ? 16 * 224 : 0;
        constexpr int NIT = I_IN + I_IN8 + I_PL + I_UPP + I_UPA + I_OUT + I_1 + I_2;
        for (int it = gw; it < NIT; it += NGW) {
            int r = it;
            if (r < I_IN) { const int nb = r >> 5, kb = r & 31, d0 = 32 * nb; int src = 0, nv = 32;
                if (GL_FP8 && ((d0 >> 8) < 12 || ((d0 >> 8) >= 16 && (d0 >> 8) < 32))) continue;
                if (d0 < 2048) src = 1024 + d0; else if (d0 < 2560) src = 3072 + (d0 - 2048); else if (d0 < 3072) src = 3584 + (d0 - 2560); else if (d0 < 4096) src = d0 - 3072;
                else if (d0 < 8192) src = 5200 + (d0 - 4096); else if (d0 < 9216) src = 4096 + (d0 - 8192); else if (d0 < 9280) src = 5120 + (d0 - 9216); else if (d0 < 9312) { src = 5184; nv = 16; } else { src = 0; nv = 0; }
                tr_item(INP(I_WIN) + (size_t)(64 * kb) * 9296 + src, 9296, nv, WTIN + (size_t)d0 * 2048 + 64 * kb, 2048, scr, lane); continue; }
            r -= I_IN;
#if GL_FP8
            if (r < I_IN8) { const int kb = r / 224, nb = r % 224, p0 = 32 * nb;
                const int src = p0 < 2048 ? 1024 + p0 : p0 < 2560 ? 3072 + (p0 - 2048) : p0 < 3072 ? 3584 + (p0 - 2560) : 5200 + (p0 - 3072);
                tr_item8(INP(I_WIN) + (size_t)(128 * kb) * 9296 + src, 9296, WTIN8 + (size_t)p0 * 2048 + 128 * kb, 2048, W8_SCALE, scr, lane); continue; }
            r -= I_IN8;
#endif
            if (r < I_PL) { const int gI = r >> 5, q = r & 31, kb = q >> 3, nb = q & 7;
                tr_item(INP(I_WPOOL) + (size_t)gI * 65536 + (size_t)(64 * kb) * 256 + 32 * nb, 256, 32, WTPOOL + (size_t)gI * 65536 + (size_t)(32 * nb) * 256 + 64 * kb, 256, scr, lane); continue; }
            r -= I_PL;
            if (r < I_UPP) {
#if UPP_FP8
                const int kb = r >> 6, nb = r & 63;
                tr_item8(INP(I_WUPP) + (size_t)(128 * kb) * 2048 + 32 * nb, 2048, (unsigned char*)WTUPP + (size_t)(32 * nb) * 2048 + 128 * kb, 2048, W8_SCALE, scr, lane);
#else
                const int nb = r >> 4, kb = r & 15;
                tr_item(INP(I_WUPP) + (size_t)(64 * kb) * 2048 + 32 * nb, 2048, 32, WTUPP + (size_t)(32 * nb) * 1024 + 64 * kb, 1024, scr, lane);
#endif
                continue; }
            r -= I_UPP;
            if (r < I_UPA) {
#if UPA_FP8
                const int kb = r >> 6, nb = r & 63;
                tr_item8(INP(I_WUPA) + (size_t)(128 * kb) * 2048 + 32 * nb, 2048, (unsigned char*)WTUPA + (size_t)(32 * nb) * 2048 + 128 * kb, 2048, W8_SCALE, scr, lane);
#else
                const int nb = r >> 5, kb = r & 31;
                tr_item(INP(I_WUPA) + (size_t)(64 * kb) * 2048 + 32 * nb, 2048, 32, WTUPA + (size_t)(32 * nb) * 2048 + 64 * kb, 2048, scr, lane);
#endif
                continue; }
            r -= I_UPA;
            if (r < I_OUT) {
#if OUT_FP8
                const int kb = r >> 6, nb = r & 63;
                tr_item8(INP(I_WOUT) + (size_t)(128 * kb) * 2048 + 32 * nb, 2048, (unsigned char*)WTOUT + (size_t)(32 * nb) * 2048 + 128 * kb, 2048, W8_SCALE, scr, lane);
#else
                const int nb = r >> 5, kb = r & 31;
                tr_item(INP(I_WOUT) + (size_t)(64 * kb) * 2048 + 32 * nb, 2048, 32, WTOUT + (size_t)(32 * nb) * 2048 + 64 * kb, 2048, scr, lane);
#endif
                continue; }
            r -= I_OUT;
            if (r < I_1) { const int e = r >> 11, q = r & 2047, kb = q >> 7, nb = q & 127, c0 = 32 * nb;
                const int dst = c0 < 2048 ? 256 * (c0 >> 7) + (c0 & 127) : 256 * ((c0 - 2048) >> 7) + 128 + ((c0 - 2048) & 127);
                tr_item8(INP(I_W1) + (size_t)e * 2048 * 4096 + (size_t)(128 * kb) * 4096 + c0, 4096, (unsigned char*)W1T + ((size_t)e * 4096 + dst) * 2048 + 128 * kb, 2048, W8_SCALE, scr, lane); continue; }
            r -= I_1;
            { const int e = r >> 10, q = r & 1023, kb = q >> 6, nb = q & 63;
                tr_item8(INP(I_W2) + (size_t)e * 2048 * 2048 + (size_t)(128 * kb) * 2048 + 32 * nb, 2048, (unsigned char*)W2T + ((size_t)e * 2048 + 32 * nb) * 2048 + 128 * kb, 2048, W8_SCALE, scr, lane); }
        }
        for (int id = bx * 512 + tid; id < NE * D; id += G * 512) WRT[id] = INP(I_WROUTER)[(size_t)(id & 2047) * 32 + (id >> 11)];
        for (int id = bx * 512 + tid; id < SEQ * 24; id += G * 512) {
            if (id < SEQ * 16) { const int pos = id >> 4, i = id & 15; float c_, s_; sincos_d((float)pos * KA->inv_a[i], c_, s_); ROPA[pos * 32 + i] = c_; ROPA[pos * 32 + 16 + i] = s_; }
            else { const int id2 = id - SEQ * 16, pos = id2 >> 3, i = id2 & 7; float c_, s_; sincos_d((float)pos * KA->inv_i[i], c_, s_); ROPI[pos * 16 + i] = c_; ROPI[pos * 16 + 8 + i] = s_; }
        }
        __syncthreads();
        LAS float* cact = (LAS float*)lds;
        LAS float* red = (LAS float*)(lds + 65536);
        for (int i = tid; i < NB * D; i += 512) { const float cv = INP(I_C)[i]; cact[i] = cv / (1.0f + __expf(-cv)); }
        __syncthreads();
        for (int cb = bx; cb < 256; cb += G) {
            float a8[8];
#pragma unroll
            for (int b = 0; b < 8; ++b) a8[b] = 0.f;
            if (lane < 48) {
                const float* wp = INP(I_WADA) + cb * 48 + lane;
#pragma unroll 1
                for (int i0 = 0; i0 < 256; i0 += 16) { float wv[16];
#pragma unroll
                    for (int i = 0; i < 16; ++i) wv[i] = wp[(size_t)(wave + 8 * (i0 + i)) * 12288];
#pragma unroll
                    for (int i = 0; i < 16; ++i) { const int k = wave + 8 * (i0 + i);
#pragma unroll
                        for (int b = 0; b < 8; ++b) a8[b] += cact[b * 2048 + k] * wv[i]; } }
#pragma unroll
                for (int b = 0; b < 8; ++b) red[(wave * 8 + b) * 48 + lane] = a8[b];
            }
            __syncthreads();
            if (tid < 384) { const int b = tid / 48, cI = tid % 48; float s = 0.f;
#pragma unroll
                for (int w = 0; w < 8; ++w) s += red[(w * 8 + b) * 48 + cI];
                MOD[b * 12288 + cb * 48 + cI] = s + INP(I_BADA)[cb * 48 + cI]; }
            __syncthreads();
        }
}

__device__ __forceinline__ void phase1() {
    PH_PROLOG();
        PHASE_BASE();
        const float* gp = INP(I_GPREMIX);
        for (int m0 = gw; m0 < T; m0 += 2 * NGW) {
            f32x4 v[2][8]; float rstd[2];
#pragma unroll
            for (int u = 0; u < 2; ++u) { const f32x4* xr = (const f32x4*)(INP(I_X) + (size_t)(m0 + u * NGW) * D) + lane;
#pragma unroll
                for (int j = 0; j < 8; ++j) v[u][j] = xr[64 * j]; }
#pragma unroll
            for (int u = 0; u < 2; ++u) { float ss = 0.f;
#pragma unroll
                for (int j = 0; j < 8; ++j) ss += (v[u][j].x * v[u][j].x + v[u][j].y * v[u][j].y) + (v[u][j].z * v[u][j].z + v[u][j].w * v[u][j].w);
                rstd[u] = rsqrtf(wave_sum(ss) * (1.0f / D) + EPS); }
#pragma unroll
            for (int u = 0; u < 2; ++u) { const int m = m0 + u * NGW, b = m >> 11; const float* mod = MOD + b * 12288;
                v2u* o8 = (v2u*)(Hb + (size_t)m * D) + lane;
#pragma unroll
                for (int j = 0; j < 8; ++j) { const int col = 4 * (lane + 64 * j);
                    const f32x4 gv = *(const f32x4*)(gp + col), sc = *(const f32x4*)(mod + 2048 + col), sh = *(const f32x4*)(mod + col);
                    const f32x4 hv = (v[u][j] * rstd[u] * gv) * (sc + 1.0f) + sh;
                    v2u w; w.x = cvt_pk_bf16(hv.x, hv.y); w.y = cvt_pk_bf16(hv.z, hv.w); o8[64 * j] = w;
#if GL_FP8
                    ((unsigned*)(H8A + (size_t)m * D))[lane + 64 * j] = pk4_fp8(hv.x, hv.y, hv.z, hv.w);
#endif
                } }
        }
}

__device__ __forceinline__ void phase2() {
    PH_PROLOG();
        PHASE_BASE();
#if GL_FP8
        { pg8::Gemm g{2 * D, 2 * D, 2 * D};
          ProjOrder<0> S{T / 256, G, bx, (const char*)Hb, (const char*)WTIN, (size_t)256 * D * 2, (size_t)256 * D * 2};
          EpiProj E{Qb, Kb, Vb, Ub, GLb, QIb, KWb, ROPA, ROPI, 1.0f};
          pg8::gemm_phase<EpiProj, ProjOrder<0>>(lds, g, S, E); }
        __syncthreads();
        { pg8::Gemm g{D, D, D};
          ProjOrder<1> S{T / 256, G, bx, (const char*)H8A, (const char*)WTIN8, (size_t)256 * D, (size_t)256 * D};
          EpiProj E{Qb, Kb, Vb, Ub, GLb, QIb, KWb, ROPA, ROPI, 1.0f / W8_SCALE};
          pg8::gemm_phase<EpiProj, ProjOrder<1>, true>(lds, g, S, E); }
#else
        pg8::Gemm g{2 * D, 2 * D, 2 * D};
        DenseOrder S{T / 256, NPROJ / 256, G, bx, (const char*)Hb, (const char*)WTIN, (size_t)256 * D * 2, 0, (size_t)256 * D * 2};
        EpiProj E{Qb, Kb, Vb, Ub, GLb, QIb, KWb, ROPA, ROPI, 1.0f};
        pg8::gemm_phase<EpiProj, DenseOrder>(lds, g, S, E);
#endif
}

__device__ __forceinline__ void phase3() { }

__device__ __forceinline__ void phase4() {
    PH_PROLOG();
        PHASE_BASE();
        { Unit pu;
          if (pg8::order_next(0, G, bx, T / 256, 4, pu)) {
              { const int c8 = pu.pn * 32 + (tid & 31), seg = tid >> 5, w = 2 << pu.pn, trow0 = pu.pm * 256 + 16 * seg, pos0 = trow0 & 2047;
                const bf16* ucol = Ub + (size_t)c8 * 8;
                float S[8];
#pragma unroll
                for (int i = 0; i < 8; ++i) S[i] = 0.f;
                { const int c0 = pos0 < w ? pos0 : w;
                  for (int j = 1; j <= c0; ++j) { const v4u uv = *(const v4u*)(ucol + (size_t)(trow0 - j) * 1024);
                      S[0] += lo16(uv.x); S[1] += hi16(uv.x); S[2] += lo16(uv.y); S[3] += hi16(uv.y); S[4] += lo16(uv.z); S[5] += hi16(uv.z); S[6] += lo16(uv.w); S[7] += hi16(uv.w); } }
#pragma unroll 4
                for (int i = 0; i < 16; ++i) { const int t = trow0 + i, pos = pos0 + i;
                    const v4u uv = *(const v4u*)(ucol + (size_t)t * 1024);
                    const float f[8] = {lo16(uv.x), hi16(uv.x), lo16(uv.y), hi16(uv.y), lo16(uv.z), hi16(uv.z), lo16(uv.w), hi16(uv.w)};
#pragma unroll
                    for (int q = 0; q < 8; ++q) S[q] += f[q];
                    if (pos >= w) { const v4u lv = *(const v4u*)(ucol + (size_t)(t - w) * 1024);
                        S[0] -= lo16(lv.x); S[1] -= hi16(lv.x); S[2] -= lo16(lv.y); S[3] -= hi16(lv.y); S[4] -= lo16(lv.z); S[5] -= hi16(lv.z); S[6] -= lo16(lv.w); S[7] -= hi16(lv.w); }
                    const int cnt = (pos + 1) < w ? (pos + 1) : w; const float inv = __builtin_amdgcn_rcpf((float)cnt); v4u o;
                    o.x = pk2(S[0] * inv - f[0], S[1] * inv - f[1]); o.y = pk2(S[2] * inv - f[2], S[3] * inv - f[3]);
                    o.z = pk2(S[4] * inv - f[4], S[5] * inv - f[5]); o.w = pk2(S[6] * inv - f[6], S[7] * inv - f[7]);
                    *(v4u*)(MIXb + (size_t)t * 1024 + c8 * 8) = o; }
              }
          }
          VM_WAIT(); __syncthreads(); }
        { pg8::Gemm g{512, 2048, 512};
          DenseOrder S{T / 256, 4, G, bx, (const char*)MIXb, (const char*)WTPOOL, (size_t)256 * 1024 * 2, (size_t)256 * 2, (size_t)256 * 256 * 2};
          EpiPool E{YPOOL, INP(I_POOLSCALE)};
          pg8::gemm_phase<EpiPool, DenseOrder>(lds, g, S, E); }
        __syncthreads();
#pragma unroll 1
        for (int rnd = 0; rnd * NGW < NB * (SEQ / 2); ++rnd) {
            const int task = gw + rnd * NGW, b = task >> 10, mir = (b >> 1) & 1;
            const int tpr = task & 1023, tp = mir ? 1023 - tpr : tpr;
            const int tpr_lo = (bx * NWAVES) & 1023, tp_hi = mir ? 1023 - tpr_lo : tpr_lo + NWAVES - 1;
            indexer_task(QIb, KWb, MASKW, b, tp, 2 * tp_hi + 1, lds, wave, lane);
        }
}

__device__ __forceinline__ void phase5() {
    PH_PROLOG();
        PHASE_BASE();
#pragma unroll 1
        for (int L = bx; L < NB * 16 * 4; L += G) {
            const int b = L & 7, rest = L >> 3, h = rest >> 2, pair = rest & 3;
#pragma unroll 1
            for (int pass = 0; pass < 2; ++pass) {
                const int qb = pass ? pair : 7 - pair;
                const size_t r0 = (size_t)b * SEQ + (size_t)qb * 256;
                att::attn_masked_body(Qb + r0 * 2048 + h * 128, Kb + (size_t)b * SEQ * 512 + (h >> 2) * 128, Vb + (size_t)b * SEQ * 512 + (h >> 2) * 128,
                                      UPA_FP8 ? (bf16*)((unsigned char*)YATTN + r0 * 2048 + h * 128) : YATTN + r0 * 2048 + h * 128, MASKW + r0 * 64, (qb + 1) * 256, lds);
                __syncthreads();
            }
        }
}

__device__ __forceinline__ void phase6() {
    PH_PROLOG();
        PHASE_BASE();
        static_assert(UPP_FP8 && UPA_FP8 && OUT_FP8, "the fused up-projection runs on e4m3 operands and writes e4m3 merged");
        { pg8::Gemm g{1024, 1024, 2048};
          UpOrder S{T / 256, D / 256, G, bx, (const char*)YPOOL, (const char*)YATTN, (const char*)WTUPP, (const char*)WTUPA};
          EpiUpF E{MERGED, GLb};
          pg8::gemm_phase<EpiUpF, UpOrder, true, true>(lds, g, S, E); }
}

__device__ __forceinline__ void phase7() {
    PH_PROLOG();
        PHASE_BASE();
        pg8::Gemm g{OUT_FP8 ? D : 2 * D, OUT_FP8 ? D : 2 * D, OUT_FP8 ? D : 2 * D};
        DenseOrder S{T / 256, D / 256, G, bx, (const char*)MERGED, (const char*)WTOUT, (size_t)256 * (OUT_FP8 ? D : 2 * D), 0, (size_t)256 * (OUT_FP8 ? D : 2 * D)};
        EpiY16 E{(bf16*)Yf};
        pg8::gemm_phase<EpiY16, DenseOrder, OUT_FP8 != 0>(lds, g, S, E);
}

__device__ __forceinline__ void phase8() {
    PH_PROLOG();
        PHASE_BASE();
        const float* gpm = INP(I_GPOSTMIX); const float* gpf = INP(I_GPREFFN);
        constexpr int NEL = 11;
        const int bs0 = (4 * (bx * NWAVES)) >> 11;
        LAS float* lp = (LAS float*)lds; LAS f32x4* wl = (LAS f32x4*)(lds + 65536);
        { for (int i = tid; i < D / 4; i += 512) { ((LAS f32x4*)lp)[i] = ((const f32x4*)gpm)[i]; ((LAS f32x4*)(lp + 2048))[i] = ((const f32x4*)gpf)[i]; }
          for (int i = tid; i < 2 * (D / 4); i += 512) { const int sl = i >> 9, c4 = i & 511; const int bb = sl ? (4 * (bx * NWAVES + NGW)) >> 11 : bs0; const float* mod = MOD + bb * 12288;
              LAS float* d = lp + 4096 + sl * 6144;
              ((LAS f32x4*)d)[c4] = ((const f32x4*)(mod + 4096))[c4]; ((LAS f32x4*)(d + 2048))[c4] = ((const f32x4*)(mod + 8192))[c4] + 1.0f; ((LAS f32x4*)(d + 4096))[c4] = ((const f32x4*)(mod + 6144))[c4]; }
          const f32x4* wg = (const f32x4*)WRT;
          for (int i = tid; i < NEL * D / 4; i += 512) wl[i] = wg[i];
          __syncthreads(); }
#pragma unroll 1
        for (int grp = gw; grp < T / 4; grp += NGW) {
            int lane = (int)__builtin_amdgcn_mbcnt_hi(~0u, __builtin_amdgcn_mbcnt_lo(~0u, 0u)); asm volatile("" : "+v"(lane));
            f32x4 hv[4][8];
#pragma unroll
            for (int r = 0; r < 4; ++r) {
                const int m = grp * 4 + r, b = m >> 11; const LAS float* lpb = lp + 4096 + ((b == bs0) ? 0 : 6144);
                const v2u* yr = (const v2u*)((const bf16*)Yf + (size_t)m * D) + lane; const f32x4* xr = (const f32x4*)(INP(I_X) + (size_t)m * D) + lane;
                v2u yw[8]; f32x4 xv[8];
#pragma unroll
                for (int j = 0; j < 8; ++j) yw[j] = yr[64 * j];
#pragma unroll
                for (int j = 0; j < 8; ++j) xv[j] = xr[64 * j];
                asm volatile("" ::: "memory");
                float ss = 0.f;
#pragma unroll
                for (int j = 0; j < 8; ++j) { const f32x4 t = {lo16(yw[j].x), hi16(yw[j].x), lo16(yw[j].y), hi16(yw[j].y)}; hv[r][j] = t; ss += (t.x * t.x + t.y * t.y) + (t.z * t.z + t.w * t.w); }
                const float rstd = rsqrtf(wave_sum(ss) * (1.0f / D) + EPS);
                float ss2 = 0.f; v2u* x1r = (v2u*)((bf16*)X1 + (size_t)m * D) + lane;
#pragma unroll
                for (int h = 0; h < 2; ++h) { f32x4 gv[4], gt[4];
#pragma unroll
                    for (int q = 0; q < 4; ++q) { const int col = 4 * (lane + 64 * (4 * h + q)); gv[q] = *(const LAS f32x4*)(lp + col); gt[q] = *(const LAS f32x4*)(lpb + col); }
                    asm volatile("" ::: "memory");
#pragma unroll
                    for (int q = 0; q < 4; ++q) { const int j = 4 * h + q;
                        const f32x4 t = xv[j] + gt[q] * (hv[r][j] * rstd * gv[q]); hv[r][j] = t; { v2u w; w.x = cvt_pk_bf16(t.x, t.y); w.y = cvt_pk_bf16(t.z, t.w); x1r[64 * j] = w; }
                        ss2 += (t.x * t.x + t.y * t.y) + (t.z * t.z + t.w * t.w); }
                    asm volatile("" ::: "memory"); }
                const float rstd2 = rsqrtf(wave_sum(ss2) * (1.0f / D) + EPS);
                unsigned* o8 = (unsigned*)((unsigned char*)Hb + (size_t)m * D) + lane;
#pragma unroll
                for (int h = 0; h < 2; ++h) { f32x4 gv[4], sc[4], sh[4];
#pragma unroll
                    for (int q = 0; q < 4; ++q) { const int col = 4 * (lane + 64 * (4 * h + q)); gv[q] = *(const LAS f32x4*)(lp + 2048 + col); sc[q] = *(const LAS f32x4*)(lpb + 2048 + col); sh[q] = *(const LAS f32x4*)(lpb + 4096 + col); }
                    asm volatile("" ::: "memory");
#pragma unroll
                    for (int q = 0; q < 4; ++q) { const int j = 4 * h + q;
                        const f32x4 t = (hv[r][j] * rstd2 * gv[q]) * sc[q] + sh[q]; hv[r][j] = t;
                        o8[64 * j] = pk4_fp8(t.x, t.y, t.z, t.w); }
                    asm volatile("" ::: "memory"); }
                asm volatile("" : "+v"(lane) :: "memory");
            }
            float lgA[4] = {0.f, 0.f, 0.f, 0.f}, lgB[4] = {0.f, 0.f, 0.f, 0.f};
            const int l15 = lane & 15;
#pragma unroll 1
            for (int e = 0; e < NEL; ++e) {
                const LAS f32x4* wp = wl + e * (D / 4) + lane;
                f32x2 p2[4] = {{0.f, 0.f}, {0.f, 0.f}, {0.f, 0.f}, {0.f, 0.f}};
#pragma unroll
                for (int j = 0; j < 8; ++j) { const f32x4 w = wp[64 * j]; const f32x2 w01 = {w.x, w.y}, w23 = {w.z, w.w};
#pragma unroll
                    for (int r = 0; r < 4; ++r) { p2[r] += (f32x2){hv[r][j].x, hv[r][j].y} * w01; p2[r] += (f32x2){hv[r][j].z, hv[r][j].w} * w23; } }
                const float p[4] = {p2[0].x + p2[0].y, p2[1].x + p2[1].y, p2[2].x + p2[2].y, p2[3].x + p2[3].y};
#pragma unroll
                for (int r = 0; r < 4; ++r) { const float sR = row_sum16(p[r]); lgA[r] = (l15 == e) ? sR : lgA[r]; }
            }
#pragma unroll 1
            for (int e = NEL; e < 16; ++e) {
                const f32x4* wp = (const f32x4*)(WRT + (size_t)e * D) + lane;
                f32x2 p2[4] = {{0.f, 0.f}, {0.f, 0.f}, {0.f, 0.f}, {0.f, 0.f}};
#pragma unroll
                for (int j = 0; j < 8; ++j) { const f32x4 w = wp[64 * j]; const f32x2 w01 = {w.x, w.y}, w23 = {w.z, w.w};
#pragma unroll
                    for (int r = 0; r < 4; ++r) { p2[r] += (f32x2){hv[r][j].x, hv[r][j].y} * w01; p2[r] += (f32x2){hv[r][j].z, hv[r][j].w} * w23; } }
                const float p[4] = {p2[0].x + p2[0].y, p2[1].x + p2[1].y, p2[2].x + p2[2].y, p2[3].x + p2[3].y};
#pragma unroll
                for (int r = 0; r < 4; ++r) { const float sR = row_sum16(p[r]); lgA[r] = (l15 == e) ? sR : lgA[r]; }
            }
#pragma unroll 1
            for (int e = 0; e < 16; ++e) {
                const f32x4* wp = (const f32x4*)(WRT + (size_t)(16 + e) * D) + lane;
                f32x2 p2[4] = {{0.f, 0.f}, {0.f, 0.f}, {0.f, 0.f}, {0.f, 0.f}};
#pragma unroll
                for (int j = 0; j < 8; ++j) { const f32x4 w = wp[64 * j]; const f32x2 w01 = {w.x, w.y}, w23 = {w.z, w.w};
#pragma unroll
                    for (int r = 0; r < 4; ++r) { p2[r] += (f32x2){hv[r][j].x, hv[r][j].y} * w01; p2[r] += (f32x2){hv[r][j].z, hv[r][j].w} * w23; } }
                const float p[4] = {p2[0].x + p2[0].y, p2[1].x + p2[1].y, p2[2].x + p2[2].y, p2[3].x + p2[3].y};
#pragma unroll
                for (int r = 0; r < 4; ++r) { const float sR = row_sum16(p[r]); lgB[r] = (l15 == e) ? sR : lgB[r]; }
            }
#pragma unroll
            for (int r = 0; r < 4; ++r) { lgA[r] += __shfl_xor(lgA[r], 16); lgA[r] += __shfl_xor(lgA[r], 32); lgB[r] += __shfl_xor(lgB[r], 16); lgB[r] += __shfl_xor(lgB[r], 32); }
            const float brt = INP(I_BROUTER)[lane & 31];
            int tiA[4][4]; float gA[4][4];
#pragma unroll
            for (int r = 0; r < 4; ++r) {
                float lv = (lane < NE) ? ((lane < 16) ? lgA[r] : lgB[r]) + brt : -__builtin_inff();
                float tv[4];
#pragma unroll
                for (int k = 0; k < 4; ++k) {
                    float m1 = row_max16(lv); m1 = __builtin_fmaxf(m1, __shfl_xor(m1, 16));
                    const float mx = __builtin_bit_cast(float, __builtin_amdgcn_readlane(__builtin_bit_cast(int, m1), 0));
                    int c1 = row_min16i((lv == mx) ? lane : 99); { const int t = __shfl_xor(c1, 16); c1 = t < c1 ? t : c1; }
                    const int ie = __builtin_amdgcn_readlane(c1, 0);
                    tv[k] = mx; tiA[r][k] = ie; if (lane == ie) lv = -__builtin_inff(); }
                const float e1 = __expf(tv[1] - tv[0]), e2 = __expf(tv[2] - tv[0]), e3 = __expf(tv[3] - tv[0]); const float is = 1.0f / (1.0f + e1 + e2 + e3);
                gA[r][0] = is; gA[r][1] = e1 * is; gA[r][2] = e2 * is; gA[r][3] = e3 * is;
            }
            if (lane < 4) {
                const int m = grp * 4 + lane; int ti[4]; float gg[4];
#pragma unroll
                for (int k = 0; k < 4; ++k) { ti[k] = lane == 0 ? tiA[0][k] : lane == 1 ? tiA[1][k] : lane == 2 ? tiA[2][k] : tiA[3][k]; gg[k] = lane == 0 ? gA[0][k] : lane == 1 ? gA[1][k] : lane == 2 ? gA[2][k] : gA[3][k]; }
                *(int4*)(TOPI + (size_t)m * 4) = make_int4(ti[0], ti[1], ti[2], ti[3]); *(f32x4*)(GATE + (size_t)m * 4) = (f32x4){gg[0], gg[1], gg[2], gg[3]};
                int ps[4];
#pragma unroll
                for (int k = 0; k < 4; ++k) ps[k] = (int)xb_add(ctl + CW_CUR + 64 * ti[k], 1u);
#pragma unroll
                for (int k = 0; k < 4; ++k) ELIST[ti[k] * 16384 + ps[k]] = m;
                *(int4*)(SLOT + (size_t)m * 4) = make_int4(ps[0], ps[1], ps[2], ps[3]); }
        }
}

__device__ __forceinline__ void phase9() { }

__device__ __forceinline__ void phase10() {
    PH_PROLOG();
    moe_tiles();
        PHASE_BASE();
        const int ntiles = (int)MISC[4]; const LAS int* tile_e = (const LAS int*)(lds + TILE_E_OFF);
        pg8::Gemm g{D, D, D};
        LAS int* tokL = (LAS int*)(lds + TOK_OFF);
        MoeOrder S{ntiles, 16, G, bx, (const char*)Hb, (const char*)W1T, 0, (size_t)4096 * D, (size_t)256 * D, tile_e, tokL, (const LAS int*)(lds + TILE_ROWS_OFF), 1};
        { const LAS int* first_t = (const LAS int*)(lds + FIRST_T_OFF); const LAS int* cnt_e = (const LAS int*)(lds + CNT_E_OFF);
          int tv[9]; const int r8 = tid & 255;
#pragma unroll
          for (int q = 0; q < 9; ++q) { const int i = (tid >> 8) + 2 * q; Unit u; const bool ok = S.next(i, u); const int pm = ok ? u.pm : 0;
              const int rr = r8 + (ok ? u.roff : 0);
              const int e = tile_e[pm], r = (pm - first_t[e]) * 256 + rr; const bool live = ok && (rr < 256) && (r < cnt_e[e]);
              const int v = ELIST[live ? e * 16384 + r : 0]; tv[q] = live ? v : 0; }
#pragma unroll
          for (int q = 0; q < 9; ++q) { const int i = (tid >> 8) + 2 * q; tokL[i * 256 + r8] = tv[q]; } }
        __syncthreads();
        EpiAct E{(unsigned char*)ACT, INP(I_B1), tile_e, (LAS float*)(lds + TOK_OFF + 18 * 1024)};
        pg8::gemm_phase<EpiAct, MoeOrder, true, true>(lds, g, S, E);
}

__device__ __forceinline__ void phase11() {
    PH_PROLOG();
    moe_tiles();
        PHASE_BASE();
        const int ntiles = (int)MISC[4]; const LAS int* tile_e = (const LAS int*)(lds + TILE_E_OFF);
        pg8::Gemm g{DFF, DFF, DFF};
        MoeOrder S{ntiles, 8, G, bx, (const char*)ACT, (const char*)W2T, (size_t)256 * DFF, (size_t)2048 * DFF, (size_t)256 * DFF, tile_e, nullptr, (const LAS int*)(lds + TILE_ROWS_OFF), 1};
        EpiYs E{(unsigned char*)YS, INP(I_B2), tile_e, (LAS float*)(lds + TOK_OFF + 18 * 1024)};
        pg8::gemm_phase<EpiYs, MoeOrder, true>(lds, g, S, E);
}

__device__ __forceinline__ void phase12() {
    PH_PROLOG();
        PHASE_BASE();
        const float* gpo = INP(I_GPOSTFFN);
        int frow;
        { int myc = 0; if (lane < NE) myc = (int)__hip_atomic_load(ctl + CW_CUR + 64 * lane, __ATOMIC_RELAXED, __HIP_MEMORY_SCOPE_AGENT);
          const int padded = (myc + 255) & ~255; int incl = padded;
#pragma unroll
          for (int o = 1; o < 32; o <<= 1) { const int t = __shfl_up(incl, o); if ((lane & 31) >= o) incl += t; }
          frow = incl - padded; }
        int4 sl = *(const int4*)(SLOT + (size_t)gw * 4), te = *(const int4*)(TOPI + (size_t)gw * 4); f32x4 gt4 = *(const f32x4*)(GATE + (size_t)gw * 4);
#pragma unroll 1
        for (int m = gw; m < T; m += NGW) {
            int lane = (int)__builtin_amdgcn_mbcnt_hi(~0u, __builtin_amdgcn_mbcnt_lo(~0u, 0u)); asm volatile("" : "+v"(lane));
            const int b = m >> 11; const float* mod = MOD + b * 12288;
            const int sk[4] = {__shfl(frow, te.x) + sl.x, __shfl(frow, te.y) + sl.y, __shfl(frow, te.z) + sl.z, __shfl(frow, te.w) + sl.w}; constexpr float IYS = 1.0f / YS8_SCALE; const float gk[4] = {gt4.x * IYS, gt4.y * IYS, gt4.z * IYS, gt4.w * IYS};
            unsigned yw[4][8]; v2u xw[8];
#pragma unroll
            for (int k = 0; k < 4; ++k) { const unsigned* yp = (const unsigned*)((const unsigned char*)YS + (size_t)sk[k] * D) + lane;
#pragma unroll
                for (int j = 0; j < 8; ++j) yw[k][j] = yp[64 * j]; }
            const v2u* x1r = (const v2u*)((const bf16*)X1 + (size_t)m * D) + lane;
#pragma unroll
            for (int j = 0; j < 8; ++j) xw[j] = x1r[64 * j];
            { const int mn = (m + NGW < T) ? m + NGW : m; sl = *(const int4*)(SLOT + (size_t)mn * 4); te = *(const int4*)(TOPI + (size_t)mn * 4); gt4 = *(const f32x4*)(GATE + (size_t)mn * 4); }
            asm volatile("" ::: "memory");
            f32x4 a[8];
#pragma unroll
            for (int j = 0; j < 8; ++j) a[j] = (f32x4){0.f, 0.f, 0.f, 0.f};
#pragma unroll
            for (int k = 0; k < 4; ++k)
#pragma unroll
                for (int j = 0; j < 8; ++j) { const int w = (int)yw[k][j]; const f32x2 lo = __builtin_amdgcn_cvt_pk_f32_fp8(w, false), hi = __builtin_amdgcn_cvt_pk_f32_fp8(w, true);
                    a[j] += (f32x4){lo.x, lo.y, hi.x, hi.y} * gk[k]; }
            float ss = 0.f;
#pragma unroll
            for (int j = 0; j < 8; ++j) ss += (a[j].x * a[j].x + a[j].y * a[j].y) + (a[j].z * a[j].z + a[j].w * a[j].w);
            const float rstd = rsqrtf(wave_sum(ss) * (1.0f / D) + EPS);
            f32x4* orow = (f32x4*)(OUTP + (size_t)m * D) + lane;
#pragma unroll
            for (int j = 0; j < 8; ++j) { const int col = 4 * (lane + 64 * j);
                const f32x4 gv = *(const f32x4*)(gpo + col), gt = *(const f32x4*)(mod + 10240 + col);
                __builtin_nontemporal_store((f32x4){lo16(xw[j].x), hi16(xw[j].x), lo16(xw[j].y), hi16(xw[j].y)} + gt * (a[j] * rstd * gv), orow + 64 * j); }
        }
}

__global__ void __launch_bounds__(NWAVES * 64, 2) fwd_kernel(Args args) {
    LAS unsigned char* lds = (LAS unsigned char*)lds_raw;
    volatile LAS unsigned* MISC = (volatile LAS unsigned*)(lds + MISC_OFF);
    const int wave = __builtin_amdgcn_readfirstlane((int)threadIdx.x >> 6);
    const int lane = (int)__builtin_amdgcn_mbcnt_hi(~0u, __builtin_amdgcn_mbcnt_lo(~0u, 0u)), tid = wave * 64 + lane;
    unsigned* ctl0 = (unsigned*)(args.ws + WS_CTL);
    for (int u = tid; u < (LDS_BYTES - MISC_OFF) / 4; u += NWAVES * 64) ((LAS unsigned*)(lds + MISC_OFF))[u] = 0u;
    __syncthreads();
    XcdBarrier bar; bar.bar = ctl0 + CW_BAR; bar.x = 0; bar.st = nullptr;
    if (MK_N_LAUNCHES == 1) bar = xcd_barrier_post(ctl0 + CW_BAR, MISC);
    const int lo = args.ph_lo, hi = args.ph_hi;
#ifndef PHMASK
#define PHMASK 0xFFFF
#endif
#define IN(k) ((((PHMASK) >> (k)) & 1) && lo <= (k) && (k) < hi)
#define SEAM(k) do { if (IN(k) && IN((k) + 1)) xcd_barrier(bar); } while (0)
#ifndef PROBE_MASK
#define PROBE_MASK 0
#endif
#define REP(k) _Pragma("unroll") for (int rep_ = 0; rep_ < ((((PROBE_MASK) >> (k)) & 1) ? 2 : 1); ++rep_)

    if (IN(0)) REP(0) { if (rep_) __syncthreads(); phase0(); }
    SEAM(0);

    if (IN(1)) REP(1) { if (rep_) __syncthreads(); phase1(); }
    SEAM(1);

    if (IN(2)) REP(2) { if (rep_) __syncthreads(); phase2(); }
    SEAM(2);


    if (IN(4)) REP(4) { if (rep_) __syncthreads(); phase4(); }
    SEAM(4);
    if (IN(5)) REP(5) { if (rep_) __syncthreads(); phase5(); }
    SEAM(5);

    if (IN(6)) REP(6) { if (rep_) __syncthreads(); phase6(); }
    SEAM(6);

    if (IN(7)) REP(7) { if (rep_) __syncthreads(); phase7(); }
    SEAM(7);

    if (IN(8)) { phase8(); }
    SEAM(8);


    if (IN(10)) REP(10) { if (rep_) __syncthreads(); phase10(); }
    SEAM(10);
    if (IN(11)) REP(11) { if (rep_) __syncthreads(); phase11(); }
    SEAM(11);

    if (IN(12)) REP(12) { if (rep_) __syncthreads(); phase12(); }
#undef IN
#undef SEAM
}

constexpr int NPHASES = 13;
extern "C" void kernel_launch(void* const* d_in, const int* in_sizes, int n_in, void* d_out, int out_size, void* d_ws, size_t ws_size, hipStream_t stream) {
    static int grid = 0;
    if (grid == 0) {
        if (n_in != 20 || out_size != T * D || ws_size < WS_END) { fprintf(stderr, "kernel_launch: unexpected shapes (n_in %d out %d ws %zu need %zu)\n", n_in, out_size, ws_size, (size_t)WS_END); grid = -1; return; }
        int dev = 0, cus = 0, per_cu = 0;
        if (hipGetDevice(&dev) != hipSuccess || hipDeviceGetAttribute(&cus, hipDeviceAttributeMultiprocessorCount, dev) != hipSuccess) { grid = -1; return; }
        if (hipFuncSetAttribute((const void*)fwd_kernel, hipFuncAttributeMaxDynamicSharedMemorySize, LDS_BYTES) != hipSuccess) { fprintf(stderr, "kernel_launch: hipFuncSetAttribute failed\n"); grid = -1; return; }
        if (hipOccupancyMaxActiveBlocksPerMultiprocessor(&per_cu, (const void*)fwd_kernel, NWAVES * 64, LDS_BYTES) != hipSuccess || per_cu < 1)
            fprintf(stderr, "kernel_launch: occupancy query reports %d workgroups per CU\n", per_cu);
        (void)hipGetLastError();
        grid = cus;
        if (grid != 256) fprintf(stderr, "kernel_launch: %d CUs (built for 256)\n", grid);
    }
    if (grid < 0) return;
    (void)in_sizes;
    if (hipMemsetAsync((char*)d_ws + WS_CTL, 0, CTL_ZERO_BYTES, stream) != hipSuccess) { fprintf(stderr, "kernel_launch: memset failed\n"); return; }
    Args a{};
    for (int i = 0; i < 20; ++i) a.in[i] = (const float*)d_in[i];
    a.out = (float*)d_out; a.ws = (unsigned char*)d_ws;
    for (int i = 0; i < 16; ++i) a.inv_a[i] = (float)pow(500000.0, -(double)(2 * i) / 32.0);
    for (int i = 0; i < 8; ++i) a.inv_i[i] = (float)pow(500000.0, -(double)(2 * i) / 16.0);
#if MK_N_LAUNCHES == 1
    a.ph_lo = 0; a.ph_hi = NPHASES;
    hipLaunchKernelGGL(fwd_kernel, dim3(grid), dim3(NWAVES * 64), LDS_BYTES, stream, a);
#else
    for (int p = 0; p < NPHASES; ++p) { a.ph_lo = p; a.ph_hi = p + 1; hipLaunchKernelGGL(fwd_kernel, dim3(grid), dim3(NWAVES * 64), LDS_BYTES, stream, a); }
#endif
    const hipError_t le = hipPeekAtLastError();
    if (le != hipSuccess) fprintf(stderr, "kernel_launch: launch failed: %s\n", hipGetErrorName(le));
}
```

```cpp
#include <hip/hip_runtime.h>
#include <cstdio>
#include <cstdint>
#include <cmath>

#ifndef MK_N_LAUNCHES
#define MK_N_LAUNCHES 1
#endif

#define GAS __attribute__((address_space(1)))
#define LAS __attribute__((address_space(3)))
typedef unsigned short bf16;
typedef unsigned v4u __attribute__((ext_vector_type(4)));
typedef unsigned v2u __attribute__((ext_vector_type(2)));
typedef float f32x4 __attribute__((ext_vector_type(4)));
typedef float f32x2 __attribute__((ext_vector_type(2)));
typedef short bf16x8 __attribute__((ext_vector_type(8)));
#define LDS_WAIT() asm volatile("s_waitcnt lgkmcnt(0)" ::: "memory")
#define VM_WAIT() asm volatile("s_waitcnt vmcnt(0)" ::: "memory")

constexpr int NB = 8, SEQ = 2048, D = 2048, T = NB * SEQ;
constexpr int NPROJ = 9472;
constexpr int NE = 32, TOPK = 4, DFF = 2048;
constexpr int MAXTILES = (T * TOPK) / 256 + NE;
constexpr int MAXROWS = MAXTILES * 256;
constexpr int NKEEP = 256;
constexpr float EPS = 1e-6f;
constexpr int NWAVES = 8;
#ifndef ATT_END
#define ATT_END T
#endif

constexpr size_t MiB = 1u << 20;
constexpr size_t WS_CTL = 0, CTL_ZERO_BYTES = 1 * MiB;
constexpr size_t WS_MOD = 1 * MiB;
constexpr size_t WS_WRT = 1 * MiB + 512 * 1024;
constexpr size_t WS_ROPA = 2 * MiB;
constexpr size_t WS_ROPI = 2 * MiB + 512 * 1024;
constexpr size_t WS_TOPI = 3 * MiB;
constexpr size_t WS_GATE = 3 * MiB + 256 * 1024;
constexpr size_t WS_SLOT = 3 * MiB + 512 * 1024;
constexpr size_t WS_WTPOOL = 4 * MiB;
constexpr size_t WS_WTUPP = 5 * MiB;
constexpr size_t WS_WTUPA = 9 * MiB;
constexpr size_t WS_WTOUT = 17 * MiB;
constexpr size_t WS_WTIN = 25 * MiB;
constexpr size_t WS_W1T = 64 * MiB;
constexpr size_t WS_W2T = 576 * MiB;
constexpr size_t WS_H = 832 * MiB;
constexpr size_t WS_Q = 896 * MiB;
constexpr size_t WS_K = 960 * MiB;
constexpr size_t WS_V = 976 * MiB;
constexpr size_t WS_U = 992 * MiB;
constexpr size_t WS_GL = 1024 * MiB;
constexpr size_t WS_QI = 1152 * MiB;
constexpr size_t WS_KW = 1184 * MiB;
constexpr size_t WS_MIX = 1192 * MiB;
constexpr size_t WS_YPOOL = 1224 * MiB;
constexpr size_t WS_YATTN = 1256 * MiB;
constexpr size_t WS_TMP = 1320 * MiB;
constexpr size_t WS_MERGED = 1448 * MiB;
constexpr size_t WS_Y = 1512 * MiB;
constexpr size_t WS_X1 = 1640 * MiB;
constexpr size_t WS_XS = 1768 * MiB;
constexpr size_t WS_ACT = 2056 * MiB;
constexpr size_t WS_YS = 2344 * MiB;
constexpr size_t WS_MASK = 2632 * MiB;
constexpr size_t WS_END = 2636 * MiB;
constexpr int CW_BAR = 4096;
constexpr int CW_CNT = 16384;
constexpr int CW_CUR = 20480;

constexpr int RING_BYTES = 131072;
constexpr int TOK_OFF = RING_BYTES;
constexpr int MISC_OFF = 155648;
constexpr int TILE_E_OFF = MISC_OFF + 64;
constexpr int LDS_BYTES = MISC_OFF + 4096;

__device__ __forceinline__ float bf2f(unsigned b) { return __uint_as_float(b << 16); }
__device__ __forceinline__ unsigned f2bf(float f) { unsigned u = __float_as_uint(f); return (u + 0x7fffu + ((u >> 16) & 1u)) >> 16; }
__device__ __forceinline__ unsigned pk2(float lo, float hi) { return f2bf(lo) | (f2bf(hi) << 16); }
__device__ __forceinline__ float lo16(unsigned w) { return __uint_as_float(w << 16); }
__device__ __forceinline__ float hi16(unsigned w) { return __uint_as_float(w & 0xffff0000u); }
__device__ __forceinline__ float wave_sum(float v) {
#pragma unroll
    for (int o = 1; o < 64; o <<= 1) v += __shfl_xor(v, o);
    return v;
}
__device__ __forceinline__ float wave_max(float v) {
#pragma unroll
    for (int o = 1; o < 64; o <<= 1) v = fmaxf(v, __shfl_xor(v, o));
    return v;
}
__device__ __forceinline__ int wave_min_i(int v) {
#pragma unroll
    for (int o = 1; o < 64; o <<= 1) { int t = __shfl_xor(v, o); v = t < v ? t : v; }
    return v;
}
__device__ __forceinline__ unsigned pk4_fp8(float a, float b, float c, float d) {
    int w = __builtin_amdgcn_cvt_pk_fp8_f32(a, b, 0, false); w = __builtin_amdgcn_cvt_pk_fp8_f32(c, d, w, true); return (unsigned)w; }
#ifndef GL_FP8
#define GL_FP8 1
#endif
#ifndef UPP_FP8
#define UPP_FP8 1
#endif
#ifndef UPA_FP8
#define UPA_FP8 1
#endif
#ifndef OUT_FP8
#define OUT_FP8 1
#endif
constexpr float W8_SCALE = 64.0f, ACT8_SCALE = 4.0f, YA8_SCALE = 4.0f, YS8_SCALE = 4.0f;
template <int CTRL> __device__ __forceinline__ float dppf(float v) { return __builtin_bit_cast(float, __builtin_amdgcn_update_dpp(0, __builtin_bit_cast(int, v), CTRL, 0xF, 0xF, true)); }
template <int CTRL> __device__ __forceinline__ int dppi(int v) { return __builtin_amdgcn_update_dpp(0, v, CTRL, 0xF, 0xF, true); }
__device__ __forceinline__ float row_sum16(float v) { v += dppf<0x128>(v); v += dppf<0x124>(v); v += dppf<0x122>(v); v += dppf<0x121>(v); return v; }
__device__ __forceinline__ float row_max16(float v) { v = __builtin_fmaxf(v, dppf<0x128>(v)); v = __builtin_fmaxf(v, dppf<0x124>(v)); v = __builtin_fmaxf(v, dppf<0x122>(v)); v = __builtin_fmaxf(v, dppf<0x121>(v)); return v; }
__device__ __forceinline__ int row_min16i(int v) { int t = dppi<0x128>(v); v = t < v ? t : v; t = dppi<0x124>(v); v = t < v ? t : v; t = dppi<0x122>(v); v = t < v ? t : v; t = dppi<0x121>(v); v = t < v ? t : v; return v; }
__device__ __forceinline__ float sigmoidf_(float x) { return __builtin_amdgcn_rcpf(1.0f + __builtin_amdgcn_exp2f(-1.4426950408889634f * x)); }

#define XB_TMO      128
#define XB_XCNT(j)  (256  + 64 * (j))
#define XB_XSUB(j)  (1280 + 64 * (j))
#define XB_XGEN(j)  (2304 + 64 * (j))
#define XB_TOP      3328
#define XB_TOPGEN   3392
#define XCD_BAR_WORDS 3456
#define XB_SPIN_CAP (1u << 22)

__device__ __forceinline__ unsigned xb_ld(unsigned* p)              { return __hip_atomic_load(p, __ATOMIC_RELAXED, __HIP_MEMORY_SCOPE_AGENT); }
__device__ __forceinline__ unsigned xb_add(unsigned* p, unsigned v) { return __hip_atomic_fetch_add(p, v, __ATOMIC_RELAXED, __HIP_MEMORY_SCOPE_AGENT); }
__device__ __forceinline__ unsigned xb_xcc_id() { return (unsigned)__builtin_amdgcn_s_getreg((3 << 11) | 20) & 0xFu; }
#define XB_SPIN(cond, bar) do { unsigned _sp = 0; while (cond) { __builtin_amdgcn_s_sleep(1); \
    if ((++_sp & 255u) == 0u) { if (xb_ld(&(bar)[XB_TMO])) break; if (_sp > XB_SPIN_CAP) { atomicAdd(&(bar)[XB_TMO], 1u); break; } } } } while (0)

struct XcdBarrier { unsigned* bar; unsigned x; volatile LAS unsigned* st; };

__device__ __forceinline__ XcdBarrier xcd_barrier_post(unsigned* bar, volatile LAS unsigned* st) {
    XcdBarrier b; b.bar = bar; b.x = xb_xcc_id(); b.st = st;
    if (threadIdx.x == 0) (void)xb_add(&bar[XB_XCNT(b.x)], 1u);
    return b;
}
__device__ __forceinline__ void xcd_barrier_complete(unsigned* bar, unsigned x, unsigned& nloc, unsigned& nx) {
    const unsigned G = gridDim.x * gridDim.y * gridDim.z;
    unsigned sum, cnt, mine, sp = 0u;
    for (;;) {
        sum = 0u; cnt = 0u; mine = 0u;
#pragma unroll
        for (unsigned j = 0; j < 16; ++j) { const unsigned c = xb_ld(&bar[XB_XCNT(j)]); sum += c; cnt += (c > 0u) ? 1u : 0u; mine = (j == x) ? c : mine; }
        if (sum == G) break;
        __builtin_amdgcn_s_sleep(1);
        if ((++sp & 255u) == 0u) { if (xb_ld(&bar[XB_TMO])) break; if (sp > XB_SPIN_CAP) { atomicAdd(&bar[XB_TMO], 1u); break; } }
    }
    nloc = mine > 0u ? mine : 1u; nx = cnt > 0u ? cnt : 1u;
}
__device__ __forceinline__ void xcd_barrier(const XcdBarrier& b) {
    asm volatile("s_waitcnt vmcnt(0)" ::: "memory");
    __syncthreads();
    if (threadIdx.x == 0) {
        unsigned* bar = b.bar;
        __builtin_amdgcn_s_waitcnt(0);
        unsigned nloc = b.st[0], nx = b.st[1];
        if (nloc == 0u) { xcd_barrier_complete(bar, b.x, nloc, nx); b.st[0] = nloc; b.st[1] = nx; }
        const unsigned old = xb_add(&bar[XB_XSUB(b.x)], 1u);
        const unsigned gen = old / nloc;
        if (old + 1u == (gen + 1u) * nloc) {
            __builtin_amdgcn_fence(__ATOMIC_RELEASE, "agent");
            asm volatile("s_waitcnt vmcnt(0)" ::: "memory");
            const unsigned og = xb_add(&bar[XB_TOP], 1u);
            const unsigned tg = og / nx;
            if (og + 1u == (tg + 1u) * nx) xb_add(&bar[XB_TOPGEN], 1u);
            else XB_SPIN(xb_ld(&bar[XB_TOPGEN]) == tg, bar);
            __builtin_amdgcn_fence(__ATOMIC_ACQUIRE, "agent");
            xb_add(&bar[XB_XGEN(b.x)], 1u);
            asm volatile("s_waitcnt vmcnt(0)" ::: "memory");
        } else {
            XB_SPIN(xb_ld(&bar[XB_XGEN(b.x)]) == gen, bar);
            __builtin_amdgcn_fence(__ATOMIC_ACQUIRE, "agent");
            asm volatile("s_waitcnt vmcnt(0)" ::: "memory");
        }
    }
    __syncthreads();
}

namespace pg8 {
constexpr int BM = 256, BK = 64, HALF = 128, HTB = HALF * BK * 2, STAGE_BYTES = 8 * HTB, NXCD = 8, WGM = 8;
__host__ __device__ __forceinline__ int lds_byte(int r, int c) { const int st = (r >> 4) * 2 + (c >> 5), rr = r & 15, cc = c & 31, ob = rr * 64 + cc * 2; return st * 1024 + (ob ^ (((ob >> 9) & 1) << 5)); }
__host__ __device__ __forceinline__ void stage_rc(int b, int& R, int& C) { const int st = b / 1024, sb = b % 1024, swz = sb ^ (((sb >> 9) & 1) << 5); R = (st >> 1) * 16 + swz / 64; C = (st & 1) * 32 + (swz % 64) / 2; }
__host__ __device__ __forceinline__ int perm32(int rho) { const int n = rho >> 4, i = rho & 15; return 8 * (i >> 2) + 4 * n + (i & 3); }
struct Unit { int pm, pn, half, roff, sub; };
struct Gemm { int Kb, lda, ldb; };

__device__ __forceinline__ void order_map(int L, int nM, int nN, Unit& u) {
    const int nwg = nM * nN;
    int wgid = L; { const int q = nwg / NXCD, r = nwg % NXCD, xcd = wgid % NXCD, off = wgid / NXCD; wgid = (xcd < r ? xcd * (q + 1) : r * (q + 1) + (xcd - r) * q) + off; }
    const int nig = WGM * nN, gid = wgid / nig, fm = gid * WGM, gsz = (nM - fm) < WGM ? (nM - fm) : WGM;
    u.pm = fm + ((wgid % nig) % gsz); u.pn = (wgid % nig) / gsz; u.half = 0; u.roff = 0; u.sub = 0;
}
__device__ __forceinline__ bool order_next(int i, int G, int c, int nM, int nN, Unit& u) {
    const int nwg = nM * nN; const long L = (long)i * G + c; if (L >= nwg) return false;
    order_map((int)L, nM, nN, u); return true;
}
__device__ __forceinline__ unsigned cvt_pk_bf16(float lo, float hi) { unsigned r; asm volatile("v_cvt_pk_bf16_f32 %0, %1, %2" : "=v"(r) : "v"(lo), "v"(hi)); return r; }

typedef int v4i_t __attribute__((ext_vector_type(4)));
typedef int v8i_t __attribute__((ext_vector_type(8)));
template <class Epi, class Sched, bool FP8 = false, bool GATHER = false>
__device__ __forceinline__ void gemm_phase(LAS unsigned char* lds, const Gemm g, const Sched& S, const Epi& E) {
    const int tid = threadIdx.x, wid = __builtin_amdgcn_readfirstlane(tid >> 6), lane = tid & 63, wr = wid >> 2, wc = wid & 3, fr = lane & 15, fq = lane >> 4;
    const int nt0 = g.Kb / 128;
    unsigned vA0[2], vA1[2], nA0[2], nA1[2], voffB[2]; int RA[2], CA[2];
#pragma unroll
    for (int i = 0; i < 2; ++i) { int R, C; stage_rc(tid * 16 + i * 8192, R, C); const int Rb = Epi::PERM ? ((R & ~31) + perm32(R & 31)) : R;
        RA[i] = R; CA[i] = C * 2; voffB[i] = (unsigned)(Rb * g.ldb + C * 2);
        if constexpr (GATHER) { vA0[i] = (unsigned)(S.tok(0, R) * g.lda + C * 2); vA1[i] = (unsigned)(S.tok(0, HALF + R) * g.lda + C * 2); }
        else { vA0[i] = (unsigned)(R * g.lda + C * 2); vA1[i] = (unsigned)((HALF + R) * g.lda + C * 2); }
        nA0[i] = vA0[i]; nA1[i] = vA1[i]; }
    const size_t kstep = (size_t)(BK * 2);
    const size_t hstepB = (size_t)HALF * g.ldb;
    const unsigned ldsw = (unsigned)wid * 1024u;
    const int aoff = lds_byte(wr * 64 + fr, fq * 8), boff = lds_byte(wc * 32 + fr, fq * 8);
#define PG8_SA(b, h) (((b) * 2 + (h)) * HTB)
#define PG8_SB(b, h) ((4 + (b) * 2 + (h)) * HTB)
#define PG8_STAGE(bufoff, gbase, voff) do { _Pragma("unroll") for (int _i = 0; _i < 2; ++_i) \
        __builtin_amdgcn_global_load_lds((const unsigned*)((const char*)(gbase) + (voff)[_i]), (LAS unsigned*)(lds + (bufoff) + ldsw + _i * 8192), 16, 0, 0); } while (0)
#define PG8_LD8(p) __builtin_shufflevector(*(const LAS v4i_t*)(p), *(const LAS v4i_t*)((p) + 1024), 0, 1, 2, 3, 4, 5, 6, 7)
#define PG8_LDA(dst, b, h) do { _Pragma("unroll") for (int m = 0; m < 4; ++m) { if constexpr (FP8) dst##8[m] = PG8_LD8(lds + PG8_SA(b, h) + aoff + m * 2048); else { _Pragma("unroll") for (int k = 0; k < 2; ++k) dst[m][k] = *(const LAS bf16x8*)(lds + PG8_SA(b, h) + aoff + m * 2048 + k * 1024); } } } while (0)
#define PG8_LDB(dst, b, h) do { _Pragma("unroll") for (int n = 0; n < 2; ++n) { if constexpr (FP8) dst##8[n] = PG8_LD8(lds + PG8_SB(b, h) + boff + n * 2048); else { _Pragma("unroll") for (int k = 0; k < 2; ++k) dst[n][k] = *(const LAS bf16x8*)(lds + PG8_SB(b, h) + boff + n * 2048 + k * 1024); } } } while (0)
#define PG8_MMA(ai, bj, At, Bt) do { __builtin_amdgcn_s_setprio(1); _Pragma("unroll") for (int m = 0; m < 4; ++m) _Pragma("unroll") for (int n = 0; n < 2; ++n) { \
        if constexpr (FP8) asm volatile("v_mfma_f32_16x16x128_f8f6f4 %0, %1, %2, %0" : "+v"(acc[ai][bj][m][n]) : "v"(Bt##8[n]), "v"(At##8[m])); \
        else { _Pragma("unroll") for (int k = 0; k < 2; ++k) acc[ai][bj][m][n] = __builtin_amdgcn_mfma_f32_16x16x32_bf16(Bt[n][k], At[m][k], acc[ai][bj][m][n], 0, 0, 0); } } \
        __builtin_amdgcn_s_setprio(0); } while (0)
#define PG8_WAIT_V(n) asm volatile("s_waitcnt vmcnt(" #n ")" ::: "memory")
#define PG8_WAIT_L(n) asm volatile("s_waitcnt lgkmcnt(" #n ")" ::: "memory")
#define PG8_BAR __builtin_amdgcn_s_barrier()
#define PG8_SCHED __builtin_amdgcn_sched_barrier(0)
    Unit cur, nxt; int ui = 0;
    if (!S.next(0, cur)) return;
    f32x4 acc[2][2][4][2];
#pragma unroll
    for (int a = 0; a < 2; ++a)
#pragma unroll
        for (int b = 0; b < 2; ++b)
#pragma unroll
            for (int m = 0; m < 4; ++m)
#pragma unroll
                for (int n = 0; n < 2; ++n) acc[a][b][m][n] = (f32x4){0.f, 0.f, 0.f, 0.f};
    const int one_scale = 0x7f7f7f7f;
    bf16x8 At[4][2], B0[2][2], B1[2][2]; v8i_t At8[4], B08[2], B18[2];
    if constexpr (Epi::PREF) { cur.sub = 0; if (wid == 0) E.prefetch(cur, lane); }
    const char* cA = S.a_ptr(cur); const char* cB = S.b_ptr(cur);
    PG8_STAGE(PG8_SB(0, 0), cB, voffB); PG8_STAGE(PG8_SB(0, 1), cB + hstepB, voffB); PG8_STAGE(PG8_SA(0, 0), cA, vA0); PG8_STAGE(PG8_SA(0, 1), cA, vA1);
    if (wr == 1) PG8_BAR;
    PG8_WAIT_V(2); PG8_BAR;
    PG8_STAGE(PG8_SB(1, 0), cB + kstep, voffB); PG8_STAGE(PG8_SA(1, 0), cA + kstep, vA0); PG8_STAGE(PG8_SB(1, 1), cB + hstepB + kstep, voffB);
    PG8_WAIT_V(6); PG8_BAR;
    for (;;) {
        const bool has_next = S.next(ui + 1, nxt); const bool hf = __builtin_amdgcn_readfirstlane(cur.half) != 0;
        const char* nA = has_next ? S.a_ptr(nxt) : cA; const char* nB = has_next ? S.b_ptr(nxt) : cB;
        int nt = nt0; if constexpr (Epi::FUSED) nt = S.nt(ui);
        if constexpr (GATHER) { if (has_next) {
#pragma unroll
            for (int i = 0; i < 2; ++i) { nA0[i] = (unsigned)(S.tok(ui + 1, RA[i]) * g.lda + CA[i]); nA1[i] = (unsigned)(S.tok(ui + 1, HALF + RA[i]) * g.lda + CA[i]); } } }
#pragma unroll 1
        for (int t = 0; t < nt; t += 2) {
            const bool last = (t == nt - 2);
            const char* a1 = cA + (size_t)(t + 1) * kstep;
            const char* a2 = last ? nA : cA + (size_t)(t + 2) * kstep; const char* b2 = last ? nB : cB + (size_t)(t + 2) * kstep;
            const char* a3 = a2 + kstep; const char* b3 = b2 + kstep;
            unsigned sA0[2], sA1[2];
#pragma unroll
            for (int i = 0; i < 2; ++i) { sA0[i] = (GATHER && last) ? nA0[i] : vA0[i]; sA1[i] = (GATHER && last) ? nA1[i] : vA1[i]; }
            PG8_LDB(B0, 0, 0); PG8_LDB(B1, 0, 1); PG8_SCHED; PG8_LDA(At, 0, 0); PG8_STAGE(PG8_SA(1, 1), a1, vA1);
            PG8_WAIT_V(8); PG8_WAIT_L(0); PG8_BAR; PG8_MMA(0, 0, At, B0); PG8_MMA(0, 1, At, B1); PG8_BAR; PG8_SCHED;
            if (!hf) { PG8_LDA(At, 0, 1); } PG8_STAGE(PG8_SB(0, 0), b2, voffB); PG8_STAGE(PG8_SB(0, 1), b2 + hstepB, voffB); PG8_STAGE(PG8_SA(0, 0), a2, sA0);
            PG8_WAIT_V(8); PG8_WAIT_L(0); PG8_BAR; if (!hf) { PG8_MMA(1, 0, At, B0); PG8_MMA(1, 1, At, B1); } PG8_BAR; PG8_SCHED;
            PG8_LDB(B0, 1, 0); PG8_LDB(B1, 1, 1); PG8_SCHED; PG8_LDA(At, 1, 0); PG8_STAGE(PG8_SA(0, 1), a2, sA1);
            PG8_WAIT_V(8); PG8_WAIT_L(0); PG8_BAR; PG8_MMA(0, 0, At, B0); PG8_MMA(0, 1, At, B1); PG8_BAR; PG8_SCHED;
            if (!hf) { PG8_LDA(At, 1, 1); } PG8_STAGE(PG8_SB(1, 0), b3, voffB); PG8_STAGE(PG8_SB(1, 1), b3 + hstepB, voffB); PG8_STAGE(PG8_SA(1, 0), a3, sA0);
            PG8_WAIT_V(8); PG8_WAIT_L(0); PG8_BAR; if (!hf) { PG8_MMA(1, 0, At, B0); PG8_MMA(1, 1, At, B1); } PG8_BAR; PG8_SCHED;
        }
        if constexpr (Epi::PREF) { if (has_next) { nxt.sub = (ui + 1) & 1; if (wid == 0) E.prefetch(nxt, lane); } }
        if (wr == 0) PG8_BAR;
        if constexpr (FP8) asm volatile("s_nop 15\n\ts_nop 15" ::: "memory");
        bool keep = false;
        if constexpr (Epi::FUSED) { if ((ui & 1) == 0) { E.mid(acc, cur, wr, wc, fr, fq); keep = true; } else E(acc, cur, wr, wc, fr, fq); }
        else E(acc, cur, wr, wc, fr, fq);
        if (!has_next) break;
        if (!keep)
#pragma unroll
        for (int a = 0; a < 2; ++a)
#pragma unroll
            for (int b = 0; b < 2; ++b)
#pragma unroll
                for (int m = 0; m < 4; ++m)
#pragma unroll
                    for (int n = 0; n < 2; ++n) acc[a][b][m][n] = (f32x4){0.f, 0.f, 0.f, 0.f};
        cur = nxt; cA = nA; cB = nB; ++ui;
#pragma unroll
        for (int i = 0; i < 2; ++i) { vA0[i] = nA0[i]; vA1[i] = nA1[i]; }
        if (wr == 1) PG8_BAR;
    }
    PG8_WAIT_V(0);
    PG8_BAR;
#undef PG8_SA
#undef PG8_SB
#undef PG8_STAGE
#undef PG8_LDA
#undef PG8_LDB
#undef PG8_MMA
#undef PG8_LD8
#undef PG8_WAIT_V
#undef PG8_WAIT_L
#undef PG8_BAR
#undef PG8_SCHED
}
}
using pg8::Unit; using pg8::cvt_pk_bf16;

struct DenseOrder {
    int nM, nN, G, c; const char* A; const char* Bt; size_t astep, astepn, bstep;
    __device__ __forceinline__ bool next(int i, Unit& u) const { return pg8::order_next(i, G, c, nM, nN, u); }
    __device__ __forceinline__ const char* a_ptr(const Unit& u) const { return A + (size_t)u.pm * astep + (size_t)u.pn * astepn; }
    __device__ __forceinline__ const char* b_ptr(const Unit& u) const { return Bt + (size_t)u.pn * bstep; }
};
template <int PART> struct ProjOrder {
    int nM, G, c; const char* A; const char* Bt; size_t astep, bstep;
    __device__ __forceinline__ bool next(int i, Unit& u) const {
        if (PART == 0) { if (!pg8::order_next(i, G, c, nM, 9, u)) return false; }
        else {
            const int nwg = nM * 28, extra = (nM * 9) % G, full = nwg / G - 1; int L;
            if (i < full) L = i * G + c; else { if (c < extra) return false; L = full * G + (i - full) * (G - extra) + (c - extra); if (L >= nwg) return false; }
            pg8::order_map(L, nM, 28, u); }
        const int j = u.pn; u.pn = PART ? (j < 12 ? j : j + 4) : (j < 4 ? 12 + j : j < 8 ? 28 + j : 36); return true; }
    __device__ __forceinline__ const char* a_ptr(const Unit& u) const { return A + (size_t)u.pm * astep; }
    __device__ __forceinline__ const char* b_ptr(const Unit& u) const { return Bt + (size_t)(PART ? (u.pn < 12 ? u.pn : u.pn - 4) : u.pn) * bstep; }
};
struct MoeOrder {
    int nM, nN, G, c; const char* A; const char* Bt; size_t astep, bstep_e, bstep; const LAS int* tile_e; const LAS int* tokL; const LAS int* tile_rows; int split;
    __device__ __forceinline__ bool next(int i, Unit& u) const {
        const int nwg = nM * nN, nfull = split ? (nwg / G) * G : nwg, L = i * G + c;
        if (L < nfull) { pg8::order_map(L, nM, nN, u); u.half = tile_rows[u.pm] <= 128 ? 1 : 0; return true; }
        const int rem = nwg - nfull, idx = L - nfull;
        if (2 * rem <= G) { if (idx >= 2 * rem) return false; pg8::order_map(nfull + (idx >> 1), nM, nN, u); u.half = 1; u.roff = (idx & 1) * 128; return true; }
        if (L >= nwg) return false;
        pg8::order_map(L, nM, nN, u); u.half = tile_rows[u.pm] <= 128 ? 1 : 0; return true; }
    __device__ __forceinline__ const char* a_ptr(const Unit& u) const { return A + (size_t)u.pm * astep + (size_t)u.roff * (astep >> 8); }
    __device__ __forceinline__ const char* b_ptr(const Unit& u) const { return Bt + (size_t)tile_e[u.pm] * bstep_e + (size_t)u.pn * bstep; }
    __device__ __forceinline__ int tok(int ui, int r) const { return tokL[ui * 256 + r]; }
};

struct EpiProj {
    static constexpr bool PERM = true; static constexpr bool FUSED = false; static constexpr bool PREF = false;
    bf16 *Q, *K, *V, *U, *GL, *QI, *KW; const float* ropa; const float* ropi; float oscale;
    __device__ __forceinline__ void operator()(const f32x4 (&acc)[2][2][4][2], const Unit& u, int wr, int wc, int fr, int fq) const {
        const int pn = u.pn; bf16* base; int ldc, c0, mode = 0;
        if (pn < 8) { base = Q; ldc = 2048; c0 = pn * 256; mode = 1; }
        else if (pn < 10) { base = K; ldc = 512; c0 = (pn - 8) * 256; mode = 1; }
        else if (pn < 12) { base = V; ldc = 512; c0 = (pn - 10) * 256; }
        else if (pn < 16) { base = U; ldc = 1024; c0 = (pn - 12) * 256; }
        else if (pn < 32) { base = GL; ldc = 4096; c0 = (pn - 16) * 256; }
        else if (pn < 36) { base = QI; ldc = 1024; c0 = (pn - 32) * 256; mode = 2; }
        else { base = KW; ldc = 256; c0 = 0; mode = 3; }
        const int row0 = u.pm * 256 + wr * 64 + fr, col0 = c0 + wc * 32 + 8 * fq;
        const bool ropeA = (mode == 1) && (wc == 0);
        const bool ropeI = ((mode == 2) && ((wc & 1) == 0)) || ((mode == 3) && (wc == 0));
        const bool wsc = (mode == 3) && (wc == 2) && (fq < 2);
        const bool anyrope = ropeA || ropeI; const float* tab = ropeA ? ropa + 8 * (fq & 1) : ropi; const int tstride = ropeA ? 32 : 16, soff = ropeA ? 16 : 8;
        f32x4 tc[4];
        if (anyrope) { const float* cs = tab + (row0 & (SEQ - 1)) * tstride; tc[0] = *(const f32x4*)cs; tc[1] = *(const f32x4*)(cs + 4); tc[2] = *(const f32x4*)(cs + soff); tc[3] = *(const f32x4*)(cs + soff + 4); }
#pragma unroll
        for (int it = 0; it < 8; ++it) { const int ai = it >> 2, m = it & 3; const int row = row0 + ai * 128 + m * 16; bf16* rowp = base + (size_t)row * ldc + col0;
            v4u w[2];
#pragma unroll
            for (int bj = 0; bj < 2; ++bj) { f32x4 v0 = acc[ai][bj][m][0] * oscale, v1 = acc[ai][bj][m][1] * oscale;
                if (ropeA) {
                    const float sg = (fq < 2) ? -1.f : 1.f;
                    const f32x4 c0v = tc[0], c1v = tc[1], s0v = tc[2] * sg, s1v = tc[3] * sg;
                    f32x4 p0, p1;
#pragma unroll
                    for (int j = 0; j < 4; ++j) { p0[j] = __shfl_xor(v0[j], 32); p1[j] = __shfl_xor(v1[j], 32); }
                    v0 = v0 * c0v + p0 * s0v; v1 = v1 * c1v + p1 * s1v;
                } else if (ropeI && (mode == 2 || bj == 0)) {
                    const float sg = (fq == 0) ? -1.f : 1.f;
                    const f32x4 c0v = tc[0], c1v = tc[1], s0v = tc[2] * sg, s1v = tc[3] * sg;
                    f32x4 p0, p1;
#pragma unroll
                    for (int j = 0; j < 4; ++j) { p0[j] = __shfl_xor(v0[j], 16); p1[j] = __shfl_xor(v1[j], 16); }
                    if (fq < 2) { v0 = v0 * c0v + p0 * s0v; v1 = v1 * c1v + p1 * s1v; }
                } else if (wsc && bj == 0) { v0 = v0 * 0.03125f; v1 = v1 * 0.03125f; }
                w[bj].x = cvt_pk_bf16(v0[0], v0[1]); w[bj].y = cvt_pk_bf16(v0[2], v0[3]); w[bj].z = cvt_pk_bf16(v1[0], v1[1]); w[bj].w = cvt_pk_bf16(v1[2], v1[3]); }
            asm volatile("" ::: "memory");
            if (anyrope && it < 7) { const int rown = row0 + ((it + 1) >> 2) * 128 + ((it + 1) & 3) * 16; const float* cs = tab + (rown & (SEQ - 1)) * tstride;
                tc[0] = *(const f32x4*)cs; tc[1] = *(const f32x4*)(cs + 4); tc[2] = *(const f32x4*)(cs + soff); tc[3] = *(const f32x4*)(cs + soff + 4); }
            asm volatile("" ::: "memory");
            *(v4u*)rowp = w[0]; *(v4u*)(rowp + 128) = w[1];
            asm volatile("" ::: "memory"); }
    }
};
struct EpiPool {
    static constexpr bool PERM = true; static constexpr bool FUSED = false; static constexpr bool PREF = false;
    bf16* O; const float* scale;
    __device__ __forceinline__ void operator()(const f32x4 (&acc)[2][2][4][2], const Unit& u, int wr, int wc, int fr, int fq) const {
        const int row0 = u.pm * 256 + wr * 64 + fr, col0 = u.pn * 256 + wc * 32 + 8 * fq;
#pragma unroll
        for (int bj = 0; bj < 2; ++bj) {
            const f32x4 s0 = *(const f32x4*)(scale + col0 + bj * 128), s1 = *(const f32x4*)(scale + col0 + bj * 128 + 4);
#pragma unroll
            for (int ai = 0; ai < 2; ++ai)
#pragma unroll
                for (int m = 0; m < 4; ++m) { const size_t off = (size_t)(row0 + ai * 128 + m * 16) * 1024 + col0 + bj * 128;
                    const f32x4 v0 = acc[ai][bj][m][0] * s0, v1 = acc[ai][bj][m][1] * s1;
#if UPP_FP8
                    v2u w; w.x = pk4_fp8(v0[0], v0[1], v0[2], v0[3]); w.y = pk4_fp8(v1[0], v1[1], v1[2], v1[3]);
                    *(v2u*)((unsigned char*)O + off) = w;
#else
                    v4u w; w.x = cvt_pk_bf16(v0[0], v0[1]); w.y = cvt_pk_bf16(v0[2], v0[3]); w.z = cvt_pk_bf16(v1[0], v1[1]); w.w = cvt_pk_bf16(v1[2], v1[3]);
                    *(v4u*)(O + off) = w;
#endif
                }
            asm volatile("" ::: "memory"); }
    }
};
template <int MODE> struct EpiUp {
    static constexpr bool PERM = true; static constexpr bool FUSED = false; static constexpr bool PREF = false;
    float* TMP; bf16* MERGED; const bf16* GL;
    __device__ __forceinline__ void operator()(const f32x4 (&acc)[2][2][4][2], const Unit& u, int wr, int wc, int fr, int fq) const {
        const int row0 = u.pm * 256 + wr * 64 + fr, col0 = u.pn * 256 + wc * 32 + 8 * fq;
        constexpr float IS = MODE ? (UPA_FP8 ? 1.0f / (W8_SCALE * YA8_SCALE) : 1.0f) : (UPP_FP8 ? 1.0f / W8_SCALE : 1.0f), RIS = 1.0f / IS;
        v4u gwn[2], twn[2];
#pragma unroll
        for (int bj = 0; bj < 2; ++bj) { const size_t row = (size_t)row0; const int col = col0 + bj * 128;
            gwn[bj] = *(const v4u*)(GL + row * 4096 + (MODE ? 2048 : 0) + col); if (MODE) twn[bj] = *(const v4u*)((const bf16*)TMP + row * 2048 + col); }
#pragma unroll
        for (int it = 0; it < 8; ++it) { const int ai = it >> 2, m = it & 3; const size_t row = (size_t)(row0 + ai * 128 + m * 16);
            v4u gwc[2] = {gwn[0], gwn[1]}, twc[2]; if (MODE) { twc[0] = twn[0]; twc[1] = twn[1]; }
            if (it < 7) { const size_t rown = (size_t)(row0 + ((it + 1) >> 2) * 128 + ((it + 1) & 3) * 16);
#pragma unroll
                for (int bj = 0; bj < 2; ++bj) { const int col = col0 + bj * 128;
                    gwn[bj] = *(const v4u*)(GL + rown * 4096 + (MODE ? 2048 : 0) + col); if (MODE) twn[bj] = *(const v4u*)((const bf16*)TMP + rown * 2048 + col); } }
            asm volatile("" ::: "memory");
#pragma unroll
            for (int bj = 0; bj < 2; ++bj) { const int col = col0 + bj * 128;
                const unsigned gwv[4] = {gwc[bj].x, gwc[bj].y, gwc[bj].z, gwc[bj].w}; f32x2 gs[4];
#pragma unroll
                for (int q = 0; q < 4; ++q) { const f32x2 ea = (f32x2){lo16(gwv[q]), hi16(gwv[q])} * (f32x2){-1.4426950408889634f, -1.4426950408889634f};
                    const f32x2 den = (f32x2){__builtin_amdgcn_exp2f(ea.x), __builtin_amdgcn_exp2f(ea.y)} * (f32x2){RIS, RIS} + (f32x2){RIS, RIS};
                    gs[q] = (f32x2){__builtin_amdgcn_rcpf(den.x), __builtin_amdgcn_rcpf(den.y)}; }
                const f32x4 a0 = acc[ai][bj][m][0], a1 = acc[ai][bj][m][1];
                f32x2 p[4] = {(f32x2){a0[0], a0[1]} * gs[0], (f32x2){a0[2], a0[3]} * gs[1], (f32x2){a1[0], a1[1]} * gs[2], (f32x2){a1[2], a1[3]} * gs[3]};
                if (MODE == 0) { v4u w; w.x = cvt_pk_bf16(p[0].x, p[0].y); w.y = cvt_pk_bf16(p[1].x, p[1].y); w.z = cvt_pk_bf16(p[2].x, p[2].y); w.w = cvt_pk_bf16(p[3].x, p[3].y); *(v4u*)((bf16*)TMP + row * 2048 + col) = w; }
                else { const v4u tw = twc[bj]; p[0] += (f32x2){lo16(tw.x), hi16(tw.x)}; p[1] += (f32x2){lo16(tw.y), hi16(tw.y)}; p[2] += (f32x2){lo16(tw.z), hi16(tw.z)}; p[3] += (f32x2){lo16(tw.w), hi16(tw.w)};
#if OUT_FP8
                    v2u w; w.x = pk4_fp8(p[0].x, p[0].y, p[1].x, p[1].y); w.y = pk4_fp8(p[2].x, p[2].y, p[3].x, p[3].y);
                    *(v2u*)((unsigned char*)MERGED + row * 2048 + col) = w; }
#else
                    v4u w; w.x = cvt_pk_bf16(p[0].x, p[0].y); w.y = cvt_pk_bf16(p[1].x, p[1].y); w.z = cvt_pk_bf16(p[2].x, p[2].y); w.w = cvt_pk_bf16(p[3].x, p[3].y);
                    *(v4u*)(MERGED + row * 2048 + col) = w; }
#endif
            }
            asm volatile("" ::: "memory"); }
    }
};
struct UpOrder {
    int nM, nN, G, c; const char* A0; const char* A1; const char* B0; const char* B1;
    __device__ __forceinline__ bool next(int i, Unit& u) const { if (!pg8::order_next(i >> 1, G, c, nM, nN, u)) return false; u.sub = i & 1; return true; }
    __device__ __forceinline__ const char* a_ptr(const Unit& u) const { return u.sub ? A1 + (size_t)u.pm * (256 * 2048) : A0 + (size_t)u.pm * (256 * 1024); }
    __device__ __forceinline__ const char* b_ptr(const Unit& u) const { return (u.sub ? B1 : B0) + (size_t)u.pn * (256 * 2048); }
    __device__ __forceinline__ int tok(int ui, int r) const { return (ui & 1) ? 2 * r : r; }
    __device__ __forceinline__ int nt(int ui) const { return (ui & 1) ? 16 : 8; }
};
struct EpiUpF {
    static constexpr bool PERM = true; static constexpr bool FUSED = true; static constexpr bool PREF = false;
    bf16* MERGED; const bf16* GL;
    __device__ __forceinline__ void mid(f32x4 (&acc)[2][2][4][2], const Unit& u, int wr, int wc, int fr, int fq) const {
        const int row0 = u.pm * 256 + wr * 64 + fr, col0 = u.pn * 256 + wc * 32 + 8 * fq;
        constexpr float RS = (1.0f / W8_SCALE) / (1.0f / (W8_SCALE * YA8_SCALE));
        v4u an[2], bn[2];
#pragma unroll
        for (int bj = 0; bj < 2; ++bj) { const bf16* gp = GL + (size_t)row0 * 4096 + col0 + bj * 128; an[bj] = *(const v4u*)gp; bn[bj] = *(const v4u*)(gp + 2048); }
#pragma unroll
        for (int it = 0; it < 8; ++it) { const int ai = it >> 2, m = it & 3;
            v4u ac[2] = {an[0], an[1]}, bc[2] = {bn[0], bn[1]};
            if (it < 7) { const size_t rown = (size_t)(row0 + ((it + 1) >> 2) * 128 + ((it + 1) & 3) * 16);
#pragma unroll
                for (int bj = 0; bj < 2; ++bj) { const bf16* gp = GL + rown * 4096 + col0 + bj * 128; an[bj] = *(const v4u*)gp; bn[bj] = *(const v4u*)(gp + 2048); } }
            asm volatile("" ::: "memory");
#pragma unroll
            for (int bj = 0; bj < 2; ++bj) { const unsigned av[4] = {ac[bj].x, ac[bj].y, ac[bj].z, ac[bj].w}, bv[4] = {bc[bj].x, bc[bj].y, bc[bj].z, bc[bj].w};
#pragma unroll
                for (int q = 0; q < 4; ++q) { const f32x2 ea = (f32x2){lo16(av[q]), hi16(av[q])} * (f32x2){-1.4426950408889634f, -1.4426950408889634f}, eb = (f32x2){lo16(bv[q]), hi16(bv[q])} * (f32x2){-1.4426950408889634f, -1.4426950408889634f};
                    const f32x2 da = (f32x2){__builtin_amdgcn_exp2f(ea.x), __builtin_amdgcn_exp2f(ea.y)} + (f32x2){1.0f, 1.0f};
                    const f32x2 db = (f32x2){__builtin_amdgcn_exp2f(eb.x), __builtin_amdgcn_exp2f(eb.y)} * (f32x2){RS, RS} + (f32x2){RS, RS};
                    const f32x2 r = db * (f32x2){__builtin_amdgcn_rcpf(da.x), __builtin_amdgcn_rcpf(da.y)};
                    f32x4& t = acc[ai][bj][m][q >> 1];
                    if (q & 1) { t[2] *= r.x; t[3] *= r.y; } else { t[0] *= r.x; t[1] *= r.y; } } }
            asm volatile("" ::: "memory"); }
    }
    __device__ __forceinline__ void operator()(const f32x4 (&acc)[2][2][4][2], const Unit& u, int wr, int wc, int fr, int fq) const {
        const int row0 = u.pm * 256 + wr * 64 + fr, col0 = u.pn * 256 + wc * 32 + 8 * fq;
        constexpr float RIS = W8_SCALE * YA8_SCALE;
        v4u bn[2];
#pragma unroll
        for (int bj = 0; bj < 2; ++bj) bn[bj] = *(const v4u*)(GL + (size_t)row0 * 4096 + 2048 + col0 + bj * 128);
#pragma unroll
        for (int it = 0; it < 8; ++it) { const int ai = it >> 2, m = it & 3; const size_t row = (size_t)(row0 + ai * 128 + m * 16);
            v4u bc[2] = {bn[0], bn[1]};
            if (it < 7) { const size_t rown = (size_t)(row0 + ((it + 1) >> 2) * 128 + ((it + 1) & 3) * 16);
#pragma unroll
                for (int bj = 0; bj < 2; ++bj) bn[bj] = *(const v4u*)(GL + rown * 4096 + 2048 + col0 + bj * 128); }
            asm volatile("" ::: "memory");
#pragma unroll
            for (int bj = 0; bj < 2; ++bj) { const int col = col0 + bj * 128; const unsigned bv[4] = {bc[bj].x, bc[bj].y, bc[bj].z, bc[bj].w}; f32x2 gs[4];
#pragma unroll
                for (int q = 0; q < 4; ++q) { const f32x2 eb = (f32x2){lo16(bv[q]), hi16(bv[q])} * (f32x2){-1.4426950408889634f, -1.4426950408889634f};
                    const f32x2 den = (f32x2){__builtin_amdgcn_exp2f(eb.x), __builtin_amdgcn_exp2f(eb.y)} * (f32x2){RIS, RIS} + (f32x2){RIS, RIS};
                    gs[q] = (f32x2){__builtin_amdgcn_rcpf(den.x), __builtin_amdgcn_rcpf(den.y)}; }
                const f32x4 a0 = acc[ai][bj][m][0], a1 = acc[ai][bj][m][1];
                const f32x2 p[4] = {(f32x2){a0[0], a0[1]} * gs[0], (f32x2){a0[2], a0[3]} * gs[1], (f32x2){a1[0], a1[1]} * gs[2], (f32x2){a1[2], a1[3]} * gs[3]};
                v2u w; w.x = pk4_fp8(p[0].x, p[0].y, p[1].x, p[1].y); w.y = pk4_fp8(p[2].x, p[2].y, p[3].x, p[3].y);
                *(v2u*)((unsigned char*)MERGED + row * 2048 + col) = w; }
            asm volatile("" ::: "memory"); }
    }
};
struct EpiY16 {
    static constexpr bool PERM = true; static constexpr bool FUSED = false; static constexpr bool PREF = false;
    bf16* C;
    __device__ __forceinline__ void operator()(const f32x4 (&acc)[2][2][4][2], const Unit& u, int wr, int wc, int fr, int fq) const {
        const int row0 = u.pm * 256 + wr * 64 + fr, col0 = u.pn * 256 + wc * 32 + 8 * fq;
#pragma unroll
        for (int ai = 0; ai < 2; ++ai)
#pragma unroll
            for (int m = 0; m < 4; ++m) { bf16* rowp = C + (size_t)(row0 + ai * 128 + m * 16) * 2048 + col0;
#pragma unroll
                for (int bj = 0; bj < 2; ++bj) { constexpr float IS = OUT_FP8 ? 1.0f / W8_SCALE : 1.0f; const f32x4 v0 = acc[ai][bj][m][0] * IS, v1 = acc[ai][bj][m][1] * IS;
                    v4u w; w.x = cvt_pk_bf16(v0[0], v0[1]); w.y = cvt_pk_bf16(v0[2], v0[3]); w.z = cvt_pk_bf16(v1[0], v1[1]); w.w = cvt_pk_bf16(v1[2], v1[3]);
                    *(v4u*)(rowp + bj * 128) = w; } }
    }
};
struct EpiAct {
    static constexpr bool PERM = true; static constexpr bool FUSED = false; static constexpr bool PREF = true;
    unsigned char* ACT8; const float* b1; const LAS int* tile_e; LAS float* bslot;
    __device__ __forceinline__ void prefetch(const Unit& u, int lane) const {
        const int e = tile_e[u.pm]; const float* src = b1 + (size_t)e * 4096 + u.pn * 128 + (lane < 32 ? 4 * lane : 2048 + 4 * (lane - 32));
        __builtin_amdgcn_global_load_lds((const unsigned*)(const GAS float*)src, (LAS unsigned*)(bslot + __builtin_amdgcn_readfirstlane(u.sub) * 256), 16, 0, 0); }
    __device__ __forceinline__ void operator()(const f32x4 (&acc)[2][2][4][2], const Unit& u, int wr, int wc, int fr, int fq) const {
        const int row0 = u.pm * 256 + u.roff + wr * 64 + fr, col0 = u.pn * 128 + wc * 32 + 8 * fq;
        const LAS float* bs = bslot + u.sub * 256 + wc * 32 + 8 * fq;
        const f32x4 bg0 = *(const LAS f32x4*)bs, bg1 = *(const LAS f32x4*)(bs + 4), bl0 = *(const LAS f32x4*)(bs + 128), bl1 = *(const LAS f32x4*)(bs + 132);
        constexpr float IS = 1.0f / W8_SCALE;
#pragma unroll
        for (int ai = 0; ai < 2; ++ai) { if (ai == 1 && u.half) break;
#pragma unroll
            for (int m = 0; m < 4; ++m) { unsigned char* rowp = ACT8 + (size_t)(row0 + ai * 128 + m * 16) * 2048 + col0;
                f32x2 o[2][2];
#pragma unroll
                for (int n = 0; n < 2; ++n)
#pragma unroll
                    for (int h = 0; h < 2; ++h) { const f32x4 ga = acc[ai][0][m][n], la = acc[ai][1][m][n], bgn = n ? bg1 : bg0, bln = n ? bl1 : bl0;
                        const f32x2 gv = (f32x2){ga[2 * h], ga[2 * h + 1]} * (f32x2){IS, IS} + (f32x2){bgn[2 * h], bgn[2 * h + 1]};
                        const f32x2 lv = (f32x2){la[2 * h], la[2 * h + 1]} * (f32x2){IS, IS} + (f32x2){bln[2 * h], bln[2 * h + 1]};
                        const f32x2 gg = {__builtin_amdgcn_fmed3f(gv.x, -3.0e38f, 7.0f), __builtin_amdgcn_fmed3f(gv.y, -3.0e38f, 7.0f)};
                        const f32x2 ll = {__builtin_amdgcn_fmed3f(lv.x, -7.0f, 7.0f), __builtin_amdgcn_fmed3f(lv.y, -7.0f, 7.0f)};
                        const f32x2 ea = gg * (f32x2){-1.702f * 1.4426950408889634f, -1.702f * 1.4426950408889634f};
                        const f32x2 den = (f32x2){__builtin_amdgcn_exp2f(ea.x), __builtin_amdgcn_exp2f(ea.y)} + (f32x2){1.0f, 1.0f};
                        const f32x2 sg = {__builtin_amdgcn_rcpf(den.x), __builtin_amdgcn_rcpf(den.y)};
                        o[n][h] = (gg * sg) * (ll * (f32x2){ACT8_SCALE, ACT8_SCALE} + (f32x2){ACT8_SCALE, ACT8_SCALE}); }
                v2u w; w.x = pk4_fp8(o[0][0].x, o[0][0].y, o[0][1].x, o[0][1].y); w.y = pk4_fp8(o[1][0].x, o[1][0].y, o[1][1].x, o[1][1].y);
                *(v2u*)rowp = w; } }
    }
};
struct EpiYs {
    static constexpr bool PERM = true; static constexpr bool FUSED = false; static constexpr bool PREF = true;
    unsigned char* YS8; const float* b2; const LAS int* tile_e; LAS float* bslot;
    __device__ __forceinline__ void prefetch(const Unit& u, int lane) const {
        const int e = tile_e[u.pm]; const float* src = b2 + (size_t)e * 2048 + u.pn * 256 + 4 * lane;
        __builtin_amdgcn_global_load_lds((const unsigned*)(const GAS float*)src, (LAS unsigned*)(bslot + __builtin_amdgcn_readfirstlane(u.sub) * 256), 16, 0, 0); }
    __device__ __forceinline__ void operator()(const f32x4 (&acc)[2][2][4][2], const Unit& u, int wr, int wc, int fr, int fq) const {
        const int row0 = u.pm * 256 + u.roff + wr * 64 + fr, col0 = u.pn * 256 + wc * 32 + 8 * fq;
        const LAS float* bs = bslot + u.sub * 256 + wc * 32 + 8 * fq;
        f32x4 bv[2][2];
#pragma unroll
        for (int bj = 0; bj < 2; ++bj)
#pragma unroll
            for (int n = 0; n < 2; ++n) bv[bj][n] = *(const LAS f32x4*)(bs + bj * 128 + 4 * n) * YS8_SCALE;
#pragma unroll
        for (int ai = 0; ai < 2; ++ai) { if (ai == 1 && u.half) break;
#pragma unroll
            for (int m = 0; m < 4; ++m) { unsigned char* rowp = YS8 + (size_t)(row0 + ai * 128 + m * 16) * 2048 + col0;
#pragma unroll
                for (int bj = 0; bj < 2; ++bj) { constexpr float IS = YS8_SCALE / (W8_SCALE * ACT8_SCALE); const f32x4 v0 = acc[ai][bj][m][0] * IS + bv[bj][0], v1 = acc[ai][bj][m][1] * IS + bv[bj][1];
                    v2u w; w.x = pk4_fp8(v0[0], v0[1], v0[2], v0[3]); w.y = pk4_fp8(v1[0], v1[1], v1[2], v1[3]);
                    *(v2u*)(rowp + bj * 128) = w; } } }
    }
};


typedef float f32x16 __attribute__((ext_vector_type(16)));
#define DPP_ADD(v, ctrl) v += __builtin_amdgcn_update_dpp(0, v, ctrl, 0xF, 0xF, true)
__device__ __forceinline__ void indexer_task(const bf16* QI, const bf16* KW, unsigned* MW, int b, int tp, int tmaxb, LAS unsigned char* lds, int wave, int lane_in) {
    int lane = lane_in; asm volatile("" : "+v"(lane));
    const int c = lane & 31, kg = lane >> 5;
    const int t0 = 2 * tp; const size_t rowbase = (size_t)b * SEQ;
    const int arow_q = (c >> 2) & 1, ahead = 4 * (c >> 3) + (c & 3);
    const bf16* qa = QI + (rowbase + t0 + arow_q) * 1024 + ahead * 64 + 8 * kg;
    bf16x8 af[4];
#pragma unroll
    for (int kk = 0; kk < 4; ++kk) af[kk] = *(const bf16x8*)(qa + 16 * kk);
    float wf[16];
    { const bf16* wp = KW + (rowbase + t0 + kg) * 256 + 64; const v4u w0 = *(const v4u*)wp, w1 = *(const v4u*)(wp + 8);
      wf[0] = lo16(w0.x); wf[1] = hi16(w0.x); wf[2] = lo16(w0.y); wf[3] = hi16(w0.y); wf[4] = lo16(w0.z); wf[5] = hi16(w0.z); wf[6] = lo16(w0.w); wf[7] = hi16(w0.w);
      wf[8] = lo16(w1.x); wf[9] = hi16(w1.x); wf[10] = lo16(w1.y); wf[11] = hi16(w1.y); wf[12] = lo16(w1.z); wf[13] = hi16(w1.z); wf[14] = lo16(w1.w); wf[15] = hi16(w1.w); }
    asm volatile("s_waitcnt vmcnt(0)" ::: "memory");
    const int tq = t0 + kg, maxblk = (t0 + 1) >> 5;
    const bf16* dsrc = KW + (rowbase + 64 * wave + (lane >> 3)) * 256 + (((lane & 7) ^ ((lane >> 3) & 7)) * 8);
#define IDX_DMA(ch) do { _Pragma("unroll") for (int i_ = 0; i_ < 8; ++i_) \
        __builtin_amdgcn_global_load_lds((const unsigned*)(dsrc + ((size_t)(512 * (ch)) + 8 * i_) * 256), (LAS unsigned*)(lds + ((ch) & 1) * 65536 + (64 * wave + 8 * i_) * 128), 16, 0, 0); } while (0)
    const int krd = c * 128;
    unsigned key[64];
    IDX_DMA(0);
#pragma unroll
    for (int ch = 0; ch < 4; ++ch) {
        if (512 * ch <= tmaxb) {
            if (512 * (ch + 1) <= tmaxb) { IDX_DMA(ch + 1); asm volatile("s_waitcnt vmcnt(8)" ::: "memory"); }
            else asm volatile("s_waitcnt vmcnt(0)" ::: "memory");
            __builtin_amdgcn_s_barrier(); asm volatile("" ::: "memory");
            const LAS unsigned char* kb_ = lds + (ch & 1) * 65536 + krd;
#pragma unroll
            for (int bi = 0; bi < 16; ++bi) { const int blk = ch * 16 + bi;
                key[blk] = 0u;
                if (blk <= maxblk) {
                    f32x16 acc = {};
#pragma unroll
                    for (int kk = 0; kk < 4; ++kk) { const bf16x8 bf = *(const LAS bf16x8*)(kb_ + bi * 4096 + (((2 * kk + kg) ^ (c & 7)) * 16));
                        acc = __builtin_amdgcn_mfma_f32_32x32x16_bf16(af[kk], bf, acc, 0, 0, 0); }
                    float sc = 0.f;
#pragma unroll
                    for (int i = 0; i < 16; ++i) sc = __builtin_fmaf(wf[i], __builtin_amdgcn_fmed3f(acc[i], 0.f, 3.0e38f), sc);
                    const unsigned u = __float_as_uint(sc); const unsigned k2 = (u >> 31) ? ~u : (u | 0x80000000u);
                    key[blk] = (blk * 32 + c <= tq) ? k2 : 0u;
                }
            }
            asm volatile("s_waitcnt lgkmcnt(0)" ::: "memory"); __builtin_amdgcn_s_barrier(); asm volatile("" ::: "memory");
        } else {
#pragma unroll
            for (int bi = 0; bi < 16; ++bi) key[ch * 16 + bi] = 0u;
        }
    }
#undef IDX_DMA
    unsigned tau = 0u; bool act = (tq + 1) > NKEEP, exact = false;
    for (int bit = 31; bit >= 0; --bit) {
        if (!__any(act)) break;
        const unsigned cand = tau | (1u << bit);
        int cnt = 0;
#pragma unroll
        for (int g4 = 0; g4 < 4; ++g4) { if (16 * g4 <= maxblk) {
#pragma unroll
            for (int bi = 0; bi < 16; bi += 4) {
                unsigned long long m0, m1, m2, m3;
                asm volatile("v_cmp_ge_u32_e64 %1, %5, %9\n\tv_cmp_ge_u32_e64 %2, %6, %9\n\tv_cmp_ge_u32_e64 %3, %7, %9\n\tv_cmp_ge_u32_e64 %4, %8, %9\n\t"
                             "v_addc_co_u32_e64 %0, %1, %0, 0, %1\n\tv_addc_co_u32_e64 %0, %2, %0, 0, %2\n\tv_addc_co_u32_e64 %0, %3, %0, 0, %3\n\tv_addc_co_u32_e64 %0, %4, %0, 0, %4"
                             : "+v"(cnt), "=&s"(m0), "=&s"(m1), "=&s"(m2), "=&s"(m3)
                             : "v"(key[16 * g4 + bi]), "v"(key[16 * g4 + bi + 1]), "v"(key[16 * g4 + bi + 2]), "v"(key[16 * g4 + bi + 3]), "v"(cand)); } } }
        DPP_ADD(cnt, 0x128); DPP_ADD(cnt, 0x124); DPP_ADD(cnt, 0x122); DPP_ADD(cnt, 0x121);
        const int r0 = __builtin_amdgcn_readlane(cnt, 0), r1 = __builtin_amdgcn_readlane(cnt, 16), r2 = __builtin_amdgcn_readlane(cnt, 32), r3 = __builtin_amdgcn_readlane(cnt, 48);
        const int tot = kg ? (r2 + r3) : (r0 + r1);
        if (act && tot >= NKEEP) tau = cand;
        if (act && tot == NKEEP) { act = false; exact = true; }
    }
    int need = 0; const bool anyt = __any(act);
    if (anyt) {
        int cnt = 0; const unsigned cand = tau + 1u;
#pragma unroll
        for (int blk = 0; blk < 64; ++blk) cnt += (key[blk] >= cand) ? 1 : 0;
        DPP_ADD(cnt, 0x128); DPP_ADD(cnt, 0x124); DPP_ADD(cnt, 0x122); DPP_ADD(cnt, 0x121);
        const int r0 = __builtin_amdgcn_readlane(cnt, 0), r1 = __builtin_amdgcn_readlane(cnt, 16), r2 = __builtin_amdgcn_readlane(cnt, 32), r3 = __builtin_amdgcn_readlane(cnt, 48);
        const int tot = kg ? (r2 + r3) : (r0 + r1);
        need = act ? NKEEP - tot : 0;
    }
    const unsigned tauX = act ? tau : (exact ? tau - 1u : 0u);
    unsigned mA = 0u, mB = 0u; int tiesb = 0;
#pragma unroll
    for (int blk = 0; blk < 64; ++blk) {
        if (blk <= maxblk) {
            bool sel = key[blk] > tauX;
            if (anyt) {
                const bool eq = act && key[blk] == tauX;
                const unsigned long long em = __ballot(eq);
                const unsigned e32 = kg ? (unsigned)(em >> 32) : (unsigned)em;
                const int rank = tiesb + __popc(e32 & ((1u << c) - 1u));
                sel = sel || (eq && rank < need);
                tiesb += __popc(e32);
            }
            const unsigned long long sm = __ballot(sel);
            if (lane == blk) { mA = (unsigned)sm; mB = (unsigned)(sm >> 32); }
        }
    }
    MW[(rowbase + t0) * 64 + lane] = mA; MW[(rowbase + t0 + 1) * 64 + lane] = mB;
}

namespace att {
constexpr int NW = 8, QBLK = 32, KVBLK = 64;
constexpr float SCALE = 0.088388347648318440f, THR = 8.f;
constexpr int LDQ = 2048, LDK = 512, LDO = 2048;
constexpr int SHM_V = KVBLK * 128 * 2, SHM_K = KVBLK * 128 * 2, SHM_ATTN = 2 * SHM_V + 2 * SHM_K + NW * 64 * 4;
typedef short s16x4 __attribute__((ext_vector_type(4)));
#define KSWZ(row, colB) ((row) * 256 + ((colB) ^ (((row) & 7) << 4)))
#define SBAR() __builtin_amdgcn_sched_barrier(0)
__device__ __forceinline__ int crow(int r, int hi) { return (r & 3) + 8 * (r >> 2) + 4 * hi; }
__device__ __forceinline__ unsigned cvtpk(float lo, float hi) { unsigned r; asm volatile("v_cvt_pk_bf16_f32 %0, %1, %2" : "=v"(r) : "v"(lo), "v"(hi)); return r; }
__device__ __forceinline__ void partialSM(f32x16& p0, f32x16& p1, float& m_reg, float& mn, float& alpha) {
  constexpr float C = SCALE * 1.4426950408889634f;
  float pmax = p0[0]; for (int r = 1; r < 16; ++r) pmax = fmaxf(pmax, p0[r]); for (int r = 0; r < 16; ++r) pmax = fmaxf(pmax, p1[r]);
  { auto rr = __builtin_amdgcn_permlane32_swap(__float_as_uint(pmax), __float_as_uint(pmax), false, false);
    pmax = fmaxf(__uint_as_float(rr[0]), __uint_as_float(rr[1])); }
  if (__builtin_expect(__all(pmax - m_reg <= THR / SCALE), 1)) { mn = m_reg; alpha = 1.f; }
  else { mn = fmaxf(m_reg, pmax); alpha = __builtin_amdgcn_exp2f((m_reg - mn) * C); m_reg = mn; }
  float mnC = -mn * C;
  for (int r = 0; r < 16; ++r) p0[r] = fmaf(p0[r], C, mnC); for (int r = 0; r < 16; ++r) p1[r] = fmaf(p1[r], C, mnC);
  for (int r = 0; r < 16; ++r) p0[r] = __builtin_amdgcn_exp2f(p0[r]);
}
__device__ __forceinline__ void finishSM(f32x16& p0, f32x16& p1, float alpha, float& l_reg, bf16x8& pa0, bf16x8& pa1, bf16x8& pa2, bf16x8& pa3) {
  for (int r = 0; r < 16; ++r) p1[r] = __builtin_amdgcn_exp2f(p1[r]);
  float ps = 0; for (int r = 0; r < 16; ++r) ps += p0[r]; for (int r = 0; r < 16; ++r) ps += p1[r];
  { auto rr = __builtin_amdgcn_permlane32_swap(__float_as_uint(ps), __float_as_uint(ps), false, false);
    ps = __uint_as_float(rr[0]) + __uint_as_float(rr[1]); }
  l_reg = l_reg * alpha + ps;
#define PK4(P, BASE, OUT) do { unsigned a0 = cvtpk(P[BASE + 0], P[BASE + 1]), a1 = cvtpk(P[BASE + 2], P[BASE + 3]);   \
    unsigned b0 = cvtpk(P[BASE + 4], P[BASE + 5]), b1 = cvtpk(P[BASE + 6], P[BASE + 7]);                              \
    auto r0 = __builtin_amdgcn_permlane32_swap(a0, b0, false, false); auto r1 = __builtin_amdgcn_permlane32_swap(a1, b1, false, false); \
    v4u w = {r0[0], r1[0], r0[1], r1[1]}; OUT = *reinterpret_cast<bf16x8*>(&w); } while (0)
  PK4(p0, 0, pa0); PK4(p0, 8, pa1); PK4(p1, 0, pa2); PK4(p1, 8, pa3);
#undef PK4
}
__device__ __forceinline__ void qkt(f32x16& p0, f32x16& p1, const char* Ks, const bf16x8* qr, int r32, int hi) {
  p0 = f32x16{}; p1 = f32x16{};
  for (int d0 = 0; d0 < 8; ++d0) { int cb = (d0 * 16 + hi * 8) * 2;
    bf16x8 b0 = *reinterpret_cast<const bf16x8*>(Ks + KSWZ(r32, cb));
    bf16x8 b1 = *reinterpret_cast<const bf16x8*>(Ks + KSWZ(32 + r32, cb));
    p0 = __builtin_amdgcn_mfma_f32_32x32x16_bf16(b0, qr[d0], p0, 0, 0, 0);
    p1 = __builtin_amdgcn_mfma_f32_32x32x16_bf16(b1, qr[d0], p1, 0, 0, 0); }
}
__device__ __forceinline__ void mask_apply(f32x16& p0, f32x16& p1, unsigned m0, unsigned m1) {
#pragma unroll
  for (int r = 0; r < 16; ++r) { const int cb = (r & 3) + 8 * (r >> 2);
    const unsigned s0 = (unsigned)(((int)(m0 << (31 - cb))) >> 31), s1 = (unsigned)(((int)(m1 << (31 - cb))) >> 31);
    p0[r] = __uint_as_float((__float_as_uint(p0[r]) & s0) | (0xFF800000u & ~s0));
    p1[r] = __uint_as_float((__float_as_uint(p1[r]) & s1) | (0xFF800000u & ~s1)); }
}
__device__ __forceinline__ int v_st(int k, int c) { const int kk = (k & ~0xC) | ((k & 4) << 1) | ((k & 8) >> 1); return ((kk >> 3) * 4 + (c >> 5)) * 512 + ((kk & 7) * 32 + (c & 31)) * 2; }
__device__ __forceinline__ int v_rd_base(int lane) { return ((lane & 3) << 3) | (((lane >> 2) & 3) << 6) | (((lane >> 4) & 1) << 5) | (((lane >> 5) & 1) << 8); }
constexpr int v_rd_off(int d0, int ks, int half) { return d0 * 512 + ks * 4096 + half * 2048; }
template <int OFF> __device__ __forceinline__ s16x4 tr_read(int vb) {
  s16x4 r; asm volatile("ds_read_b64_tr_b16 %0, %1 offset:%2" : "=&v"(r) : "v"(vb), "i"(OFF) : "memory"); return r;
}
template <int D0> __device__ __forceinline__ void pv_one(f32x16& od, int vb, bf16x8 pa0, bf16x8 pa1, bf16x8 pa2, bf16x8 pa3) {
  const s16x4 l0 = tr_read<v_rd_off(D0, 0, 0)>(vb), h0 = tr_read<v_rd_off(D0, 0, 1)>(vb), l1 = tr_read<v_rd_off(D0, 1, 0)>(vb), h1 = tr_read<v_rd_off(D0, 1, 1)>(vb);
  const s16x4 l2 = tr_read<v_rd_off(D0, 2, 0)>(vb), h2 = tr_read<v_rd_off(D0, 2, 1)>(vb), l3 = tr_read<v_rd_off(D0, 3, 0)>(vb), h3 = tr_read<v_rd_off(D0, 3, 1)>(vb);
  asm volatile("s_waitcnt lgkmcnt(0)" ::: "memory"); SBAR();
#define PK(L, H) (bf16x8){L[0], L[1], L[2], L[3], H[0], H[1], H[2], H[3]}
  od = __builtin_amdgcn_mfma_f32_32x32x16_bf16(pa0, PK(l0, h0), od, 0, 0, 0);
  od = __builtin_amdgcn_mfma_f32_32x32x16_bf16(pa1, PK(l1, h1), od, 0, 0, 0);
  od = __builtin_amdgcn_mfma_f32_32x32x16_bf16(pa2, PK(l2, h2), od, 0, 0, 0);
  od = __builtin_amdgcn_mfma_f32_32x32x16_bf16(pa3, PK(l3, h3), od, 0, 0, 0);
#undef PK
}
__device__ __forceinline__ void pv_d0(f32x16* o, int vb, bf16x8 pa0, bf16x8 pa1, bf16x8 pa2, bf16x8 pa3) {
  pv_one<0>(o[0], vb, pa0, pa1, pa2, pa3); pv_one<1>(o[1], vb, pa0, pa1, pa2, pa3); pv_one<2>(o[2], vb, pa0, pa1, pa2, pa3); pv_one<3>(o[3], vb, pa0, pa1, pa2, pa3);
}
constexpr int ATT_K0 = 0, ATT_V0 = 2 * SHM_K, ATT_WS = ATT_V0 + 3 * SHM_V, ATT_M0 = ATT_WS + NW * 64 * 4, ATT_END = ATT_M0 + 65536;
__device__ __forceinline__ void attn_masked_body(const bf16* __restrict__ Qb, const bf16* __restrict__ Kh, const bf16* __restrict__ Vh, bf16* __restrict__ Ob,
                                                 const unsigned* __restrict__ Mq, int seq, LAS unsigned char* ldsl) {
  char* lds = (char*)ldsl;
  int tid = threadIdx.x; asm volatile("" : "+v"(tid));
  const int wid = __builtin_amdgcn_readfirstlane(tid >> 6), lane = tid & 63, r32 = lane & 31, hi = lane >> 5;
  char* K_lds = lds + ATT_K0; char* V_lds = lds + ATT_V0;
  float* ws = (float*)(lds + ATT_WS) + wid * 64; float* li_l = ws; float* al_l = ws + 32;
  float m_reg = -1e30f, l_reg = 0; f32x16 o[4] = {}; bf16x8 qr[8];
  const int NT = seq / KVBLK, sh4 = 4 * hi;
  unsigned offK[2], offV[2];
#pragma unroll
  for (int q = 0; q < 2; ++q) {
      const int krow = 8 * wid + 4 * q + (lane >> 4);
      offK[q] = (unsigned)((krow * LDK + 8 * ((lane & 15) ^ (krow & 7))) * 2);
      const int kk = 8 * wid + ((lane & 31) >> 2), vk = (kk & ~0xC) | ((kk & 4) << 1) | ((kk & 8) >> 1);
      offV[q] = (unsigned)((vk * LDK + 32 * (2 * q + (lane >> 5)) + 8 * (lane & 3)) * 2);
  }
#define DMA_TILE(t, kbuf, vbuf) do { const char* kt_ = (const char*)Kh + (size_t)(t) * (KVBLK * LDK * 2); const char* vt_ = (const char*)Vh + (size_t)(t) * (KVBLK * LDK * 2); \
    _Pragma("unroll") for (int q_ = 0; q_ < 2; ++q_) { \
      __builtin_amdgcn_global_load_lds((const unsigned*)(kt_ + offK[q_]), (LAS unsigned*)(ldsl + ATT_K0 + (kbuf) * SHM_K + (2 * wid + q_) * 1024), 16, 0, 0); \
      __builtin_amdgcn_global_load_lds((const unsigned*)(vt_ + offV[q_]), (LAS unsigned*)(ldsl + ATT_V0 + (vbuf) * SHM_V + (2 * wid + q_) * 1024), 16, 0, 0); } } while (0)
#define TILE_SYNC() do { asm volatile("s_waitcnt vmcnt(0)" ::: "memory"); __builtin_amdgcn_s_barrier(); asm volatile("" ::: "memory"); } while (0)
  DMA_TILE(0, 0, 0);
  const bf16* Qw = Qb + (long)(wid * QBLK + r32) * LDQ + hi * 8;
#pragma unroll
  for (int d0 = 0; d0 < 8; ++d0) qr[d0] = *reinterpret_cast<const bf16x8*>(Qw + d0 * 16);
  char* M_lds = lds + ATT_M0;
  { v2u mw[32];
#pragma unroll
    for (int rr = 0; rr < 32; ++rr) { const int r = wid * QBLK + rr; mw[rr] = (lane < NT) ? ((const v2u*)(Mq + (size_t)r * 64))[lane] : (v2u){0u, 0u}; }
#pragma unroll
    for (int rr = 0; rr < 32; ++rr) { const int r = wid * QBLK + rr; if (lane < NT) *(v2u*)(M_lds + r * 256 + ((lane ^ rr) << 3)) = mw[rr]; } }
  const char* mrow = M_lds + (wid * QBLK + r32) * 256;
#define MLOAD(j) (*(const v2u*)(mrow + ((((j)) ^ r32) << 3)))
  const int vbase = (int)(uintptr_t)V_lds + v_rd_base(lane);
#define RESC(a) do { if (__any((a) < 1.f)) { if (hi == 0) al_l[r32] = (a); asm volatile("s_waitcnt lgkmcnt(0)" ::: "memory"); \
    for (int d = 0; d < 4; ++d) for (int r = 0; r < 16; ++r) o[d][r] *= al_l[crow(r, hi)]; } } while (0)
  f32x16 pA0, pA1, pB0, pB1; float mnA, mnB, alA, alB; bf16x8 pa0, pa1, pa2, pa3;
  TILE_SYNC();
  DMA_TILE(1, 1, 1);
  qkt(pA0, pA1, K_lds, qr, r32, hi); { const v2u mk = MLOAD(0); mask_apply(pA0, pA1, mk.x >> sh4, mk.y >> sh4); } partialSM(pA0, pA1, m_reg, mnA, alA);
  TILE_SYNC();
  int vprev = 0;
  for (int j = 1; j + 1 < NT; j += 2) {
    const int vcur = vprev == 2 ? 0 : vprev + 1, vnxt = vcur == 2 ? 0 : vcur + 1;
    DMA_TILE(j + 1, 0, vnxt);
    SBAR(); qkt(pB0, pB1, K_lds + SHM_K, qr, r32, hi);
    finishSM(pA0, pA1, alA, l_reg, pa0, pa1, pa2, pa3); SBAR();
    pv_d0(o, vbase + vprev * (int)SHM_V, pa0, pa1, pa2, pa3); { const v2u mk = MLOAD(j); mask_apply(pB0, pB1, mk.x >> sh4, mk.y >> sh4); } partialSM(pB0, pB1, m_reg, mnB, alB);
    RESC(alB); TILE_SYNC();
    DMA_TILE(j + 2, 1, vprev);
    SBAR(); qkt(pA0, pA1, K_lds, qr, r32, hi);
    finishSM(pB0, pB1, alB, l_reg, pa0, pa1, pa2, pa3); SBAR();
    pv_d0(o, vbase + vcur * (int)SHM_V, pa0, pa1, pa2, pa3); { const v2u mk = MLOAD(j + 1); mask_apply(pA0, pA1, mk.x >> sh4, mk.y >> sh4); } partialSM(pA0, pA1, m_reg, mnA, alA);
    RESC(alA); TILE_SYNC();
    vprev = vnxt;
  }
  { const int vcur = vprev == 2 ? 0 : vprev + 1;
    SBAR(); qkt(pB0, pB1, K_lds + SHM_K, qr, r32, hi);
    finishSM(pA0, pA1, alA, l_reg, pa0, pa1, pa2, pa3); SBAR();
    pv_d0(o, vbase + vprev * (int)SHM_V, pa0, pa1, pa2, pa3); { const v2u mk = MLOAD(NT - 1); mask_apply(pB0, pB1, mk.x >> sh4, mk.y >> sh4); } partialSM(pB0, pB1, m_reg, mnB, alB);
    RESC(alB);
    finishSM(pB0, pB1, alB, l_reg, pa0, pa1, pa2, pa3); SBAR();
    pv_d0(o, vbase + vcur * (int)SHM_V, pa0, pa1, pa2, pa3); }
  if (hi == 0) li_l[r32] = l_reg; asm volatile("s_waitcnt lgkmcnt(0)" ::: "memory");
  float rli[16];
#pragma unroll
  for (int r = 0; r < 16; ++r) rli[r] = __builtin_amdgcn_rcpf(li_l[crow(r, hi)]);
  bf16* Ow = Ob + (long)(wid * QBLK) * LDO;
#pragma unroll
  for (int r = 0; r < 16; ++r) { const int orow = crow(r, hi);
#pragma unroll
    for (int d0 = 0; d0 < 4; ++d0) { const float v = o[d0][r] * rli[r];
#if UPA_FP8
      ((unsigned char*)Ob)[(long)(wid * QBLK + orow) * LDO + d0 * 32 + r32] = (unsigned char)(__builtin_amdgcn_cvt_pk_fp8_f32(v * YA8_SCALE, 0.f, 0, false) & 0xff);
#else
      const float vn = __shfl_xor(v, 1);
      if ((r32 & 1) == 0) *(unsigned*)(Ow + (long)orow * LDO + d0 * 32 + r32) = cvtpk(v, vn);
#endif
    } }
  (void)Ow;
#undef DMA_TILE
#undef TILE_SYNC
#undef RESC
#undef MLOAD
}
#undef KSWZ
#undef SBAR
}

struct Args { const float* in[20]; float* out; unsigned char* ws; float inv_a[16]; float inv_i[8]; int ph_lo, ph_hi; };
enum { I_X = 0, I_C, I_WADA, I_BADA, I_GPREMIX, I_GPOSTMIX, I_WIN, I_WPOOL, I_POOLSCALE, I_WUPP, I_WUPA, I_WOUT, I_GPREFFN, I_GPOSTFFN, I_WROUTER, I_BROUTER, I_W1, I_B1, I_W2, I_B2 };

__device__ __forceinline__ void tr_item(const float* W, int ldw, int nvalid, bf16* WT, int ldt, LAS float* scr, int lane) {
    const int kr = lane >> 3, n4 = (lane & 7) * 4;
    f32x4 v[8];
#pragma unroll
    for (int i = 0; i < 8; ++i) v[i] = (n4 < nvalid) ? *(const f32x4*)(W + (size_t)(8 * i + kr) * ldw + n4) : (f32x4){0.f, 0.f, 0.f, 0.f};
#pragma unroll
    for (int i = 0; i < 8; ++i) { LAS float* d = scr + (8 * i + kr) * 33 + n4; d[0] = v[i].x; d[1] = v[i].y; d[2] = v[i].z; d[3] = v[i].w; }
    LDS_WAIT(); asm volatile("" ::: "memory");
    const int c = lane & 7;
#pragma unroll
    for (int j = 0; j < 4; ++j) { const int n = (lane >> 3) + 8 * j; const LAS float* s = scr + (8 * c) * 33 + n;
        v4u o; o.x = pk2(s[0 * 33], s[1 * 33]); o.y = pk2(s[2 * 33], s[3 * 33]); o.z = pk2(s[4 * 33], s[5 * 33]); o.w = pk2(s[6 * 33], s[7 * 33]);
        *(v4u*)(WT + (size_t)n * ldt + 8 * c) = o; }
    LDS_WAIT(); asm volatile("" ::: "memory");
}
__device__ __forceinline__ void tr_item8(const float* W, int ldw, unsigned char* WT, int ldt, float scale, LAS float* scr, int lane) {
    { const int kr = lane >> 3, s = lane & 7;
#pragma unroll
      for (int i = 0; i < 16; ++i) { const int c = 2 * (i >> 2) + (kr & 1), ip = 4 * (i & 3) + (kr >> 1), k = 16 * c + ip, g = s ^ (2 * (i >> 2));
          __builtin_amdgcn_global_load_lds((const unsigned*)(W + (size_t)k * ldw + 4 * g), (LAS unsigned*)(scr + i * 256), 16, 0, 2); } }
    VM_WAIT(); asm volatile("" ::: "memory");
    const int c = lane & 7;
#pragma unroll
    for (int j = 0; j < 4; ++j) { const int n = (lane >> 3) + 8 * j; const LAS float* sp = scr + 1024 * (c >> 1) + 32 * (c & 1) + 4 * ((n >> 2) ^ (2 * (c >> 1))) + (n & 3);
        float f[16];
#pragma unroll
        for (int ip = 0; ip < 16; ++ip) f[ip] = sp[256 * (ip >> 2) + 64 * (ip & 3)] * scale;
        v4u o; o.x = pk4_fp8(f[0], f[1], f[2], f[3]); o.y = pk4_fp8(f[4], f[5], f[6], f[7]); o.z = pk4_fp8(f[8], f[9], f[10], f[11]); o.w = pk4_fp8(f[12], f[13], f[14], f[15]);
        __builtin_nontemporal_store(o, (v4u*)(WT + (size_t)n * ldt + 16 * c)); asm volatile("" ::: "memory"); }
    LDS_WAIT(); asm volatile("" ::: "memory");
}

__device__ __forceinline__ void sincos_d(float angf, float& c_out, float& s_out) {
    const double a = (double)angf;
    const double kq = __builtin_rint(a * 0.63661977236758134308);
    double r = __builtin_fma(-kq, 1.57079632679489655800, a);
    r = __builtin_fma(-kq, 6.12323399573676603587e-17, r);
    const int q = ((int)kq) & 3;
    const double r2 = r * r;
    double sp = 1.0 / 6227020800.0; sp = sp * r2 - 1.0 / 39916800.0; sp = sp * r2 + 1.0 / 362880.0; sp = sp * r2 - 1.0 / 5040.0; sp = sp * r2 + 1.0 / 120.0; sp = sp * r2 - 1.0 / 6.0; sp = sp * r2 + 1.0;
    const double sr = sp * r;
    double cp = -1.0 / 87178291200.0; cp = cp * r2 + 1.0 / 479001600.0; cp = cp * r2 - 1.0 / 3628800.0; cp = cp * r2 + 1.0 / 40320.0; cp = cp * r2 - 1.0 / 720.0; cp = cp * r2 + 1.0 / 24.0; cp = cp * r2 - 0.5; cp = cp * r2 + 1.0;
    const double cr = cp;
    double c, s;
    if (q == 0) { c = cr; s = sr; } else if (q == 1) { c = -sr; s = cr; } else if (q == 2) { c = -cr; s = -sr; } else { c = sr; s = -cr; }
    c_out = (float)c; s_out = (float)s;
}


#define WSP(off) (wsb + (off))
#define MOD ((float*)WSP(WS_MOD))
#define WRT ((float*)WSP(WS_WRT))
#define ROPA ((float*)WSP(WS_ROPA))
#define ROPI ((float*)WSP(WS_ROPI))
#define TOPI ((int*)WSP(WS_TOPI))
#define GATE ((float*)WSP(WS_GATE))
#define SLOT ((int*)WSP(WS_SLOT))
#define WTPOOL ((bf16*)WSP(WS_WTPOOL))
#define WTUPP ((bf16*)WSP(WS_WTUPP))
#define WTUPA ((bf16*)WSP(WS_WTUPA))
#define WTOUT ((bf16*)WSP(WS_WTOUT))
#define WTIN ((bf16*)WSP(WS_WTIN))
#define W1T ((bf16*)WSP(WS_W1T))
#define W2T ((bf16*)WSP(WS_W2T))
#define Hb ((bf16*)WSP(WS_H))
#define Qb ((bf16*)WSP(WS_Q))
#define Kb ((bf16*)WSP(WS_K))
#define Vb ((bf16*)WSP(WS_V))
#define Ub ((bf16*)WSP(WS_U))
#define GLb ((bf16*)WSP(WS_GL))
#define QIb ((bf16*)WSP(WS_QI))
#define KWb ((bf16*)WSP(WS_KW))
#define MIXb ((bf16*)WSP(WS_MIX))
#define YPOOL ((bf16*)WSP(WS_YPOOL))
#define YATTN ((bf16*)WSP(WS_YATTN))
#define TMP ((float*)WSP(WS_TMP))
#define MERGED ((bf16*)WSP(WS_MERGED))
#define Yf ((float*)WSP(WS_Y))
#define X1 ((float*)WSP(WS_X1))
#define XS ((bf16*)WSP(WS_XS))
#define ACT ((bf16*)WSP(WS_ACT))
#define YS ((bf16*)WSP(WS_YS))
#define MASKW ((unsigned*)WSP(WS_MASK))
#define H8A ((unsigned char*)WSP(WS_XS + 1 * MiB))
#define WTIN8 ((unsigned char*)WSP(WS_XS + 64 * MiB))
#define ELIST ((int*)WSP(WS_XS + 40 * MiB))
#define ROWTOK ((int*)WSP(WS_XS))
#define PHASE_BASE() GAS unsigned char* wsg_ = (GAS unsigned char*)KA->ws; asm volatile("" : "+s"(wsg_)); unsigned char* wsb = (unsigned char*)wsg_; unsigned* ctl = (unsigned*)(wsb + WS_CTL); (void)ctl
#define INP(i) ((const float*)(const GAS float*)KA->in[i])
#define OUTP ((float*)(GAS float*)KA->out)
#define CAS __attribute__((address_space(4)))
extern __shared__ __attribute__((aligned(16))) unsigned char lds_raw[];
#define PH_PROLOG() \
    const CAS Args* KA = (const CAS Args*)__builtin_amdgcn_kernarg_segment_ptr(); LAS unsigned char* lds = (LAS unsigned char*)lds_raw; \
    volatile LAS unsigned* MISC = (volatile LAS unsigned*)(lds + MISC_OFF); (void)MISC; \
    const int wave = __builtin_amdgcn_readfirstlane((int)threadIdx.x >> 6); \
    const int lane = (int)__builtin_amdgcn_mbcnt_hi(~0u, __builtin_amdgcn_mbcnt_lo(~0u, 0u)), tid = wave * 64 + lane; \
    const int G = gridDim.x, bx = blockIdx.x; const int gw = bx * NWAVES + wave, NGW = G * NWAVES; (void)tid; (void)gw; (void)NGW; (void)lane

constexpr int FIRST_T_OFF = MISC_OFF + 1280, CNT_E_OFF = MISC_OFF + 1408, TILE_ROWS_OFF = MISC_OFF + 1536;
static_assert(TILE_ROWS_OFF + MAXTILES * 4 <= LDS_BYTES, "tile tables overflow the LDS block");
constexpr int FIRST_T_OFF_ = 0;
__device__ __forceinline__ void moe_tiles() {
    PH_PROLOG();
        PHASE_BASE();
        LAS int* tile_e = (LAS int*)(lds + TILE_E_OFF);
        if (wave == 0) {
            int myc = 0; if (lane < NE) myc = (int)__hip_atomic_load(ctl + CW_CUR + 64 * lane, __ATOMIC_RELAXED, __HIP_MEMORY_SCOPE_AGENT);
            const int ntl = (myc + 255) >> 8; int incl = ntl;
#pragma unroll
            for (int o = 1; o < 32; o <<= 1) { const int t = __shfl_up(incl, o); if ((lane & 31) >= o) incl += t; }
            if (lane < NE) { for (int i = incl - ntl; i < incl; ++i) { tile_e[i] = lane; const int lv = myc - (i - (incl - ntl)) * 256; ((LAS int*)(lds + TILE_ROWS_OFF))[i] = lv < 256 ? lv : 256; }
                ((LAS int*)(lds + FIRST_T_OFF))[lane] = incl - ntl; ((LAS int*)(lds + CNT_E_OFF))[lane] = myc; }
            if (lane == NE - 1) MISC[4] = (unsigned)incl;
        }
        __syncthreads();
}

__device__ __forceinline__ void phase0() {
    PH_PROLOG();
        PHASE_BASE();
        LAS float* scr = (LAS float*)(lds + wave * 16896);
        constexpr int I_IN = 296 * 32, I_PL = 128, I_UPP = UPP_FP8 ? 512 : 1024, I_UPA = UPA_FP8 ? 1024 : 2048, I_OUT = OUT_FP8 ? 1024 : 2048, I_1 = 32 * 2048, I_2 = 32 * 1024;
        constexpr int I_IN8 = GL_FP8 ? 16 * 224 : 0;
        constexpr int NIT = I_IN + I_IN8 + I_PL + I_UPP + I_UPA + I_OUT + I_1 + I_2;
        for (int it = gw; it < NIT; it += NGW) {
            int r = it;
            if (r < I_IN) { const int nb = r >> 5, kb = r & 31, d0 = 32 * nb; int src = 0, nv = 32;
                if (GL_FP8 && ((d0 >> 8) < 12 || ((d0 >> 8) >= 16 && (d0 >> 8) < 32))) continue;
                if (d0 < 2048) src = 1024 + d0; else if (d0 < 2560) src = 3072 + (d0 - 2048); else if (d0 < 3072) src = 3584 + (d0 - 2560); else if (d0 < 4096) src = d0 - 3072;
                else if (d0 < 8192) src = 5200 + (d0 - 4096); else if (d0 < 9216) src = 4096 + (d0 - 8192); else if (d0 < 9280) src = 5120 + (d0 - 9216); else if (d0 < 9312) { src = 5184; nv = 16; } else { src = 0; nv = 0; }
                tr_item(INP(I_WIN) + (size_t)(64 * kb) * 9296 + src, 9296, nv, WTIN + (size_t)d0 * 2048 + 64 * kb, 2048, scr, lane); continue; }
            r -= I_IN;
#if GL_FP8
            if (r < I_IN8) { const int kb = r / 224, nb = r % 224, p0 = 32 * nb;
                const int src = p0 < 2048 ? 1024 + p0 : p0 < 2560 ? 3072 + (p0 - 2048) : p0 < 3072 ? 3584 + (p0 - 2560) : 5200 + (p0 - 3072);
                tr_item8(INP(I_WIN) + (size_t)(128 * kb) * 9296 + src, 9296, WTIN8 + (size_t)p0 * 2048 + 128 * kb, 2048, W8_SCALE, scr, lane); continue; }
            r -= I_IN8;
#endif
            if (r < I_PL) { const int gI = r >> 5, q = r & 31, kb = q >> 3, nb = q & 7;
                tr_item(INP(I_WPOOL) + (size_t)gI * 65536 + (size_t)(64 * kb) * 256 + 32 * nb, 256, 32, WTPOOL + (size_t)gI * 65536 + (size_t)(32 * nb) * 256 + 64 * kb, 256, scr, lane); continue; }
            r -= I_PL;
            if (r < I_UPP) {
#if UPP_FP8
                const int kb = r >> 6, nb = r & 63;
                tr_item8(INP(I_WUPP) + (size_t)(128 * kb) * 2048 + 32 * nb, 2048, (unsigned char*)WTUPP + (size_t)(32 * nb) * 2048 + 128 * kb, 2048, W8_SCALE, scr, lane);
#else
                const int nb = r >> 4, kb = r & 15;
                tr_item(INP(I_WUPP) + (size_t)(64 * kb) * 2048 + 32 * nb, 2048, 32, WTUPP + (size_t)(32 * nb) * 1024 + 64 * kb, 1024, scr, lane);
#endif
                continue; }
            r -= I_UPP;
            if (r < I_UPA) {
#if UPA_FP8
                const int kb = r >> 6, nb = r & 63;
                tr_item8(INP(I_WUPA) + (size_t)(128 * kb) * 2048 + 32 * nb, 2048, (unsigned char*)WTUPA + (size_t)(32 * nb) * 2048 + 128 * kb, 2048, W8_SCALE, scr, lane);
#else
                const int nb = r >> 5, kb = r & 31;
                tr_item(INP(I_WUPA) + (size_t)(64 * kb) * 2048 + 32 * nb, 2048, 32, WTUPA + (size_t)(32 * nb) * 2048 + 64 * kb, 2048, scr, lane);
#endif
                continue; }
            r -= I_UPA;
            if (r < I_OUT) {
#if OUT_FP8
                const int kb = r >> 6, nb = r & 63;
                tr_item8(INP(I_WOUT) + (size_t)(128 * kb) * 2048 + 32 * nb, 2048, (unsigned char*)WTOUT + (size_t)(32 * nb) * 2048 + 128 * kb, 2048, W8_SCALE, scr, lane);
#else
                const int nb = r >> 5, kb = r & 31;
                tr_item(INP(I_WOUT) + (size_t)(64 * kb) * 2048 + 32 * nb, 2048, 32, WTOUT + (size_t)(32 * nb) * 2048 + 64 * kb, 2048, scr, lane);
#endif
                continue; }
            r -= I_OUT;
            if (r < I_1) { const int e = r >> 11, q = r & 2047, kb = q >> 7, nb = q & 127, c0 = 32 * nb;
                const int dst = c0 < 2048 ? 256 * (c0 >> 7) + (c0 & 127) : 256 * ((c0 - 2048) >> 7) + 128 + ((c0 - 2048) & 127);
                tr_item8(INP(I_W1) + (size_t)e * 2048 * 4096 + (size_t)(128 * kb) * 4096 + c0, 4096, (unsigned char*)W1T + ((size_t)e * 4096 + dst) * 2048 + 128 * kb, 2048, W8_SCALE, scr, lane); continue; }
            r -= I_1;
            { const int e = r >> 10, q = r & 1023, kb = q >> 6, nb = q & 63;
                tr_item8(INP(I_W2) + (size_t)e * 2048 * 2048 + (size_t)(128 * kb) * 2048 + 32 * nb, 2048, (unsigned char*)W2T + ((size_t)e * 2048 + 32 * nb) * 2048 + 128 * kb, 2048, W8_SCALE, scr, lane); }
        }
        for (int id = bx * 512 + tid; id < NE * D; id += G * 512) WRT[id] = INP(I_WROUTER)[(size_t)(id & 2047) * 32 + (id >> 11)];
        for (int id = bx * 512 + tid; id < SEQ * 24; id += G * 512) {
            if (id < SEQ * 16) { const int pos = id >> 4, i = id & 15; float c_, s_; sincos_d((float)pos * KA->inv_a[i], c_, s_); ROPA[pos * 32 + i] = c_; ROPA[pos * 32 + 16 + i] = s_; }
            else { const int id2 = id - SEQ * 16, pos = id2 >> 3, i = id2 & 7; float c_, s_; sincos_d((float)pos * KA->inv_i[i], c_, s_); ROPI[pos * 16 + i] = c_; ROPI[pos * 16 + 8 + i] = s_; }
        }
        __syncthreads();
        LAS float* cact = (LAS float*)lds;
        LAS float* red = (LAS float*)(lds + 65536);
        for (int i = tid; i < NB * D; i += 512) { const float cv = INP(I_C)[i]; cact[i] = cv / (1.0f + __expf(-cv)); }
        __syncthreads();
        for (int cb = bx; cb < 256; cb += G) {
            float a8[8];
#pragma unroll
            for (int b = 0; b < 8; ++b) a8[b] = 0.f;
            if (lane < 48) {
                const float* wp = INP(I_WADA) + cb * 48 + lane;
#pragma unroll 1
                for (int i0 = 0; i0 < 256; i0 += 16) { float wv[16];
#pragma unroll
                    for (int i = 0; i < 16; ++i) wv[i] = wp[(size_t)(wave + 8 * (i0 + i)) * 12288];
#pragma unroll
                    for (int i = 0; i < 16; ++i) { const int k = wave + 8 * (i0 + i);
#pragma unroll
                        for (int b = 0; b < 8; ++b) a8[b] += cact[b * 2048 + k] * wv[i]; } }
#pragma unroll
                for (int b = 0; b < 8; ++b) red[(wave * 8 + b) * 48 + lane] = a8[b];
            }
            __syncthreads();
            if (tid < 384) { const int b = tid / 48, cI = tid % 48; float s = 0.f;
#pragma unroll
                for (int w = 0; w < 8; ++w) s += red[(w * 8 + b) * 48 + cI];
                MOD[b * 12288 + cb * 48 + cI] = s + INP(I_BADA)[cb * 48 + cI]; }
            __syncthreads();
        }
}

__device__ __forceinline__ void phase1() {
    PH_PROLOG();
        PHASE_BASE();
        const float* gp = INP(I_GPREMIX);
        LAS float* lp = (LAS float*)lds;
        { for (int i = tid; i < D / 4; i += 512) ((LAS f32x4*)lp)[i] = ((const f32x4*)gp)[i];
          for (int i = tid; i < NB * (D / 4); i += 512) { const int bb = i >> 9, c4 = i & 511; const float* mod = MOD + bb * 12288;
              ((LAS f32x4*)(lp + 2048 + bb * 4096))[c4] = ((const f32x4*)(mod + 2048))[c4] + 1.0f; ((LAS f32x4*)(lp + 2048 + bb * 4096 + 2048))[c4] = ((const f32x4*)mod)[c4]; }
          __syncthreads(); }
        for (int m0 = gw; m0 < T; m0 += 2 * NGW) {
            f32x4 v[2][8]; float rstd[2];
#pragma unroll
            for (int u = 0; u < 2; ++u) { const f32x4* xr = (const f32x4*)(INP(I_X) + (size_t)(m0 + u * NGW) * D) + lane;
#pragma unroll
                for (int j = 0; j < 8; ++j) v[u][j] = xr[64 * j]; }
#pragma unroll
            for (int u = 0; u < 2; ++u) { float ss = 0.f;
#pragma unroll
                for (int j = 0; j < 8; ++j) ss += (v[u][j].x * v[u][j].x + v[u][j].y * v[u][j].y) + (v[u][j].z * v[u][j].z + v[u][j].w * v[u][j].w);
                rstd[u] = rsqrtf(wave_sum(ss) * (1.0f / D) + EPS); }
#pragma unroll
            for (int u = 0; u < 2; ++u) { const int m = m0 + u * NGW, b = m >> 11; const LAS float* lpb = lp + 2048 + b * 4096;
                v2u* o8 = (v2u*)(Hb + (size_t)m * D) + lane;
#pragma unroll
                for (int j = 0; j < 8; ++j) { const int col = 4 * (lane + 64 * j);
                    const f32x4 gv = *(const LAS f32x4*)(lp + col), sc = *(const LAS f32x4*)(lpb + col), sh = *(const LAS f32x4*)(lpb + 2048 + col);
                    const f32x4 hv = (v[u][j] * rstd[u] * gv) * sc + sh;
                    v2u w; w.x = cvt_pk_bf16(hv.x, hv.y); w.y = cvt_pk_bf16(hv.z, hv.w); o8[64 * j] = w;
#if GL_FP8
                    ((unsigned*)(H8A + (size_t)m * D))[lane + 64 * j] = pk4_fp8(hv.x, hv.y, hv.z, hv.w);
#endif
                } }
        }
}

__device__ __forceinline__ void phase2() {
    PH_PROLOG();
        PHASE_BASE();
#if GL_FP8
        { pg8::Gemm g{2 * D, 2 * D, 2 * D};
          ProjOrder<0> S{T / 256, G, bx, (const char*)Hb, (const char*)WTIN, (size_t)256 * D * 2, (size_t)256 * D * 2};
          EpiProj E{Qb, Kb, Vb, Ub, GLb, QIb, KWb, ROPA, ROPI, 1.0f};
          pg8::gemm_phase<EpiProj, ProjOrder<0>>(lds, g, S, E); }
        __syncthreads();
        { pg8::Gemm g{D, D, D};
          ProjOrder<1> S{T / 256, G, bx, (const char*)H8A, (const char*)WTIN8, (size_t)256 * D, (size_t)256 * D};
          EpiProj E{Qb, Kb, Vb, Ub, GLb, QIb, KWb, ROPA, ROPI, 1.0f / W8_SCALE};
          pg8::gemm_phase<EpiProj, ProjOrder<1>, true>(lds, g, S, E); }
#else
        pg8::Gemm g{2 * D, 2 * D, 2 * D};
        DenseOrder S{T / 256, NPROJ / 256, G, bx, (const char*)Hb, (const char*)WTIN, (size_t)256 * D * 2, 0, (size_t)256 * D * 2};
        EpiProj E{Qb, Kb, Vb, Ub, GLb, QIb, KWb, ROPA, ROPI, 1.0f};
        pg8::gemm_phase<EpiProj, DenseOrder>(lds, g, S, E);
#endif
}

__device__ __forceinline__ void phase3() { }

__device__ __forceinline__ void phase4() {
    PH_PROLOG();
        PHASE_BASE();
        { Unit pu;
          if (pg8::order_next(0, G, bx, T / 256, 4, pu)) {
              { const int c8 = pu.pn * 32 + (tid & 31), seg = tid >> 5, w = 2 << pu.pn, trow0 = pu.pm * 256 + 16 * seg, pos0 = trow0 & 2047;
                const bf16* ucol = Ub + (size_t)c8 * 8;
                float S[8];
#pragma unroll
                for (int i = 0; i < 8; ++i) S[i] = 0.f;
                { const int c0 = pos0 < w ? pos0 : w;
                  for (int j = 1; j <= c0; ++j) { const v4u uv = *(const v4u*)(ucol + (size_t)(trow0 - j) * 1024);
                      S[0] += lo16(uv.x); S[1] += hi16(uv.x); S[2] += lo16(uv.y); S[3] += hi16(uv.y); S[4] += lo16(uv.z); S[5] += hi16(uv.z); S[6] += lo16(uv.w); S[7] += hi16(uv.w); } }
#pragma unroll 4
                for (int i = 0; i < 16; ++i) { const int t = trow0 + i, pos = pos0 + i;
                    const v4u uv = *(const v4u*)(ucol + (size_t)t * 1024);
                    const float f[8] = {lo16(uv.x), hi16(uv.x), lo16(uv.y), hi16(uv.y), lo16(uv.z), hi16(uv.z), lo16(uv.w), hi16(uv.w)};
#pragma unroll
                    for (int q = 0; q < 8; ++q) S[q] += f[q];
                    if (pos >= w) { const v4u lv = *(const v4u*)(ucol + (size_t)(t - w) * 1024);
                        S[0] -= lo16(lv.x); S[1] -= hi16(lv.x); S[2] -= lo16(lv.y); S[3] -= hi16(lv.y); S[4] -= lo16(lv.z); S[5] -= hi16(lv.z); S[6] -= lo16(lv.w); S[7] -= hi16(lv.w); }
                    const int cnt = (pos + 1) < w ? (pos + 1) : w; const float inv = __builtin_amdgcn_rcpf((float)cnt); v4u o;
                    o.x = pk2(S[0] * inv - f[0], S[1] * inv - f[1]); o.y = pk2(S[2] * inv - f[2], S[3] * inv - f[3]);
                    o.z = pk2(S[4] * inv - f[4], S[5] * inv - f[5]); o.w = pk2(S[6] * inv - f[6], S[7] * inv - f[7]);
                    *(v4u*)(MIXb + (size_t)t * 1024 + c8 * 8) = o; }
              }
          }
          VM_WAIT(); __syncthreads(); }
        { pg8::Gemm g{512, 2048, 512};
          DenseOrder S{T / 256, 4, G, bx, (const char*)MIXb, (const char*)WTPOOL, (size_t)256 * 1024 * 2, (size_t)256 * 2, (size_t)256 * 256 * 2};
          EpiPool E{YPOOL, INP(I_POOLSCALE)};
          pg8::gemm_phase<EpiPool, DenseOrder>(lds, g, S, E); }
        __syncthreads();
#pragma unroll 1
        for (int rnd = 0; rnd * NGW < NB * (SEQ / 2); ++rnd) {
            const int task = gw + rnd * NGW, b = task >> 10, mir = (b >> 1) & 1;
            const int tpr = task & 1023, tp = mir ? 1023 - tpr : tpr;
            const int tpr_lo = (bx * NWAVES) & 1023, tp_hi = mir ? 1023 - tpr_lo : tpr_lo + NWAVES - 1;
            indexer_task(QIb, KWb, MASKW, b, tp, 2 * tp_hi + 1, lds, wave, lane);
        }
}

__device__ __forceinline__ void phase5() {
    PH_PROLOG();
        PHASE_BASE();
#pragma unroll 1
        for (int L = bx; L < NB * 16 * 4; L += G) {
            const int b = L & 7, rest = L >> 3, h = rest >> 2, pair = rest & 3;
#pragma unroll 1
            for (int pass = 0; pass < 2; ++pass) {
                const int qb = pass ? pair : 7 - pair;
                const size_t r0 = (size_t)b * SEQ + (size_t)qb * 256;
                att::attn_masked_body(Qb + r0 * 2048 + h * 128, Kb + (size_t)b * SEQ * 512 + (h >> 2) * 128, Vb + (size_t)b * SEQ * 512 + (h >> 2) * 128,
                                      UPA_FP8 ? (bf16*)((unsigned char*)YATTN + r0 * 2048 + h * 128) : YATTN + r0 * 2048 + h * 128, MASKW + r0 * 64, (qb + 1) * 256, lds);
                __syncthreads();
            }
        }
}

__device__ __forceinline__ void phase6() {
    PH_PROLOG();
        PHASE_BASE();
        static_assert(UPP_FP8 && UPA_FP8 && OUT_FP8, "the fused up-projection runs on e4m3 operands and writes e4m3 merged");
        { pg8::Gemm g{1024, 1024, 2048};
          UpOrder S{T / 256, D / 256, G, bx, (const char*)YPOOL, (const char*)YATTN, (const char*)WTUPP, (const char*)WTUPA};
          EpiUpF E{MERGED, GLb};
          pg8::gemm_phase<EpiUpF, UpOrder, true, true>(lds, g, S, E); }
}

__device__ __forceinline__ void phase7() {
    PH_PROLOG();
        PHASE_BASE();
        pg8::Gemm g{OUT_FP8 ? D : 2 * D, OUT_FP8 ? D : 2 * D, OUT_FP8 ? D : 2 * D};
        DenseOrder S{T / 256, D / 256, G, bx, (const char*)MERGED, (const char*)WTOUT, (size_t)256 * (OUT_FP8 ? D : 2 * D), 0, (size_t)256 * (OUT_FP8 ? D : 2 * D)};
        EpiY16 E{(bf16*)Yf};
        pg8::gemm_phase<EpiY16, DenseOrder, OUT_FP8 != 0>(lds, g, S, E);
}

__device__ __forceinline__ void phase8() {
    PH_PROLOG();
        PHASE_BASE();
        const float* gpm = INP(I_GPOSTMIX); const float* gpf = INP(I_GPREFFN);
        constexpr int NEL = 11;
        const int bs0 = (4 * (bx * NWAVES)) >> 11;
        LAS float* lp = (LAS float*)lds; LAS f32x4* wl = (LAS f32x4*)(lds + 65536);
        { for (int i = tid; i < D / 4; i += 512) { ((LAS f32x4*)lp)[i] = ((const f32x4*)gpm)[i]; ((LAS f32x4*)(lp + 2048))[i] = ((const f32x4*)gpf)[i]; }
          for (int i = tid; i < 2 * (D / 4); i += 512) { const int sl = i >> 9, c4 = i & 511; const int bb = sl ? (4 * (bx * NWAVES + NGW)) >> 11 : bs0; const float* mod = MOD + bb * 12288;
              LAS float* d = lp + 4096 + sl * 6144;
              ((LAS f32x4*)d)[c4] = ((const f32x4*)(mod + 4096))[c4]; ((LAS f32x4*)(d + 2048))[c4] = ((const f32x4*)(mod + 8192))[c4] + 1.0f; ((LAS f32x4*)(d + 4096))[c4] = ((const f32x4*)(mod + 6144))[c4]; }
          const f32x4* wg = (const f32x4*)WRT;
          for (int i = tid; i < NEL * D / 4; i += 512) wl[i] = wg[i];
          __syncthreads(); }
#pragma unroll 1
        for (int grp = gw; grp < T / 4; grp += NGW) {
            int lane = (int)__builtin_amdgcn_mbcnt_hi(~0u, __builtin_amdgcn_mbcnt_lo(~0u, 0u)); asm volatile("" : "+v"(lane));
            f32x4 hv[4][8];
#pragma unroll
            for (int r = 0; r < 4; ++r) {
                const int m = grp * 4 + r, b = m >> 11; const LAS float* lpb = lp + 4096 + ((b == bs0) ? 0 : 6144);
                const v2u* yr = (const v2u*)((const bf16*)Yf + (size_t)m * D) + lane; const f32x4* xr = (const f32x4*)(INP(I_X) + (size_t)m * D) + lane;
                v2u yw[8]; f32x4 xv[8];
#pragma unroll
                for (int j = 0; j < 8; ++j) yw[j] = yr[64 * j];
#pragma unroll
                for (int j = 0; j < 8; ++j) xv[j] = xr[64 * j];
                asm volatile("" ::: "memory");
                float ss = 0.f;
#pragma unroll
                for (int j = 0; j < 8; ++j) { const f32x4 t = {lo16(yw[j].x), hi16(yw[j].x), lo16(yw[j].y), hi16(yw[j].y)}; hv[r][j] = t; ss += (t.x * t.x + t.y * t.y) + (t.z * t.z + t.w * t.w); }
                const float rstd = rsqrtf(wave_sum(ss) * (1.0f / D) + EPS);
                float ss2 = 0.f; v2u* x1r = (v2u*)((bf16*)X1 + (size_t)m * D) + lane;
#pragma unroll
                for (int h = 0; h < 2; ++h) { f32x4 gv[4], gt[4];
#pragma unroll
                    for (int q = 0; q < 4; ++q) { const int col = 4 * (lane + 64 * (4 * h + q)); gv[q] = *(const LAS f32x4*)(lp + col); gt[q] = *(const LAS f32x4*)(lpb + col); }
                    asm volatile("" ::: "memory");
#pragma unroll
                    for (int q = 0; q < 4; ++q) { const int j = 4 * h + q;
                        const f32x4 t = xv[j] + gt[q] * (hv[r][j] * rstd * gv[q]); hv[r][j] = t; { v2u w; w.x = cvt_pk_bf16(t.x, t.y); w.y = cvt_pk_bf16(t.z, t.w); x1r[64 * j] = w; }
                        ss2 += (t.x * t.x + t.y * t.y) + (t.z * t.z + t.w * t.w); }
                    asm volatile("" ::: "memory"); }
                const float rstd2 = rsqrtf(wave_sum(ss2) * (1.0f / D) + EPS);
                unsigned* o8 = (unsigned*)((unsigned char*)Hb + (size_t)m * D) + lane;
#pragma unroll
                for (int h = 0; h < 2; ++h) { f32x4 gv[4], sc[4], sh[4];
#pragma unroll
                    for (int q = 0; q < 4; ++q) { const int col = 4 * (lane + 64 * (4 * h + q)); gv[q] = *(const LAS f32x4*)(lp + 2048 + col); sc[q] = *(const LAS f32x4*)(lpb + 2048 + col); sh[q] = *(const LAS f32x4*)(lpb + 4096 + col); }
                    asm volatile("" ::: "memory");
#pragma unroll
                    for (int q = 0; q < 4; ++q) { const int j = 4 * h + q;
                        const f32x4 t = (hv[r][j] * rstd2 * gv[q]) * sc[q] + sh[q]; hv[r][j] = t;
                        o8[64 * j] = pk4_fp8(t.x, t.y, t.z, t.w); }
                    asm volatile("" ::: "memory"); }
                asm volatile("" : "+v"(lane) :: "memory");
            }
            float lgA[4] = {0.f, 0.f, 0.f, 0.f}, lgB[4] = {0.f, 0.f, 0.f, 0.f};
            const int l15 = lane & 15;
#pragma unroll 1
            for (int e = 0; e < NEL; ++e) {
                const LAS f32x4* wp = wl + e * (D / 4) + lane;
                f32x2 p2[4] = {{0.f, 0.f}, {0.f, 0.f}, {0.f, 0.f}, {0.f, 0.f}};
#pragma unroll
                for (int j = 0; j < 8; ++j) { const f32x4 w = wp[64 * j]; const f32x2 w01 = {w.x, w.y}, w23 = {w.z, w.w};
#pragma unroll
                    for (int r = 0; r < 4; ++r) { p2[r] += (f32x2){hv[r][j].x, hv[r][j].y} * w01; p2[r] += (f32x2){hv[r][j].z, hv[r][j].w} * w23; } }
                const float p[4] = {p2[0].x + p2[0].y, p2[1].x + p2[1].y, p2[2].x + p2[2].y, p2[3].x + p2[3].y};
#pragma unroll
                for (int r = 0; r < 4; ++r) { const float sR = row_sum16(p[r]); lgA[r] = (l15 == e) ? sR : lgA[r]; }
            }
#pragma unroll 1
            for (int e = NEL; e < 16; ++e) {
                const f32x4* wp = (const f32x4*)(WRT + (size_t)e * D) + lane;
                f32x2 p2[4] = {{0.f, 0.f}, {0.f, 0.f}, {0.f, 0.f}, {0.f, 0.f}};
#pragma unroll
                for (int j = 0; j < 8; ++j) { const f32x4 w = wp[64 * j]; const f32x2 w01 = {w.x, w.y}, w23 = {w.z, w.w};
#pragma unroll
                    for (int r = 0; r < 4; ++r) { p2[r] += (f32x2){hv[r][j].x, hv[r][j].y} * w01; p2[r] += (f32x2){hv[r][j].z, hv[r][j].w} * w23; } }
                const float p[4] = {p2[0].x + p2[0].y, p2[1].x + p2[1].y, p2[2].x + p2[2].y, p2[3].x + p2[3].y};
#pragma unroll
                for (int r = 0; r < 4; ++r) { const float sR = row_sum16(p[r]); lgA[r] = (l15 == e) ? sR : lgA[r]; }
            }
#pragma unroll 1
            for (int e = 0; e < 16; ++e) {
                const f32x4* wp = (const f32x4*)(WRT + (size_t)(16 + e) * D) + lane;
                f32x2 p2[4] = {{0.f, 0.f}, {0.f, 0.f}, {0.f, 0.f}, {0.f, 0.f}};
#pragma unroll
                for (int j = 0; j < 8; ++j) { const f32x4 w = wp[64 * j]; const f32x2 w01 = {w.x, w.y}, w23 = {w.z, w.w};
#pragma unroll
                    for (int r = 0; r < 4; ++r) { p2[r] += (f32x2){hv[r][j].x, hv[r][j].y} * w01; p2[r] += (f32x2){hv[r][j].z, hv[r][j].w} * w23; } }
                const float p[4] = {p2[0].x + p2[0].y, p2[1].x + p2[1].y, p2[2].x + p2[2].y, p2[3].x + p2[3].y};
#pragma unroll
                for (int r = 0; r < 4; ++r) { const float sR = row_sum16(p[r]); lgB[r] = (l15 == e) ? sR : lgB[r]; }
            }
#pragma unroll
            for (int r = 0; r < 4; ++r) { lgA[r] += __shfl_xor(lgA[r], 16); lgA[r] += __shfl_xor(lgA[r], 32); lgB[r] += __shfl_xor(lgB[r], 16); lgB[r] += __shfl_xor(lgB[r], 32); }
            const float brt = INP(I_BROUTER)[lane & 31];
            int tiA[4][4]; float gA[4][4];
#pragma unroll
            for (int r = 0; r < 4; ++r) {
                float lv = (lane < NE) ? ((lane < 16) ? lgA[r] : lgB[r]) + brt : -__builtin_inff();
                float tv[4];
#pragma unroll
                for (int k = 0; k < 4; ++k) {
                    float m1 = row_max16(lv); m1 = __builtin_fmaxf(m1, __shfl_xor(m1, 16));
                    const float mx = __builtin_bit_cast(float, __builtin_amdgcn_readlane(__builtin_bit_cast(int, m1), 0));
                    int c1 = row_min16i((lv == mx) ? lane : 99); { const int t = __shfl_xor(c1, 16); c1 = t < c1 ? t : c1; }
                    const int ie = __builtin_amdgcn_readlane(c1, 0);
                    tv[k] = mx; tiA[r][k] = ie; if (lane == ie) lv = -__builtin_inff(); }
                const float e1 = __expf(tv[1] - tv[0]), e2 = __expf(tv[2] - tv[0]), e3 = __expf(tv[3] - tv[0]); const float is = 1.0f / (1.0f + e1 + e2 + e3);
                gA[r][0] = is; gA[r][1] = e1 * is; gA[r][2] = e2 * is; gA[r][3] = e3 * is;
            }
            if (lane < 4) {
                const int m = grp * 4 + lane; int ti[4]; float gg[4];
#pragma unroll
                for (int k = 0; k < 4; ++k) { ti[k] = lane == 0 ? tiA[0][k] : lane == 1 ? tiA[1][k] : lane == 2 ? tiA[2][k] : tiA[3][k]; gg[k] = lane == 0 ? gA[0][k] : lane == 1 ? gA[1][k] : lane == 2 ? gA[2][k] : gA[3][k]; }
                *(int4*)(TOPI + (size_t)m * 4) = make_int4(ti[0], ti[1], ti[2], ti[3]); *(f32x4*)(GATE + (size_t)m * 4) = (f32x4){gg[0], gg[1], gg[2], gg[3]};
                int ps[4];
#pragma unroll
                for (int k = 0; k < 4; ++k) ps[k] = (int)xb_add(ctl + CW_CUR + 64 * ti[k], 1u);
#pragma unroll
                for (int k = 0; k < 4; ++k) ELIST[ti[k] * 16384 + ps[k]] = m;
                *(int4*)(SLOT + (size_t)m * 4) = make_int4(ps[0], ps[1], ps[2], ps[3]); }
        }
}

__device__ __forceinline__ void phase9() { }

__device__ __forceinline__ void phase10() {
    PH_PROLOG();
    moe_tiles();
        PHASE_BASE();
        const int ntiles = (int)MISC[4]; const LAS int* tile_e = (const LAS int*)(lds + TILE_E_OFF);
        pg8::Gemm g{D, D, D};
        LAS int* tokL = (LAS int*)(lds + TOK_OFF);
        MoeOrder S{ntiles, 16, G, bx, (const char*)Hb, (const char*)W1T, 0, (size_t)4096 * D, (size_t)256 * D, tile_e, tokL, (const LAS int*)(lds + TILE_ROWS_OFF), 1};
        { const LAS int* first_t = (const LAS int*)(lds + FIRST_T_OFF); const LAS int* cnt_e = (const LAS int*)(lds + CNT_E_OFF);
          int tv[9]; const int r8 = tid & 255;
#pragma unroll
          for (int q = 0; q < 9; ++q) { const int i = (tid >> 8) + 2 * q; Unit u; const bool ok = S.next(i, u); const int pm = ok ? u.pm : 0;
              const int rr = r8 + (ok ? u.roff : 0);
              const int e = tile_e[pm], r = (pm - first_t[e]) * 256 + rr; const bool live = ok && (rr < 256) && (r < cnt_e[e]);
              const int v = ELIST[live ? e * 16384 + r : 0]; tv[q] = live ? v : 0; }
#pragma unroll
          for (int q = 0; q < 9; ++q) { const int i = (tid >> 8) + 2 * q; tokL[i * 256 + r8] = tv[q]; } }
        __syncthreads();
        EpiAct E{(unsigned char*)ACT, INP(I_B1), tile_e, (LAS float*)(lds + TOK_OFF + 18 * 1024)};
        pg8::gemm_phase<EpiAct, MoeOrder, true, true>(lds, g, S, E);
}

__device__ __forceinline__ void phase11() {
    PH_PROLOG();
    moe_tiles();
        PHASE_BASE();
        const int ntiles = (int)MISC[4]; const LAS int* tile_e = (const LAS int*)(lds + TILE_E_OFF);
        pg8::Gemm g{DFF, DFF, DFF};
        MoeOrder S{ntiles, 8, G, bx, (const char*)ACT, (const char*)W2T, (size_t)256 * DFF, (size_t)2048 * DFF, (size_t)256 * DFF, tile_e, nullptr, (const LAS int*)(lds + TILE_ROWS_OFF), 1};
        EpiYs E{(unsigned char*)YS, INP(I_B2), tile_e, (LAS float*)(lds + TOK_OFF + 18 * 1024)};
        pg8::gemm_phase<EpiYs, MoeOrder, true>(lds, g, S, E);
}

__device__ __forceinline__ void phase12() {
    PH_PROLOG();
        PHASE_BASE();
        const float* gpo = INP(I_GPOSTFFN);
        int frow;
        { int myc = 0; if (lane < NE) myc = (int)__hip_atomic_load(ctl + CW_CUR + 64 * lane, __ATOMIC_RELAXED, __HIP_MEMORY_SCOPE_AGENT);
          const int padded = (myc + 255) & ~255; int incl = padded;
#pragma unroll
          for (int o = 1; o < 32; o <<= 1) { const int t = __shfl_up(incl, o); if ((lane & 31) >= o) incl += t; }
          frow = incl - padded; }
        LAS float* lp = (LAS float*)lds;
        { for (int i = tid; i < D / 4; i += 512) ((LAS f32x4*)lp)[i] = ((const f32x4*)gpo)[i];
          for (int i = tid; i < NB * (D / 4); i += 512) { const int bb = i >> 9, c4 = i & 511; ((LAS f32x4*)(lp + 2048 + bb * 2048))[c4] = ((const f32x4*)(MOD + bb * 12288 + 10240))[c4]; }
          __syncthreads(); }
        int4 sl = *(const int4*)(SLOT + (size_t)gw * 4), te = *(const int4*)(TOPI + (size_t)gw * 4); f32x4 gt4 = *(const f32x4*)(GATE + (size_t)gw * 4);
#pragma unroll 1
        for (int m = gw; m < T; m += NGW) {
            int lane = (int)__builtin_amdgcn_mbcnt_hi(~0u, __builtin_amdgcn_mbcnt_lo(~0u, 0u)); asm volatile("" : "+v"(lane));
            const int b = m >> 11;
            const int sk[4] = {__shfl(frow, te.x) + sl.x, __shfl(frow, te.y) + sl.y, __shfl(frow, te.z) + sl.z, __shfl(frow, te.w) + sl.w}; constexpr float IYS = 1.0f / YS8_SCALE; const float gk[4] = {gt4.x * IYS, gt4.y * IYS, gt4.z * IYS, gt4.w * IYS};
            unsigned yw[4][8]; v2u xw[8];
#pragma unroll
            for (int k = 0; k < 4; ++k) { const unsigned* yp = (const unsigned*)((const unsigned char*)YS + (size_t)sk[k] * D) + lane;
#pragma unroll
                for (int j = 0; j < 8; ++j) yw[k][j] = yp[64 * j]; }
            const v2u* x1r = (const v2u*)((const bf16*)X1 + (size_t)m * D) + lane;
#pragma unroll
            for (int j = 0; j < 8; ++j) xw[j] = x1r[64 * j];
            { const int mn = (m + NGW < T) ? m + NGW : m; sl = *(const int4*)(SLOT + (size_t)mn * 4); te = *(const int4*)(TOPI + (size_t)mn * 4); gt4 = *(const f32x4*)(GATE + (size_t)mn * 4); }
            asm volatile("" ::: "memory");
            f32x4 a[8];
#pragma unroll
            for (int j = 0; j < 8; ++j) a[j] = (f32x4){0.f, 0.f, 0.f, 0.f};
#pragma unroll
            for (int k = 0; k < 4; ++k)
#pragma unroll
                for (int j = 0; j < 8; ++j) { const int w = (int)yw[k][j]; const f32x2 lo = __builtin_amdgcn_cvt_pk_f32_fp8(w, false), hi = __builtin_amdgcn_cvt_pk_f32_fp8(w, true);
                    a[j] += (f32x4){lo.x, lo.y, hi.x, hi.y} * gk[k]; }
            float ss = 0.f;
#pragma unroll
            for (int j = 0; j < 8; ++j) ss += (a[j].x * a[j].x + a[j].y * a[j].y) + (a[j].z * a[j].z + a[j].w * a[j].w);
            const float rstd = rsqrtf(wave_sum(ss) * (1.0f / D) + EPS);
            f32x4* orow = (f32x4*)(OUTP + (size_t)m * D) + lane;
#pragma unroll
            for (int j = 0; j < 8; ++j) { const int col = 4 * (lane + 64 * j);
                const f32x4 gv = *(const LAS f32x4*)(lp + col), gt = *(const LAS f32x4*)(lp + 2048 + b * 2048 + col);
                __builtin_nontemporal_store((f32x4){lo16(xw[j].x), hi16(xw[j].x), lo16(xw[j].y), hi16(xw[j].y)} + gt * (a[j] * rstd * gv), orow + 64 * j); }
        }
}

__global__ void __launch_bounds__(NWAVES * 64, 2) fwd_kernel(Args args) {
    LAS unsigned char* lds = (LAS unsigned char*)lds_raw;
    volatile LAS unsigned* MISC = (volatile LAS unsigned*)(lds + MISC_OFF);
    const int wave = __builtin_amdgcn_readfirstlane((int)threadIdx.x >> 6);
    const int lane = (int)__builtin_amdgcn_mbcnt_hi(~0u, __builtin_amdgcn_mbcnt_lo(~0u, 0u)), tid = wave * 64 + lane;
    unsigned* ctl0 = (unsigned*)(args.ws + WS_CTL);
    for (int u = tid; u < (LDS_BYTES - MISC_OFF) / 4; u += NWAVES * 64) ((LAS unsigned*)(lds + MISC_OFF))[u] = 0u;
    __syncthreads();
    XcdBarrier bar; bar.bar = ctl0 + CW_BAR; bar.x = 0; bar.st = nullptr;
    if (MK_N_LAUNCHES == 1) bar = xcd_barrier_post(ctl0 + CW_BAR, MISC);
    const int lo = args.ph_lo, hi = args.ph_hi;
#ifndef PHMASK
#define PHMASK 0xFFFF
#endif
#define IN(k) ((((PHMASK) >> (k)) & 1) && lo <= (k) && (k) < hi)
#define SEAM(k) do { if (IN(k) && IN((k) + 1)) xcd_barrier(bar); } while (0)
#ifndef PROBE_MASK
#define PROBE_MASK 0
#endif
#define REP(k) _Pragma("unroll") for (int rep_ = 0; rep_ < ((((PROBE_MASK) >> (k)) & 1) ? 2 : 1); ++rep_)

    if (IN(0)) REP(0) { if (rep_) __syncthreads(); phase0(); }
    SEAM(0);

    if (IN(1)) REP(1) { if (rep_) __syncthreads(); phase1(); }
    SEAM(1);

    if (IN(2)) REP(2) { if (rep_) __syncthreads(); phase2(); }
    SEAM(2);


    if (IN(4)) REP(4) { if (rep_) __syncthreads(); phase4(); }
    SEAM(4);
    if (IN(5)) REP(5) { if (rep_) __syncthreads(); phase5(); }
    SEAM(5);

    if (IN(6)) REP(6) { if (rep_) __syncthreads(); phase6(); }
    SEAM(6);

    if (IN(7)) REP(7) { if (rep_) __syncthreads(); phase7(); }
    SEAM(7);

    if (IN(8)) { phase8(); }
    SEAM(8);


    if (IN(10)) REP(10) { if (rep_) __syncthreads(); phase10(); }
    SEAM(10);
    if (IN(11)) REP(11) { if (rep_) __syncthreads(); phase11(); }
    SEAM(11);

    if (IN(12)) REP(12) { if (rep_) __syncthreads(); phase12(); }
#undef IN
#undef SEAM
}

constexpr int NPHASES = 13;
extern "C" void kernel_launch(void* const* d_in, const int* in_sizes, int n_in, void* d_out, int out_size, void* d_ws, size_t ws_size, hipStream_t stream) {
    static int grid = 0;
    if (grid == 0) {
        if (n_in != 20 || out_size != T * D || ws_size < WS_END) { fprintf(stderr, "kernel_launch: unexpected shapes (n_in %d out %d ws %zu need %zu)\n", n_in, out_size, ws_size, (size_t)WS_END); grid = -1; return; }
        int dev = 0, cus = 0, per_cu = 0;
        if (hipGetDevice(&dev) != hipSuccess || hipDeviceGetAttribute(&cus, hipDeviceAttributeMultiprocessorCount, dev) != hipSuccess) { grid = -1; return; }
        if (hipFuncSetAttribute((const void*)fwd_kernel, hipFuncAttributeMaxDynamicSharedMemorySize, LDS_BYTES) != hipSuccess) { fprintf(stderr, "kernel_launch: hipFuncSetAttribute failed\n"); grid = -1; return; }
        if (hipOccupancyMaxActiveBlocksPerMultiprocessor(&per_cu, (const void*)fwd_kernel, NWAVES * 64, LDS_BYTES) != hipSuccess || per_cu < 1)
            fprintf(stderr, "kernel_launch: occupancy query reports %d workgroups per CU\n", per_cu);
        (void)hipGetLastError();
        grid = cus;
        if (grid != 256) fprintf(stderr, "kernel_launch: %d CUs (built for 256)\n", grid);
    }
    if (grid < 0) return;
    (void)in_sizes;
    if (hipMemsetAsync((char*)d_ws + WS_CTL, 0, CTL_ZERO_BYTES, stream) != hipSuccess) { fprintf(stderr, "kernel_launch: memset failed\n"); return; }
    Args a{};
    for (int i = 0; i < 20; ++i) a.in[i] = (const float*)d_in[i];
    a.out = (float*)d_out; a.ws = (unsigned char*)d_ws;
    for (int i = 0; i < 16; ++i) a.inv_a[i] = (float)pow(500000.0, -(double)(2 * i) / 32.0);
    for (int i = 0; i < 8; ++i) a.inv_i[i] = (float)pow(500000.0, -(double)(2 * i) / 16.0);
#if MK_N_LAUNCHES == 1
    a.ph_lo = 0; a.ph_hi = NPHASES;
    hipLaunchKernelGGL(fwd_kernel, dim3(grid), dim3(NWAVES * 64), LDS_BYTES, stream, a);
#else
    for (int p = 0; p < NPHASES; ++p) { a.ph_lo = p; a.ph_hi = p + 1; hipLaunchKernelGGL(fwd_kernel, dim3(grid), dim3(NWAVES * 64), LDS_BYTES, stream, a); }
#endif
    const hipError_t le = hipPeekAtLastError();
    if (le != hipSuccess) fprintf(stderr, "kernel_launch: launch failed: %s\n", hipGetErrorName(le));
}
```
